# Optimizing an MI355X kernel written in HIP

```python
import jax
import jax.numpy as jnp
from jax import lax
import numpy as np

D_MODEL = 2048
BATCH = 2
SEQ = 4096
DEPTH = 2

GRID_W = 64
CTX_LEN = 256
N_MOD = 6
ATT_HEADS = 8
ATT_KV_HEADS = 2
HEAD_DIM = 128
ATT_W = ATT_HEADS * HEAD_DIM
KV_W = ATT_KV_HEADS * HEAD_DIM
ROPE_AXIS_DIM = HEAD_DIM // 2
ROPE_BASE = 10000.0
Q_BLOCK = 128
ML_HEADS = 4
ML_DK = 256
ML_DV = 256
ML_W = ML_HEADS * ML_DV
CONV_W = 3
HG_HEADS = 8
HG_DK = 128
HG_DV = 128
HG_W = HG_HEADS * HG_DV
CHUNK = 64
N_BRANCH = 3
BRANCH_W = 1024
D_FF = 5632
N_EXPERTS = 8
TOP_K = 2
EPS = 1e-6
NEG_INIT = -1e30
IN_SPLITS = (ATT_W, KV_W, KV_W, ML_W, ML_W, ML_W, ML_W, 4 * ML_HEADS, HG_W, HG_W, HG_W, HG_W, HG_W, N_BRANCH * D_MODEL)
N_IN = sum(IN_SPLITS)

kernel_name = 'hybrid_gqa_mlstm_hgrn2_moe_prefix_block'


def rms_norm(x, g):
    x32 = x.astype(jnp.float32)
    y = x32 * lax.rsqrt(jnp.mean(x32 * x32, axis=-1, keepdims=True) + EPS)
    return (y * g.astype(jnp.float32)).astype(x.dtype)


def split_cols(p):
    return jnp.split(p, np.cumsum(IN_SPLITS)[:-1].tolist(), axis=-1)


def to_heads(t, n):
    b, s, _ = t.shape
    return t.reshape(b, s, n, -1).transpose(0, 2, 1, 3)


def head_rms(h, g):
    b, n, s, d = h.shape
    y = rms_norm(h.transpose(0, 2, 1, 3), g.reshape(n, d))
    return y.reshape(b, s, n * d)


def to_chunks(t):
    b, n, s = t.shape[:3]
    return jnp.moveaxis(t.reshape((b, n, s // CHUNK, CHUNK) + t.shape[3:]), 2, 0)


def from_chunks(t):
    t = jnp.moveaxis(t, 0, 2)
    return t.reshape(t.shape[:2] + (-1,) + t.shape[4:])


FLIPS = (lambda t: t, lambda t: jnp.flip(t, axis=2))


def axial_rope_tables(n, dtype):
    rows = n // GRID_W
    t = jnp.arange(rows * GRID_W)
    pos = jnp.stack([t // GRID_W, t % GRID_W], axis=-1).astype(jnp.float32)
    inv_freq = jnp.exp(-jnp.log(ROPE_BASE) * jnp.arange(0, ROPE_AXIS_DIM, 2, dtype=jnp.float32) / ROPE_AXIS_DIM)
    ang = pos[..., None] * inv_freq
    return jnp.cos(ang).astype(dtype), jnp.sin(ang).astype(dtype)


def apply_rope(x, cos, sin):
    b, s, h, _ = x.shape
    xr = x.reshape(b, s, h, 2, 2, ROPE_AXIS_DIM // 2)
    x1, x2 = xr[..., 0, :], xr[..., 1, :]
    co, si = cos[None, :, None], sin[None, :, None]
    return jnp.stack([x1 * co - x2 * si, x2 * co + x1 * si], axis=-2).reshape(x.shape)


def centred_conv(x, w):
    pad = CONV_W // 2
    s = x.shape[1]
    xp = jnp.pad(x, ((0, 0), (pad, pad), (0, 0)))
    y = xp[:, 0:s] * w[0]
    for j in range(1, CONV_W):
        y = y + xp[:, j:j + s] * w[j]
    return y


def attention_branch(pc, pl, qg, kg, cos, sin, need_ctx):
    scale = HEAD_DIM ** -0.5
    grp = ATT_HEADS // ATT_KV_HEADS
    kc = rms_norm(pc[1].reshape(pc[1].shape[:2] + (ATT_KV_HEADS, HEAD_DIM)), kg)
    vc = pc[2].reshape(pc[2].shape[:2] + (ATT_KV_HEADS, HEAD_DIM))
    b, s, _ = pl[0].shape
    kl = apply_rope(rms_norm(pl[1].reshape(b, s, ATT_KV_HEADS, HEAD_DIM), kg), cos, sin)
    vl = pl[2].reshape(b, s, ATT_KV_HEADS, HEAD_DIM)
    keys = jnp.concatenate([kc, kl], axis=1).transpose(0, 2, 1, 3)
    vals = jnp.concatenate([vc, vl], axis=1).transpose(0, 2, 1, 3)
    ql = apply_rope(rms_norm(pl[0].reshape(b, s, ATT_HEADS, HEAD_DIM), qg), cos, sin) * scale
    qb = ql.reshape(b, s // Q_BLOCK, Q_BLOCK, ATT_KV_HEADS, grp, HEAD_DIM).transpose(1, 0, 3, 4, 2, 5)

    def block(qblk):
        sc = jnp.einsum('bkgqd,bktd->bkgqt', qblk, keys).astype(jnp.float32)
        p = jax.nn.softmax(sc, axis=-1).astype(vals.dtype)
        return jnp.einsum('bkgqt,bktd->bkgqd', p, vals)

    ob = lax.map(block, qb)
    y_l = ob.transpose(1, 0, 4, 2, 3, 5).reshape(b, s, ATT_W)
    y_c = None
    if need_ctx:
        bc, tc, _ = pc[0].shape
        qc = rms_norm(pc[0].reshape(bc, tc, ATT_HEADS, HEAD_DIM), qg) * scale
        qc = qc.reshape(bc, tc, ATT_KV_HEADS, grp, HEAD_DIM)
        sc = jnp.einsum('bqkgd,btkd->bkgqt', qc, kc).astype(jnp.float32)
        p = jax.nn.softmax(sc, axis=-1).astype(vc.dtype)
        y_c = jnp.einsum('bkgqt,btkd->bqkgd', p, vc).reshape(bc, tc, ATT_W)
    return y_c, y_l


def mlstm_zero_state(b):
    return (jnp.zeros((b, ML_HEADS, ML_DK, ML_DV), jnp.float32), jnp.zeros((b, ML_HEADS, ML_DK), jnp.float32),
            jnp.full((b, ML_HEADS), NEG_INIT, jnp.float32))


def mlstm_final_state(k, v, log_i, log_f):
    f_cum = jnp.cumsum(log_f, axis=-1)
    g = f_cum[..., -1:] - f_cum + log_i
    m = jnp.max(g, axis=-1)
    w = jnp.exp(g - m[..., None])
    return (jnp.einsum('bhs,bhsd,bhse->bhde', w, k, v), jnp.einsum('bhs,bhsd->bhd', w, k), m)


def mlstm_chunkwise(q, k, v, log_i, log_f, state):
    tril = jnp.tril(jnp.ones((CHUNK, CHUNK), bool))

    def step(carry, inp):
        c_st, n_st, m_st = carry
        qc, kc, vc, li, lf = inp
        f_cum = jnp.cumsum(lf, axis=-1)
        dmat = jnp.where(tril, f_cum[..., :, None] - f_cum[..., None, :] + li[..., None, :], -jnp.inf)
        inter = f_cum + m_st[..., None]
        m_t = jnp.maximum(inter, jnp.max(dmat, axis=-1))
        w = jnp.exp(dmat - m_t[..., None])
        a = jnp.exp(inter - m_t)
        sc = jnp.einsum('bhtd,bhsd->bhts', qc, kc) * w
        num = jnp.einsum('bhts,bhse->bhte', sc, vc) + a[..., None] * jnp.einsum('bhtd,bhde->bhte', qc, c_st)
        den = jnp.sum(sc, axis=-1) + a * jnp.einsum('bhtd,bhd->bht', qc, n_st)
        h = num / jnp.maximum(jnp.abs(den), jnp.exp(-m_t))[..., None]
        f_last = f_cum[..., -1]
        g = f_last[..., None] - f_cum + li
        m_new = jnp.maximum(f_last + m_st, jnp.max(g, axis=-1))
        ws = jnp.exp(g - m_new[..., None])
        decay = jnp.exp(f_last + m_st - m_new)
        c_new = decay[..., None, None] * c_st + jnp.einsum('bhs,bhsd,bhse->bhde', ws, kc, vc)
        n_new = decay[..., None] * n_st + jnp.einsum('bhs,bhsd->bhd', ws, kc)
        return (c_new, n_new, m_new), h

    _, h = lax.scan(step, state, tuple(to_chunks(t) for t in (q, k, v, log_i, log_f)))
    return from_chunks(h)


def mlstm_branch(pc, pl, conv_w, gate_b, norm_g, need_ctx):
    def prep(q, k, v, gates):
        b, s, _ = q.shape
        qk = centred_conv(jnp.concatenate([q, k], axis=-1), conv_w).astype(jnp.float32)
        qh = to_heads(qk[..., :ML_W], ML_HEADS)
        kh = to_heads(qk[..., ML_W:], ML_HEADS) * ML_DK ** -0.5
        vh = to_heads(v.astype(jnp.float32), ML_HEADS)
        g = (gates + gate_b).astype(jnp.float32).reshape(b, s, 4, ML_HEADS).transpose(2, 0, 3, 1)
        return qh, kh, vh, g[:2], jax.nn.log_sigmoid(g[2:])

    def finish(h, o):
        return (head_rms(h, norm_g) * jax.nn.sigmoid(o.astype(jnp.float32))).astype(o.dtype)

    qc, kc, vc, lic, lfc = prep(pc[0], pc[1], pc[2], pc[4])
    ql, kl, vl, lil, lfl = prep(pl[0], pl[1], pl[2], pl[4])
    outs_l, outs_c = [], []
    for d in range(2):
        fl = FLIPS[d]
        state = mlstm_final_state(fl(kc), fl(vc), fl(lic[d]), fl(lfc[d]))
        outs_l.append(fl(mlstm_chunkwise(fl(ql), fl(kl), fl(vl), fl(lil[d]), fl(lfl[d]), state)))
        if need_ctx:
            outs_c.append(fl(mlstm_chunkwise(fl(qc), fl(kc), fl(vc), fl(lic[d]), fl(lfc[d]), mlstm_zero_state(qc.shape[0]))))
    y_l = finish(outs_l[0] + outs_l[1], pl[3])
    y_c = finish(outs_c[0] + outs_c[1], pc[3]) if need_ctx else None
    return y_c, y_l


def hgrn2_final_state(k, v, log_f):
    g_cum = jnp.cumsum(log_f, axis=2)
    return jnp.einsum('bhsd,bhse->bhde', k * jnp.exp(g_cum[:, :, -1:] - g_cum), v)


def hgrn2_chunkwise(q, k, v, log_f, state):
    tril = jnp.tril(jnp.ones((CHUNK, CHUNK), bool))[:, :, None]

    def step(s_st, inp):
        qc, kc, vc, gc = inp
        g_cum = jnp.cumsum(gc, axis=2)
        diff = g_cum[:, :, :, None, :] - g_cum[:, :, None, :, :]
        dec = jnp.exp(jnp.where(tril, diff, -jnp.inf))
        att = jnp.einsum('bhtd,bhsd,bhtsd->bhts', qc, kc, dec)
        o = jnp.einsum('bhts,bhse->bhte', att, vc) + jnp.einsum('bhtd,bhde->bhte', qc * jnp.exp(g_cum), s_st)
        g_last = g_cum[:, :, -1:]
        s_new = jnp.exp(g_last[:, :, 0])[..., None] * s_st + jnp.einsum('bhsd,bhse->bhde', kc * jnp.exp(g_last - g_cum), vc)
        return s_new, o

    _, o = lax.scan(step, state, tuple(to_chunks(t) for t in (q, k, v, log_f)))
    return from_chunks(o)


def hgrn2_branch(pc, pl, lb, norm_g, need_ctx):
    lbh = lb.reshape(HG_HEADS, 1, HG_DK)

    def prep(q, f_fwd, f_bwd, i):
        qh = to_heads(jax.nn.silu(q.astype(jnp.float32)), HG_HEADS)
        vh = to_heads(i.astype(jnp.float32), HG_HEADS)
        log_f = [jnp.logaddexp(jnp.log(lbh), jnp.log1p(-lbh) + jax.nn.log_sigmoid(to_heads(z.astype(jnp.float32), HG_HEADS)))
                 for z in (f_fwd, f_bwd)]
        return qh, vh, log_f, [-jnp.expm1(lf) for lf in log_f]

    def finish(o, g):
        return (head_rms(o, norm_g) * jax.nn.silu(g.astype(jnp.float32))).astype(g.dtype)

    qc, vc, lfc, kc = prep(pc[0], pc[1], pc[2], pc[3])
    ql, vl, lfl, kl = prep(pl[0], pl[1], pl[2], pl[3])
    outs_l, outs_c = [], []
    for d in range(2):
        fl = FLIPS[d]
        state = hgrn2_final_state(fl(kc[d]), fl(vc), fl(lfc[d]))
        outs_l.append(fl(hgrn2_chunkwise(fl(ql), fl(kl[d]), fl(vl), fl(lfl[d]), state)))
        if need_ctx:
            zero = jnp.zeros((qc.shape[0], HG_HEADS, HG_DK, HG_DV), jnp.float32)
            outs_c.append(fl(hgrn2_chunkwise(fl(qc), fl(kc[d]), fl(vc), fl(lfc[d]), zero)))
    y_l = finish(outs_l[0] + outs_l[1], pl[4])
    y_c = finish(outs_c[0] + outs_c[1], pc[4]) if need_ctx else None
    return y_c, y_l


def token_mixing(hc, hl, w_in, qg, kg, conv_w, gate_b, ml_g, lb, hg_g, w_branch, w_out, cos, sin, need_ctx):
    pc = split_cols(hc @ w_in)
    pl = split_cols(hl @ w_in)
    ya_c, ya_l = attention_branch(pc[0:3], pl[0:3], qg, kg, cos, sin, need_ctx)
    ym_c, ym_l = mlstm_branch(pc[3:8], pl[3:8], conv_w, gate_b, ml_g, need_ctx)
    yh_c, yh_l = hgrn2_branch(pc[8:13], pl[8:13], lb, hg_g, need_ctx)

    def merge(ys, gate_cols):
        proj = jnp.einsum('btnc,ncd->btnd', jnp.stack(ys, axis=-2), w_branch)
        gates = jax.nn.sigmoid(gate_cols).reshape(proj.shape)
        return jnp.sum(gates * proj, axis=-2) @ w_out

    y_l = merge((ya_l, ym_l, yh_l), pl[13])
    y_c = merge((ya_c, ym_c, yh_c), pc[13]) if need_ctx else None
    return y_c, y_l


def swiglu(h, wg, wu, wd):
    return (jax.nn.silu(h @ wg) * (h @ wu)) @ wd


def moe_ffn(h, w_router, wg, wu, wd):
    logits = (h @ w_router).astype(jnp.float32)
    top_v, top_i = lax.top_k(logits, TOP_K)
    top_w = jax.nn.softmax(top_v, axis=-1)
    gate = jnp.sum(top_w[..., None] * jax.nn.one_hot(top_i, N_EXPERTS, dtype=jnp.float32), axis=-2).astype(h.dtype)
    out = jnp.zeros_like(h)
    for e in range(N_EXPERTS):
        out = out + gate[..., e:e + 1] * swiglu(h, wg[e], wu[e], wd[e])
    return out


def modulation(cvec, w, b):
    return [m[:, None, :] for m in jnp.split(jax.nn.silu(cvec) @ w + b, N_MOD, axis=-1)]


def setup_inputs(seed: int = 0) -> dict:
    key = jax.random.key(seed)
    ks = iter(jax.random.split(key, 32))
    f32 = jnp.float32
    n_dense = (DEPTH + 1) // 2
    n_moe = DEPTH // 2

    def nrm(shape, fan_in, s=1.0):
        return jax.random.normal(next(ks), shape, f32) * (s * fan_in ** -0.5)

    def gain(shape):
        return 1.0 + 0.05 * jax.random.normal(next(ks), shape, f32)

    ml_gate_b = jnp.concatenate([0.1 * jax.random.normal(next(ks), (DEPTH, 2 * ML_HEADS), f32),
                                 3.0 + 3.0 * jax.random.uniform(next(ks), (DEPTH, 2 * ML_HEADS), f32)], axis=-1)
    return {
        'x': jax.random.normal(next(ks), (BATCH, SEQ, D_MODEL), f32),
        'c': jax.random.normal(next(ks), (BATCH, D_MODEL), f32),
        'ctx': jax.random.normal(next(ks), (BATCH, CTX_LEN, D_MODEL), f32),
        'c_ctx': jax.random.normal(next(ks), (D_MODEL,), f32),
        'w_mod': nrm((DEPTH, D_MODEL, N_MOD * D_MODEL), D_MODEL, 0.5),
        'b_mod': 0.02 * jax.random.normal(next(ks), (DEPTH, N_MOD * D_MODEL), f32),
        'norm1_g': gain((DEPTH, D_MODEL)),
        'norm2_g': gain((DEPTH, D_MODEL)),
        'w_in': nrm((DEPTH, D_MODEL, N_IN), D_MODEL),
        'attn_q_norm_g': gain((DEPTH, HEAD_DIM)),
        'attn_k_norm_g': gain((DEPTH, HEAD_DIM)),
        'ml_conv_w': nrm((DEPTH, CONV_W, 2 * ML_W), CONV_W),
        'ml_gate_b': ml_gate_b,
        'ml_norm_g': gain((DEPTH, ML_W)),
        'hg_lb_logits': 0.5 * jax.random.normal(next(ks), (DEPTH, HG_HEADS * HG_DK), f32),
        'hg_norm_g': gain((DEPTH, HG_W)),
        'w_branch': nrm((DEPTH, N_BRANCH, BRANCH_W, D_MODEL), BRANCH_W),
        'w_out': nrm((DEPTH, D_MODEL, D_MODEL), D_MODEL),
        'ffn_w_gate': nrm((n_dense, D_MODEL, D_FF), D_MODEL),
        'ffn_w_up': nrm((n_dense, D_MODEL, D_FF), D_MODEL),
        'ffn_w_down': nrm((n_dense, D_FF, D_MODEL), D_FF),
        'moe_w_router': nrm((n_moe, D_MODEL, N_EXPERTS), D_MODEL),
        'moe_w_gate': nrm((n_moe, N_EXPERTS, D_MODEL, D_FF), D_MODEL),
        'moe_w_up': nrm((n_moe, N_EXPERTS, D_MODEL, D_FF), D_MODEL),
        'moe_w_down': nrm((n_moe, N_EXPERTS, D_FF, D_MODEL), D_FF),
    }


def reference(x, c, ctx, c_ctx, w_mod, b_mod, norm1_g, norm2_g, w_in, attn_q_norm_g, attn_k_norm_g, ml_conv_w,
              ml_gate_b, ml_norm_g, hg_lb_logits, hg_norm_g, w_branch, w_out, ffn_w_gate, ffn_w_up, ffn_w_down,
              moe_w_router, moe_w_gate, moe_w_up, moe_w_down):
    cos, sin = axial_rope_tables(x.shape[1], x.dtype)
    lb_all = jnp.cumsum(jax.nn.softmax(hg_lb_logits.astype(jnp.float32), axis=0), axis=0)
    lb_all = lb_all - lb_all[:1]
    for l in range(DEPTH):
        need_ctx = l < DEPTH - 1
        ml = modulation(c, w_mod[l], b_mod[l])
        mc = modulation(c_ctx[None], w_mod[l], b_mod[l])
        hl = rms_norm(x, norm1_g[l]) * (1 + ml[1]) + ml[0]
        hc = rms_norm(ctx, norm1_g[l]) * (1 + mc[1]) + mc[0]
        y_c, y_l = token_mixing(hc, hl, w_in[l], attn_q_norm_g[l], attn_k_norm_g[l], ml_conv_w[l], ml_gate_b[l],
                                ml_norm_g[l], lb_all[l], hg_norm_g[l], w_branch[l], w_out[l], cos, sin, need_ctx)
        x = x + ml[2] * y_l
        if l % 2 == 0:
            ffn = lambda h: swiglu(h, ffn_w_gate[l // 2], ffn_w_up[l // 2], ffn_w_down[l // 2])
        else:
            ffn = lambda h: moe_ffn(h, moe_w_router[l // 2], moe_w_gate[l // 2], moe_w_up[l // 2], moe_w_down[l // 2])
        x = x + ml[5] * ffn(rms_norm(x, norm2_g[l]) * (1 + ml[4]) + ml[3])
        if need_ctx:
            ctx = ctx + mc[2] * y_c
            ctx = ctx + mc[5] * ffn(rms_norm(ctx, norm2_g[l]) * (1 + mc[4]) + mc[3])
    return x
```

```cpp
#ifdef HOST_EMU
#include "emu.h"
#define DEV inline
#define WAVE_LDS_SYNC() emu::wave_barrier()
#define MFMA32(a, b, c) emu_mfma_32x32x16_bf16((a), (b), (c))
#define LDS_BASE() EMU_LDS_BASE()
#else
#include <hip/hip_runtime.h>
#include <cstdio>
#define DEV __device__ __forceinline__
#define WAVE_LDS_SYNC() asm volatile("s_waitcnt lgkmcnt(0)" ::: "memory")
#define MFMA32(a, b, c) __builtin_amdgcn_mfma_f32_32x32x16_bf16((a), (b), (c), 0, 0, 0)
typedef short bf16x8 __attribute__((ext_vector_type(8)));
typedef float f32x16 __attribute__((ext_vector_type(16)));
typedef float f32x4 __attribute__((ext_vector_type(4)));
#endif
typedef unsigned short bf16_t;
typedef unsigned u32x4 __attribute__((ext_vector_type(4)));
typedef unsigned u32x2 __attribute__((ext_vector_type(2)));
typedef float f32x2 __attribute__((ext_vector_type(2)));

#ifdef SMALL_CFG
constexpr int D = 512, NB = 2, TL = 256, TC = 256, AH = 4, AKV = 2, MLH = 2, HGH = 4, DFF = 768;
#else
constexpr int D = 2048, NB = 2, TL = 4096, TC = 256, AH = 8, AKV = 2, MLH = 4, HGH = 8, DFF = 5632;
#endif
constexpr int DEPTH = 2, GRIDW = 64, HD = 128, ATT_W = AH * HD, KV_W = AKV * HD, MDK = 256, MDV = 256, ML_W = MLH * MDV, HDK = 128, HDV = 128, HG_W = HGH * HDV;
constexpr int BW = ATT_W, NE = 8, CH = 64, NV = NB + 1;
constexpr float EPS = 1e-6f;
constexpr int MLAT = NB * TL, MCTX = NB * TC, MT = MLAT + MCTX, TT = TC + TL, NCH = TT / CH, NCHC = TC / CH;
constexpr int NG = 4 * MLH;
static_assert(ML_W == BW && HG_W == BW && NG <= 16 && TC % 256 == 0 && TL % 256 == 0 && D % 256 == 0 && DFF % 128 == 0, "config");
constexpr int OQ = 0, OK_ = OQ + ATT_W, OV = OK_ + KV_W, OMQ = OV + KV_W, OMK = OMQ + ML_W, OMV = OMK + ML_W, OMO = OMV + ML_W, OMG = OMO + ML_W;
constexpr int OHQ = OMG + NG, OHF = OHQ + HG_W, OHB = OHF + HG_W, OHI = OHB + HG_W, OHG = OHI + HG_W, OGATE = OHG + HG_W, N_IN = OGATE + 3 * D;
constexpr int PQ = OQ, PK = OK_, PV = OV, PMQ = OMQ, PMK = OMK, PMV = OMV, PMO = OMO, PHQ = OMG, PHF = PHQ + HG_W, PHB = PHF + HG_W, PHI = PHB + HG_W, PHG = PHI + HG_W, PGATE = PHG + HG_W;
constexpr int NPB = N_IN - NG, NP = NPB + 256;
static_assert(NPB % 256 == 0 && PGATE + 3 * D == NPB, "projection layout");
constexpr int MOE_ROWS = MLAT * 2 + NE * 256, MOE_PANELS = MOE_ROWS / 256;
constexpr int NSQM = NB * MLH * 2, NSQH = NB * HGH * 2;

constexpr size_t al256(size_t x) { return (x + 255) / 256 * 256; }
constexpr size_t WS_CTL = 0, CTL_BYTES = 1u << 20;
constexpr size_t WS_MODP = WS_CTL + CTL_BYTES;
constexpr size_t WS_MOD = WS_MODP + al256((size_t)(D / 64) * DEPTH * NV * 6 * D * 4);
constexpr size_t WS_LB = WS_MOD + al256((size_t)DEPTH * NV * 6 * D * 4);
constexpr size_t WS_WIN = WS_LB + al256((size_t)DEPTH * HG_W * 4);
constexpr size_t WS_WBR = WS_WIN + al256((size_t)DEPTH * NP * D * 2);
constexpr size_t WS_WOUT = WS_WBR + al256((size_t)DEPTH * 3 * D * BW * 2);
constexpr size_t WS_WGU = WS_WOUT + al256((size_t)DEPTH * D * D * 2);
constexpr size_t WS_WDN = WS_WGU + al256((size_t)2 * DFF * D * 2);
constexpr size_t WS_WMGU = WS_WDN + al256((size_t)D * DFF * 2);
constexpr size_t WS_WMDN = WS_WMGU + al256((size_t)NE * 2 * DFF * D * 2);
constexpr size_t WS_H = WS_WMDN + al256((size_t)NE * D * DFF * 2);
constexpr size_t WS_G16 = WS_H + al256((size_t)MT * D * 2);
constexpr size_t WS_QA = WS_G16 + al256((size_t)MT * 16 * 4);
constexpr size_t WS_KCAT = WS_QA + al256((size_t)MT * ATT_W * 2);
constexpr size_t WS_VCAT = WS_KCAT + al256((size_t)NB * TT * KV_W * 2);
constexpr size_t WS_QM = WS_VCAT + al256((size_t)NB * TT * KV_W * 2);
constexpr size_t WS_KM = WS_QM + al256((size_t)MT * ML_W * 2);
constexpr size_t WS_Y = WS_KM + al256((size_t)MT * ML_W * 2);
constexpr size_t WS_MGF = WS_Y + al256((size_t)3 * MT * BW * 2);
constexpr size_t WS_MG = WS_MGF + al256((size_t)MT * D * 4);
constexpr size_t WS_X1 = WS_MG + al256((size_t)MT * D * 2);
constexpr size_t WS_X2 = WS_X1 + al256((size_t)MT * D * 4);
constexpr size_t WS_SMALL = WS_X2 + al256((size_t)MT * D * 4);
constexpr size_t SM_FL = 0;
constexpr size_t SM_MLOC = SM_FL + al256((size_t)NSQM * NCH * 4);
constexpr size_t SM_MST = SM_MLOC + al256((size_t)NSQM * NCH * 4);
constexpr size_t SM_NLOC = SM_MST + al256((size_t)NSQM * NCH * 4);
constexpr size_t SM_LAM = SM_NLOC + al256((size_t)NSQM * NCH * MDK * 4);
constexpr size_t SM_TE = SM_LAM + al256((size_t)NSQH * NCH * HDK * 4);
constexpr size_t SM_TW = SM_TE + al256((size_t)MLAT * 2 * 4);
constexpr size_t SM_TP = SM_TW + al256((size_t)MLAT * 2 * 4);
constexpr size_t SM_RTOK = SM_TP + al256((size_t)MLAT * 2 * 4);
constexpr size_t SM_RW = SM_RTOK + al256((size_t)MOE_ROWS * 4);
constexpr size_t SM_RSLOT = SM_RW + al256((size_t)MOE_ROWS * 4);
constexpr size_t SM_END = SM_RSLOT + al256((size_t)MOE_ROWS * 4);
constexpr size_t WS_BIG = WS_SMALL + SM_END;
constexpr size_t WS_P = WS_BIG;
constexpr size_t WS_ACT = WS_BIG;
constexpr size_t WS_APERM = WS_ACT + al256((size_t)MOE_ROWS * DFF * 2);
constexpr size_t BIG_BYTES = al256((size_t)MT * NPB * 2) > al256((size_t)MOE_ROWS * DFF * 2) + al256((size_t)MOE_ROWS * D * 2) ? al256((size_t)MT * NPB * 2) : al256((size_t)MOE_ROWS * DFF * 2) + al256((size_t)MOE_ROWS * D * 2);
constexpr size_t WS_ST = WS_BIG + BIG_BYTES;
constexpr size_t WS_CSTM = WS_ST;
constexpr size_t WS_CSTH = WS_CSTM + al256((size_t)NSQM * NCH * MDV * MDK * 2);
constexpr size_t WS_YS = WS_ST;
constexpr size_t ST_BYTES = al256((size_t)NSQM * NCH * MDV * MDK * 2) + al256((size_t)NSQH * NCH * HDV * HDK * 2) > al256((size_t)2 * MLAT * D * 4) ? al256((size_t)NSQM * NCH * MDV * MDK * 2) + al256((size_t)NSQH * NCH * HDV * HDK * 2) : al256((size_t)2 * MLAT * D * 4);
constexpr size_t WS_END = WS_ST + ST_BYTES;
constexpr int CW_BAR = 4096;
constexpr int CW_CNT = 1024;

constexpr int NTHREADS = 512, NWAVES = 8;
constexpr int LDS_BYTES = 147456;

struct Params {
    const float *x, *c, *ctx, *c_ctx, *w_mod, *b_mod, *norm1_g, *norm2_g, *w_in, *qn_g, *kn_g, *conv_w, *gate_b, *ml_norm_g, *lb_logits, *hg_norm_g,
        *w_branch, *w_out, *ffn_wg, *ffn_wu, *ffn_wd, *moe_wr, *moe_wg, *moe_wu, *moe_wd;
    float* out; unsigned char* ws;
};

DEV unsigned fbits(float f) { return __builtin_bit_cast(unsigned, f); }
DEV float bitsf(unsigned u) { return __builtin_bit_cast(float, u); }
DEV float bf2f(bf16_t h) { return bitsf(((unsigned)h) << 16); }
DEV unsigned f2bf(float f) { const unsigned u = fbits(f); return (u + 0x7fffu + ((u >> 16) & 1u)) >> 16; }
DEV unsigned pk2(float lo, float hi) { return f2bf(lo) | (f2bf(hi) << 16); }
#ifdef HOST_EMU
DEV float fexp(float x) { return expf(x); }
#else
DEV float fexp(float x) { return __builtin_amdgcn_exp2f(x * 1.4426950408889634f); }
#endif
DEV float sigmoidf_(float x) { return 1.0f / (1.0f + expf(-x)); }
DEV float siluf_(float x) { return x * sigmoidf_(x); }
DEV float logsigmoidf_(float x) { return fminf(x, 0.f) - log1pf(expf(-fabsf(x))); }
DEV float wave_sum(float v) {
#pragma unroll
    for (int o = 1; o < 64; o <<= 1) v += __shfl_xor(v, o);
    return v;
}
DEV int crow(int r, int hi) { return (r & 3) + 8 * (r >> 2) + 4 * hi; }
DEV void unpack8(const u32x4 w, float (&f)[8]) {
    f[0] = bitsf(w.x << 16); f[1] = bitsf(w.x & 0xffff0000u); f[2] = bitsf(w.y << 16); f[3] = bitsf(w.y & 0xffff0000u);
    f[4] = bitsf(w.z << 16); f[5] = bitsf(w.z & 0xffff0000u); f[6] = bitsf(w.w << 16); f[7] = bitsf(w.w & 0xffff0000u);
}
DEV u32x4 pack8(const float (&f)[8]) { u32x4 w; w.x = pk2(f[0], f[1]); w.y = pk2(f[2], f[3]); w.z = pk2(f[4], f[5]); w.w = pk2(f[6], f[7]); return w; }
DEV int lat_row(int b, int t) { return b * TL + t; }
DEV int ctx_row(int b, int t) { return MLAT + b * TC + t; }
DEV int seq_row(int b, int d, int p) {
    if (p < TC) return ctx_row(b, d ? TC - 1 - p : p);
    const int t = p - TC; return lat_row(b, d ? TL - 1 - t : t);
}
DEV int dir_chunk(int cc, int d) { if (!d) return cc; return cc < NCHC ? NCHC - 1 - cc : NCH - 1 - (cc - NCHC); }
DEV int chunk_row0(int b, int cc) { return cc < NCHC ? ctx_row(b, cc * CH) : lat_row(b, (cc - NCHC) * CH); }
DEV int row_vec(int row) { return row < MLAT ? row / TL : NB; }

#ifdef HOST_EMU
DEV int opaque_tid() { return threadIdx.x; }
#else
DEV int opaque_tid() { int t = threadIdx.x; asm volatile("" : "+v"(t)); return t; }
#endif
struct Ctx {
    int tid, lane, wave, gw, ngw, bid, nblk; unsigned char* lds;
};
DEV Ctx make_ctx(unsigned char* lds) {
    Ctx c; c.tid = opaque_tid(); c.lane = c.tid & 63; c.wave = c.tid >> 6; c.bid = blockIdx.x; c.nblk = gridDim.x; c.gw = c.bid * NWAVES + c.wave; c.ngw = c.nblk * NWAVES; c.lds = lds; return c;
}
#define WSP(T, off) ((T*)(P.ws + (off)))

struct Job { const float* src; int K, ld, c0, nc; bf16_t* dst; int r0, mode; };
constexpr int NJOBS = DEPTH * 6 + 3 + NE * 3;
DEV Job get_job(const Params& P, int j) {
    Job J; J.mode = 0; J.r0 = 0; J.c0 = 0;
    if (j < DEPTH * 6) {
        const int l = j / 6, k = j % 6;
        if (k == 0) { J.src = P.w_in + (size_t)l * D * N_IN; J.K = D; J.ld = N_IN; J.c0 = 0; J.nc = OMG; J.dst = WSP(bf16_t, WS_WIN) + (size_t)l * NP * D; J.r0 = 0; }
        else if (k == 1) { J.src = P.w_in + (size_t)l * D * N_IN; J.K = D; J.ld = N_IN; J.c0 = OMG + NG; J.nc = N_IN - OMG - NG; J.dst = WSP(bf16_t, WS_WIN) + (size_t)l * NP * D; J.r0 = OMG; }
        else if (k < 5) { const int n = k - 2; J.src = P.w_branch + (size_t)(l * 3 + n) * BW * D; J.K = BW; J.ld = D; J.nc = D; J.dst = WSP(bf16_t, WS_WBR) + (size_t)(l * 3 + n) * D * BW; }
        else { J.src = P.w_out + (size_t)l * D * D; J.K = D; J.ld = D; J.nc = D; J.dst = WSP(bf16_t, WS_WOUT) + (size_t)l * D * D; }
        return J;
    }
    j -= DEPTH * 6;
    if (j < 3) {
        if (j == 0) { J.src = P.ffn_wg; J.K = D; J.ld = DFF; J.nc = DFF; J.dst = WSP(bf16_t, WS_WGU); J.r0 = 0; J.mode = 1; }
        else if (j == 1) { J.src = P.ffn_wu; J.K = D; J.ld = DFF; J.nc = DFF; J.dst = WSP(bf16_t, WS_WGU); J.r0 = 128; J.mode = 1; }
        else { J.src = P.ffn_wd; J.K = DFF; J.ld = D; J.nc = D; J.dst = WSP(bf16_t, WS_WDN); }
        return J;
    }
    j -= 3; const int e = j / 3, k = j % 3;
    if (k == 0) { J.src = P.moe_wg + (size_t)e * D * DFF; J.K = D; J.ld = DFF; J.nc = DFF; J.dst = WSP(bf16_t, WS_WMGU) + (size_t)e * 2 * DFF * D; J.r0 = 0; J.mode = 1; }
    else if (k == 1) { J.src = P.moe_wu + (size_t)e * D * DFF; J.K = D; J.ld = DFF; J.nc = DFF; J.dst = WSP(bf16_t, WS_WMGU) + (size_t)e * 2 * DFF * D; J.r0 = 128; J.mode = 1; }
    else { J.src = P.moe_wd + (size_t)e * DFF * D; J.K = DFF; J.ld = D; J.nc = D; J.dst = WSP(bf16_t, WS_WMDN) + (size_t)e * D * DFF; }
    return J;
}
DEV int job_items(const Job& J) { return (J.K / 64) * (J.nc / 32); }
DEV void transpose_item(const Job& J, int item, float* scr, int lane) {
    const int nblk = J.nc / 32, kb = item / nblk, nb = item % nblk, k0 = 64 * kb, n0 = 32 * nb;
#pragma unroll 8
    for (int i = 0; i < 32; ++i) { const int kk = 2 * i + (lane >> 5); scr[kk * 33 + (lane & 31)] = J.src[(size_t)(k0 + kk) * J.ld + J.c0 + n0 + (lane & 31)]; }
    WAVE_LDS_SYNC();
    const int c = lane & 7;
#pragma unroll
    for (int jj = 0; jj < 4; ++jj) { const int n = (lane >> 3) + 8 * jj; const float* s = scr + (8 * c) * 33 + n; const int nn = n0 + n;
        u32x4 o; o.x = pk2(s[0 * 33], s[1 * 33]); o.y = pk2(s[2 * 33], s[3 * 33]); o.z = pk2(s[4 * 33], s[5 * 33]); o.w = pk2(s[6 * 33], s[7 * 33]);
        const int row = J.mode ? J.r0 + 256 * (nn / 128) + (nn % 128) : J.r0 + nn;
        *(u32x4*)(J.dst + (size_t)row * J.K + k0 + 8 * c) = o; }
    WAVE_LDS_SYNC();
}
DEV void phase_weights(const Params& P, const Ctx& C) {
    float* scr = (float*)(C.lds + C.wave * 16384);
    int total = 0;
    for (int j = 0; j < NJOBS; ++j) total += job_items(get_job(P, j));
    for (int it = C.gw; it < total; it += C.ngw) {
        int r = it, j = 0; Job J = get_job(P, 0);
        for (;;) { const int n = job_items(J); if (r < n) break; r -= n; ++j; J = get_job(P, j); }
        transpose_item(J, r, scr, C.lane);
    }
    const int gt = C.bid * NTHREADS + C.tid, ngt = C.nblk * NTHREADS;
    for (int i = gt; i < DEPTH * 256 * (D / 8); i += ngt) {
        const int l = i / (256 * (D / 8)), r = (i / (D / 8)) % 256, k8 = (i % (D / 8)) * 8;
        float f[8];
#pragma unroll
        for (int q = 0; q < 8; ++q) f[q] = r < NG ? P.w_in[((size_t)l * D + k8 + q) * N_IN + OMG + r] : 0.f;
        *(u32x4*)(WSP(bf16_t, WS_WIN) + ((size_t)l * NP + NPB + r) * D + k8) = pack8(f);
    }
}
DEV const float* cvec_ptr(const Params& P, int v) { return v < NB ? P.c + (size_t)v * D : P.c_ctx; }
DEV void phase_mod_partial(const Params& P, const Ctx& C) {
    constexpr int NCG = 6 * D / 256, NKS = D / 64;
    for (int it = C.gw; it < DEPTH * NKS * NCG; it += C.ngw) {
        const int cg = it % NCG, ks = (it / NCG) % NKS, l = it / (NCG * NKS), col = cg * 256 + C.lane * 4;
        f32x4 acc[NV];
#pragma unroll
        for (int v = 0; v < NV; ++v) acc[v] = (f32x4){0.f, 0.f, 0.f, 0.f};
        for (int k = ks * 64; k < ks * 64 + 64; ++k) {
            const f32x4 w = *(const f32x4*)(P.w_mod + ((size_t)l * D + k) * 6 * D + col);
#pragma unroll
            for (int v = 0; v < NV; ++v) { const float s = siluf_(cvec_ptr(P, v)[k]); acc[v] += w * s; }
        }
#pragma unroll
        for (int v = 0; v < NV; ++v) *(f32x4*)(WSP(float, WS_MODP) + (((size_t)ks * DEPTH + l) * NV + v) * 6 * D + col) = acc[v];
    }
}
DEV void phase_mod_final(const Params& P, const Ctx& C) {
    constexpr int NKS = D / 64;
    const int gt = C.bid * NTHREADS + C.tid, ngt = C.nblk * NTHREADS;
    for (int i = gt; i < DEPTH * NV * 6 * D; i += ngt) {
        const int col = i % (6 * D), v = (i / (6 * D)) % NV, l = i / (6 * D * NV);
        float s = P.b_mod[(size_t)l * 6 * D + col];
        for (int ks = 0; ks < NKS; ++ks) s += WSP(float, WS_MODP)[(((size_t)ks * DEPTH + l) * NV + v) * 6 * D + col];
        WSP(float, WS_MOD)[((size_t)l * NV + v) * 6 * D + col] = s;
    }
    for (int i = gt; i < HG_W; i += ngt) {
        float mx = -1e30f; for (int l = 0; l < DEPTH; ++l) mx = fmaxf(mx, P.lb_logits[(size_t)l * HG_W + i]);
        float den = 0.f; for (int l = 0; l < DEPTH; ++l) den += expf(P.lb_logits[(size_t)l * HG_W + i] - mx);
        float cum = 0.f;
        for (int l = 0; l < DEPTH; ++l) { if (l > 0) cum += expf(P.lb_logits[(size_t)l * HG_W + i] - mx) / den; WSP(float, WS_LB)[(size_t)l * HG_W + i] = cum; }
    }
}
DEV const float* mod_vec(const Params& P, int l, int v, int idx) { return WSP(float, WS_MOD) + ((size_t)l * NV + v) * 6 * D + (size_t)idx * D; }

DEV void phase_hpass(const Params& P, const Ctx& C, int l, int which, bool router) {
    constexpr int NJ = D / 256;
    const int nrows = (which == 1 && l == DEPTH - 1) ? MLAT : MT;
    const float* g = (which ? P.norm2_g : P.norm1_g) + (size_t)l * D;
    for (int row = C.gw; row < nrows; row += C.ngw) {
        const float* src;
        if (which) src = WSP(float, WS_X1) + (size_t)row * D;
        else if (l == 0) src = row < MLAT ? P.x + (size_t)row * D : P.ctx + (size_t)(row - MLAT) * D;
        else src = WSP(float, WS_X2) + (size_t)row * D;
        const int v = row_vec(row);
        const float* sh = mod_vec(P, l, v, which ? 3 : 0); const float* sc = mod_vec(P, l, v, which ? 4 : 1);
        f32x4 x[NJ]; float ss = 0.f;
#pragma unroll
        for (int j = 0; j < NJ; ++j) { x[j] = *(const f32x4*)(src + 256 * j + 4 * C.lane); ss += (x[j].x * x[j].x + x[j].y * x[j].y) + (x[j].z * x[j].z + x[j].w * x[j].w); }
        const float rstd = 1.0f / sqrtf(wave_sum(ss) * (1.0f / D) + EPS);
        float lg[NE];
#pragma unroll
        for (int e = 0; e < NE; ++e) lg[e] = 0.f;
#pragma unroll
        for (int j = 0; j < NJ; ++j) {
            const int col = 256 * j + 4 * C.lane;
            const f32x4 gg = *(const f32x4*)(g + col), s1 = *(const f32x4*)(sc + col), s0 = *(const f32x4*)(sh + col);
            f32x4 y = x[j] * rstd * gg * (s1 + 1.0f) + s0;
            u32x2 o; o.x = pk2(y.x, y.y); o.y = pk2(y.z, y.w);
            *(u32x2*)(WSP(bf16_t, WS_H) + (size_t)row * D + col) = o;
            if (router) {
                const float* wr = P.moe_wr + (size_t)(l / 2) * D * NE + (size_t)col * NE;
#pragma unroll
                for (int q = 0; q < 4; ++q)
#pragma unroll
                    for (int e = 0; e < NE; ++e) lg[e] += y[q] * wr[q * NE + e];
            }
        }
        if (router) {
#pragma unroll
            for (int e = 0; e < NE; ++e) lg[e] = wave_sum(lg[e]);
            if (C.lane == 0) {
                int i0 = 0; float v0 = lg[0];
#pragma unroll
                for (int e = 1; e < NE; ++e) if (lg[e] > v0) { v0 = lg[e]; i0 = e; }
                int i1 = -1; float v1 = -3.0e38f;
#pragma unroll
                for (int e = 0; e < NE; ++e) if (e != i0 && lg[e] > v1) { v1 = lg[e]; i1 = e; }
                const float w1 = 1.0f / (1.0f + expf(v0 - v1)), w0 = 1.0f - w1;
                int* te = WSP(int, WS_SMALL + SM_TE) + row * 2; float* tw = WSP(float, WS_SMALL + SM_TW) + row * 2; int* tp = WSP(int, WS_SMALL + SM_TP) + row * 2;
                unsigned* cnt = WSP(unsigned, WS_CTL) + CW_CNT;
                te[0] = i0; te[1] = i1; tw[0] = w0; tw[1] = w1;
                tp[0] = (int)atomicAdd(cnt + i0, 1u); tp[1] = (int)atomicAdd(cnt + i1, 1u);
            }
        }
    }
    if (router) {
        const int gt = C.bid * NTHREADS + C.tid, ngt = C.nblk * NTHREADS;
        for (int i = gt; i < MOE_ROWS; i += ngt) WSP(int, WS_SMALL + SM_RTOK)[i] = -1;
    }
}

DEV void phase_fixup(const Params& P, const Ctx& C, int l, bool need_ctx) {
    const bf16_t* Pb = WSP(bf16_t, WS_P);
    const float* qg = P.qn_g + (size_t)l * HD; const float* kg = P.kn_g + (size_t)l * HD;
    const float* cw = P.conv_w + (size_t)l * 3 * 2 * ML_W;
    const int lane = C.lane, jf = lane & 31;
    const float invf = expf(-logf(10000.0f) * (float)(2 * jf) / 64.0f);
    for (int row = C.gw; row < MT; row += C.ngw) {
        const bool lat = row < MLAT;
        const int b = lat ? row / TL : (row - MLAT) / TC, t = lat ? row % TL : (row - MLAT) % TC, tseg = lat ? TL : TC;
        const bf16_t* pr = Pb + (size_t)row * NPB;
        float c0 = 1.f, s0 = 0.f, c1 = 1.f, s1 = 0.f;
        if (lat) { const float a0 = (float)(t / GRIDW) * invf, a1 = (float)(t % GRIDW) * invf; c0 = cosf(a0); s0 = sinf(a0); c1 = cosf(a1); s1 = sinf(a1); }
        const int pos = lat ? TC + t : t;
        for (int hh = 0; hh < AH + AKV; ++hh) {
            const bool isq = hh < AH;
            if (isq && !lat && !need_ctx) continue;
            const int col = isq ? PQ + hh * HD : PK + (hh - AH) * HD;
            float e0 = bf2f(pr[col + lane]), e1 = bf2f(pr[col + 64 + lane]);
            const float r = 1.0f / sqrtf(wave_sum(e0 * e0 + e1 * e1) * (1.0f / HD) + EPS);
            const float* gg = isq ? qg : kg;
            e0 *= r * gg[lane]; e1 *= r * gg[64 + lane];
            if (lat) {
                const float p0 = __shfl_xor(e0, 32), p1 = __shfl_xor(e1, 32);
                e0 = lane < 32 ? e0 * c0 - p0 * s0 : e0 * c0 + p0 * s0;
                e1 = lane < 32 ? e1 * c1 - p1 * s1 : e1 * c1 + p1 * s1;
            }
            bf16_t* dst = isq ? WSP(bf16_t, WS_QA) + (size_t)row * ATT_W + hh * HD : WSP(bf16_t, WS_KCAT) + ((size_t)b * TT + pos) * KV_W + (hh - AH) * HD;
            dst[lane] = (bf16_t)f2bf(e0); dst[64 + lane] = (bf16_t)f2bf(e1);
        }
        for (int cidx = lane * 4; cidx < KV_W; cidx += 256) *(u32x2*)(WSP(bf16_t, WS_VCAT) + ((size_t)b * TT + pos) * KV_W + cidx) = *(const u32x2*)(pr + PV + cidx);
        for (int cidx = lane * 8; cidx < 2 * ML_W; cidx += 512) {
            const bool isk = cidx >= ML_W; const int pc = isk ? PMK + (cidx - ML_W) : PMQ + cidx;
            float xm[8], x0[8], xp[8], o[8];
            unpack8(*(const u32x4*)(pr + pc), x0);
            if (t > 0) unpack8(*(const u32x4*)(pr - NPB + pc), xm); else { for (int q = 0; q < 8; ++q) xm[q] = 0.f; }
            if (t + 1 < tseg) unpack8(*(const u32x4*)(pr + NPB + pc), xp); else { for (int q = 0; q < 8; ++q) xp[q] = 0.f; }
            const float sc = isk ? 0.0625f : 1.0f;
#pragma unroll
            for (int q = 0; q < 8; ++q) o[q] = (xm[q] * cw[cidx + q] + x0[q] * cw[2 * ML_W + cidx + q] + xp[q] * cw[4 * ML_W + cidx + q]) * sc;
            bf16_t* dst = (isk ? WSP(bf16_t, WS_KM) + (size_t)row * ML_W + (cidx - ML_W) : WSP(bf16_t, WS_QM) + (size_t)row * ML_W + cidx);
            *(u32x4*)dst = pack8(o);
        }
    }
}

constexpr int MQP = MDK + 8, CP = CH + 8;
DEV void mlstm_s1_unit(const Params& P, const Ctx& C0, int l, int u) {
    const Ctx C = make_ctx(C0.lds);
    const int c = u % NCH, sq = u / NCH, d = sq & 1, h = (sq >> 1) % MLH, b = sq / (2 * MLH);
    bf16_t* KT = (bf16_t*)C.lds;
    bf16_t* VT = KT + MDK * CP;
    float* vec = (float*)(VT + MDV * CP);
    float* lf = vec, *li = vec + 64, *wsv = vec + 128;
    const float* G16 = WSP(float, WS_G16); const float* gb = P.gate_b + (size_t)l * NG;
    if (C.tid < CH) {
        const int row = seq_row(b, d, c * CH + C.tid);
        li[C.tid] = G16[(size_t)row * 16 + d * MLH + h] + gb[d * MLH + h];
        lf[C.tid] = logsigmoidf_(G16[(size_t)row * 16 + (2 + d) * MLH + h] + gb[(2 + d) * MLH + h]);
    }
    __syncthreads();
    if (C.tid == 0) {
        float fc = 0.f, tot = 0.f; for (int j = 0; j < CH; ++j) tot += lf[j];
        float mx = -3.0e38f;
        for (int j = 0; j < CH; ++j) { fc += lf[j]; const float gj = tot - fc + li[j]; wsv[j] = gj; mx = fmaxf(mx, gj); }
        for (int j = 0; j < CH; ++j) wsv[j] = expf(wsv[j] - mx);
        WSP(float, WS_SMALL + SM_FL)[sq * NCH + c] = tot; WSP(float, WS_SMALL + SM_MLOC)[sq * NCH + c] = mx;
    }
    __syncthreads();
    for (int i = C.tid; i < CH * (MDK / 8); i += NTHREADS) {
        const int s = i / (MDK / 8), cg = i % (MDK / 8), row = seq_row(b, d, c * CH + s);
        float kk[8], vv[8];
        unpack8(*(const u32x4*)(WSP(bf16_t, WS_KM) + (size_t)row * ML_W + h * MDK + cg * 8), kk);
        unpack8(*(const u32x4*)(WSP(bf16_t, WS_P) + (size_t)row * NPB + PMV + h * MDV + cg * 8), vv);
        const float w = wsv[s];
#pragma unroll
        for (int q = 0; q < 8; ++q) { KT[(cg * 8 + q) * CP + s] = (bf16_t)f2bf(kk[q]); VT[(cg * 8 + q) * CP + s] = (bf16_t)f2bf(vv[q] * w); }
    }
    __syncthreads();
    const int r32 = C.lane & 31, hi = C.lane >> 5, w = C.wave;
    f32x16 acc[8];
#pragma unroll
    for (int nb = 0; nb < 8; ++nb) acc[nb] = (f32x16){0};
#pragma unroll
    for (int ks = 0; ks < CH / 16; ++ks) {
        const bf16x8 a = *(const bf16x8*)(VT + (32 * w + r32) * CP + 16 * ks + 8 * hi);
#pragma unroll
        for (int nb = 0; nb < 8; ++nb) { const bf16x8 bb = *(const bf16x8*)(KT + (32 * nb + r32) * CP + 16 * ks + 8 * hi); acc[nb] = MFMA32(a, bb, acc[nb]); }
    }
    bf16_t* out = WSP(bf16_t, WS_CSTM) + ((size_t)sq * NCH + c) * MDV * MDK;
#pragma unroll
    for (int nb = 0; nb < 8; ++nb)
#pragma unroll
        for (int r = 0; r < 16; ++r) out[(size_t)(32 * w + crow(r, hi)) * MDK + 32 * nb + r32] = (bf16_t)f2bf(acc[nb][r]);
    if (C.tid < MDK) { float s = 0.f; for (int j = 0; j < CH; ++j) s += wsv[j] * bf2f(KT[C.tid * CP + j]); WSP(float, WS_SMALL + SM_NLOC)[((size_t)sq * NCH + c) * MDK + C.tid] = s; }
    __syncthreads();
}
DEV void mlstm_s2(const Params& P, const Ctx& C) {
    const int gt = C.bid * NTHREADS + C.tid, ngt = C.nblk * NTHREADS;
    constexpr int NG8 = MDV * MDK / 8;
    const float* FL = WSP(float, WS_SMALL + SM_FL); const float* MLOC = WSP(float, WS_SMALL + SM_MLOC);
    for (int i = gt; i < NSQM * NG8; i += ngt) {
        const int sq = i / NG8, g8 = i % NG8; float run[8];
#pragma unroll
        for (int q = 0; q < 8; ++q) run[q] = 0.f;
        float m_run = -1e30f;
        u32x4* p = (u32x4*)(WSP(bf16_t, WS_CSTM) + (size_t)sq * NCH * MDV * MDK + (size_t)g8 * 8);
        for (int c = 0; c < NCH; ++c) {
            float kl[8]; unpack8(p[(size_t)c * NG8], kl);
            p[(size_t)c * NG8] = pack8(run);
            const float fl = FL[sq * NCH + c], ml = MLOC[sq * NCH + c], mn = fmaxf(fl + m_run, ml), dec = expf(fl + m_run - mn), sl = expf(ml - mn);
#pragma unroll
            for (int q = 0; q < 8; ++q) run[q] = dec * run[q] + sl * kl[q];
            m_run = mn;
        }
    }
    for (int i = gt; i < NSQM * MDK; i += ngt) {
        const int sq = i / MDK, dk = i % MDK; float run = 0.f, m_run = -1e30f;
        float* p = WSP(float, WS_SMALL + SM_NLOC) + (size_t)sq * NCH * MDK + dk;
        for (int c = 0; c < NCH; ++c) {
            const float nl = p[(size_t)c * MDK]; p[(size_t)c * MDK] = run;
            const float fl = FL[sq * NCH + c], ml = MLOC[sq * NCH + c], mn = fmaxf(fl + m_run, ml), dec = expf(fl + m_run - mn), sl = expf(ml - mn);
            run = dec * run + sl * nl;
            if (dk == 0) WSP(float, WS_SMALL + SM_MST)[sq * NCH + c] = m_run;
            m_run = mn;
        }
    }
}
DEV void mlstm_s3_unit(const Params& P, const Ctx& C0, int l, int u) {
    const Ctx C = make_ctx(C0.lds);
    const int cc = u % NCH, h = (u / NCH) % MLH, b = u / (NCH * MLH);
    const int row0 = chunk_row0(b, cc);
    bf16_t* Qs = (bf16_t*)C.lds;
    bf16_t* Ks = Qs + CH * MQP;
    bf16_t* VT = Ks + CH * MQP;
    bf16_t* SC = VT + MDV * CP;
    float* vec = (float*)(SC + 2 * CH * CP);
    float* lfv = vec;
    float* liv = vec + 128;
    float* fcv = vec + 256;
    float* mtv = vec + 384;
    float* av = vec + 512;
    float* qnv = vec + 640;
    float* rinv = vec + 768;
    float* mst = vec + 896;
    float* HS = (float*)C.lds;
    const float* G16 = WSP(float, WS_G16); const float* gb = P.gate_b + (size_t)l * NG;
    const int sq0 = (b * MLH + h) * 2, c0 = dir_chunk(cc, 0), c1 = dir_chunk(cc, 1);
    if (C.tid < 2 * CH) {
        const int d = C.tid >> 6, j = C.tid & 63, row = row0 + j;
        liv[C.tid] = G16[(size_t)row * 16 + d * MLH + h] + gb[d * MLH + h];
        lfv[C.tid] = logsigmoidf_(G16[(size_t)row * 16 + (2 + d) * MLH + h] + gb[(2 + d) * MLH + h]);
        if (j == 0) mst[d] = WSP(float, WS_SMALL + SM_MST)[(sq0 + d) * NCH + (d ? c1 : c0)];
    }
    for (int i = C.tid; i < CH * (MDK / 8); i += NTHREADS) {
        const int s = i / (MDK / 8), cg = i % (MDK / 8), row = row0 + s;
        *(u32x4*)(Qs + s * MQP + cg * 8) = *(const u32x4*)(WSP(bf16_t, WS_QM) + (size_t)row * ML_W + h * MDK + cg * 8);
        *(u32x4*)(Ks + s * MQP + cg * 8) = *(const u32x4*)(WSP(bf16_t, WS_KM) + (size_t)row * ML_W + h * MDK + cg * 8);
        const u32x4 vv = *(const u32x4*)(WSP(bf16_t, WS_P) + (size_t)row * NPB + PMV + h * MDV + cg * 8);
        const unsigned wv[4] = {vv.x, vv.y, vv.z, vv.w};
#pragma unroll
        for (int q = 0; q < 8; ++q) VT[(cg * 8 + q) * CP + s] = (bf16_t)((wv[q >> 1] >> ((q & 1) * 16)) & 0xffffu);
    }
    __syncthreads();
    const int r32 = C.lane & 31, hi = C.lane >> 5, w = C.wave;
    f32x16 sacc = (f32x16){0};
    if (w < 4) {
        const int tb = w >> 1, sb = w & 1;
#pragma unroll
        for (int ks = 0; ks < MDK / 16; ++ks) {
            const bf16x8 a = *(const bf16x8*)(Qs + (32 * tb + r32) * MQP + 16 * ks + 8 * hi);
            const bf16x8 bb = *(const bf16x8*)(Ks + (32 * sb + r32) * MQP + 16 * ks + 8 * hi);
            sacc = MFMA32(a, bb, sacc);
        }
    } else if (C.tid == 256 || C.tid == 320) {
        const int d = (C.tid - 256) >> 6; const float ms = mst[d];
        float fc = 0.f, pm = -3.0e38f;
        for (int st = 0; st < CH; ++st) { const int j = d ? CH - 1 - st : st;
            fc += lfv[d * 64 + j]; fcv[d * 64 + j] = fc; pm = fmaxf(pm, liv[d * 64 + j] - fc);
            const float mt = fc + fmaxf(ms, pm); mtv[d * 64 + j] = mt; av[d * 64 + j] = expf(fc + ms - mt); }
    } else if (w >= 6) {
        const int d = w - 6, j = C.lane; const float* nst = WSP(float, WS_SMALL + SM_NLOC) + ((size_t)(sq0 + d) * NCH + (d ? c1 : c0)) * MDK;
        float s = 0.f; for (int k = 0; k < MDK; ++k) s += bf2f(Qs[j * MQP + k]) * nst[k];
        qnv[d * 64 + j] = s;
    }
    __syncthreads();
    if (w < 4) {
        const int tb = w >> 1, sb = w & 1, s = 32 * sb + r32;
#pragma unroll
        for (int d = 0; d < 2; ++d) { const float fs = fcv[d * 64 + s], ls = liv[d * 64 + s];
#pragma unroll
            for (int r = 0; r < 16; ++r) { const int t = 32 * tb + crow(r, hi); const bool ok = d ? (s >= t) : (s <= t);
                const float wgt = ok ? fexp(fcv[d * 64 + t] - fs + ls - mtv[d * 64 + t]) : 0.f;
                SC[(d * CH + t) * CP + s] = (bf16_t)f2bf(ok ? sacc[r] * wgt : 0.f);
                if ((r & 3) == 3) asm volatile("" ::: "memory"); } }
    }
    __syncthreads();
    if (C.tid < 2 * CH) { const int d = C.tid >> 6, t = C.tid & 63; float s = 0.f; for (int k = 0; k < CH; ++k) s += bf2f(SC[(d * CH + t) * CP + k]);
        const float den = s + av[C.tid] * qnv[C.tid]; rinv[C.tid] = 1.0f / fmaxf(fabsf(den), expf(-mtv[C.tid])); }
    __syncthreads();
    f32x16 hs[2]; hs[0] = (f32x16){0}; hs[1] = (f32x16){0};
#pragma unroll 1
    for (int d = 0; d < 2; ++d) {
        { f32x16 a1[2]; a1[0] = (f32x16){0}; a1[1] = (f32x16){0};
#pragma unroll
        for (int ks = 0; ks < CH / 16; ++ks) {
            const bf16x8 bb = *(const bf16x8*)(VT + (32 * w + r32) * CP + 16 * ks + 8 * hi);
            const bf16x8 x0 = *(const bf16x8*)(SC + (d * CH + r32) * CP + 16 * ks + 8 * hi), x1 = *(const bf16x8*)(SC + (d * CH + 32 + r32) * CP + 16 * ks + 8 * hi);
            a1[0] = MFMA32(x0, bb, a1[0]); a1[1] = MFMA32(x1, bb, a1[1]);
        }
#pragma unroll
        for (int r = 0; r < 16; ++r) { const int t = crow(r, hi); hs[0][r] += a1[0][r] * rinv[d * 64 + t]; hs[1][r] += a1[1][r] * rinv[d * 64 + 32 + t]; } }
        f32x16 a2[2]; a2[0] = (f32x16){0}; a2[1] = (f32x16){0};
        const bf16_t* cst = WSP(bf16_t, WS_CSTM) + ((size_t)(sq0 + d) * NCH + (d ? c1 : c0)) * MDV * MDK + (size_t)(32 * w + r32) * MDK + 8 * hi;
#pragma unroll 4
        for (int ks = 0; ks < MDK / 16; ++ks) {
            const bf16x8 bb = *(const bf16x8*)(cst + 16 * ks);
            const bf16x8 x0 = *(const bf16x8*)(Qs + r32 * MQP + 16 * ks + 8 * hi), x1 = *(const bf16x8*)(Qs + (32 + r32) * MQP + 16 * ks + 8 * hi);
            a2[0] = MFMA32(x0, bb, a2[0]); a2[1] = MFMA32(x1, bb, a2[1]);
        }
#pragma unroll
        for (int r = 0; r < 16; ++r) { const int t = crow(r, hi);
            hs[0][r] += av[d * 64 + t] * a2[0][r] * rinv[d * 64 + t];
            hs[1][r] += av[d * 64 + 32 + t] * a2[1][r] * rinv[d * 64 + 32 + t]; }
    }
    __syncthreads();
#pragma unroll
    for (int tb = 0; tb < 2; ++tb)
#pragma unroll
        for (int r = 0; r < 16; ++r) HS[(32 * tb + crow(r, hi)) * 257 + 32 * w + r32] = hs[tb][r];
    __syncthreads();
    const float* ng = P.ml_norm_g + (size_t)l * ML_W + h * MDV;
    for (int t = w; t < CH; t += NWAVES) {
        float v[4], ss = 0.f;
#pragma unroll
        for (int q = 0; q < 4; ++q) { v[q] = HS[t * 257 + C.lane * 4 + q]; ss += v[q] * v[q]; }
        const float rstd = 1.0f / sqrtf(wave_sum(ss) * (1.0f / MDV) + EPS);
        const int row = row0 + t; const u32x2 ov = *(const u32x2*)(WSP(bf16_t, WS_P) + (size_t)row * NPB + PMO + h * MDV + C.lane * 4);
        const float o0 = bitsf(ov.x << 16), o1 = bitsf(ov.x & 0xffff0000u), o2 = bitsf(ov.y << 16), o3 = bitsf(ov.y & 0xffff0000u);
        u32x2 y; y.x = pk2(v[0] * rstd * ng[C.lane * 4 + 0] * sigmoidf_(o0), v[1] * rstd * ng[C.lane * 4 + 1] * sigmoidf_(o1));
        y.y = pk2(v[2] * rstd * ng[C.lane * 4 + 2] * sigmoidf_(o2), v[3] * rstd * ng[C.lane * 4 + 3] * sigmoidf_(o3));
        *(u32x2*)(WSP(bf16_t, WS_Y) + ((size_t)1 * MT + row) * BW + h * MDV + C.lane * 4) = y;
    }
    __syncthreads();
}

constexpr int HQP = HDK + 8;
DEV float hg_f(float z, float lb) { return lb + (1.0f - lb) * sigmoidf_(z); }
DEV void hgrn_s1_unit(const Params& P, const Ctx& C0, int l, int u) {
    const Ctx C = make_ctx(C0.lds);
    const int cc = u % NCH, h = (u / NCH) % HGH, b = u / (NCH * HGH), row0 = chunk_row0(b, cc);
    bf16_t* KT = (bf16_t*)C.lds;
    bf16_t* VT = KT + 2 * HDK * CP;
    const bf16_t* Pb = WSP(bf16_t, WS_P); const float* LB = WSP(float, WS_LB) + (size_t)l * HG_W + h * HDK;
    const int sq0 = (b * HGH + h) * 2;
    if (C.tid < 2 * HDK) {
        const int d = C.tid >> 7, dk = C.tid & 127; const float lb = LB[dk]; const int zc = (d ? PHB : PHF) + h * HDK + dk;
        float R = 0.f;
        for (int st = 0; st < CH; ++st) { const int j = d ? st : CH - 1 - st;
            const float f = hg_f(bf2f(Pb[(size_t)(row0 + j) * NPB + zc]), lb);
            KT[(d * HDK + dk) * CP + j] = (bf16_t)f2bf((1.0f - f) * expf(R)); R += logf(f); }
        WSP(float, WS_SMALL + SM_LAM)[((size_t)(sq0 + d) * NCH + dir_chunk(cc, d)) * HDK + dk] = expf(R);
    }
    for (int i = C.tid; i < CH * (HDV / 8); i += NTHREADS) {
        const int s = i / (HDV / 8), cg = i % (HDV / 8);
        const u32x4 vv = *(const u32x4*)(Pb + (size_t)(row0 + s) * NPB + PHI + h * HDV + cg * 8); const unsigned wv[4] = {vv.x, vv.y, vv.z, vv.w};
#pragma unroll
        for (int q = 0; q < 8; ++q) VT[(cg * 8 + q) * CP + s] = (bf16_t)((wv[q >> 1] >> ((q & 1) * 16)) & 0xffffu);
    }
    __syncthreads();
    const int r32 = C.lane & 31, hi = C.lane >> 5, w = C.wave, d = w >> 2, eb = w & 3;
    f32x16 acc[4];
#pragma unroll
    for (int nb = 0; nb < 4; ++nb) acc[nb] = (f32x16){0};
#pragma unroll
    for (int ks = 0; ks < CH / 16; ++ks) {
        const bf16x8 a = *(const bf16x8*)(VT + (32 * eb + r32) * CP + 16 * ks + 8 * hi);
#pragma unroll
        for (int nb = 0; nb < 4; ++nb) { const bf16x8 bb = *(const bf16x8*)(KT + (d * HDK + 32 * nb + r32) * CP + 16 * ks + 8 * hi); acc[nb] = MFMA32(a, bb, acc[nb]); }
    }
    bf16_t* out = WSP(bf16_t, WS_CSTH) + ((size_t)(sq0 + d) * NCH + dir_chunk(cc, d)) * HDV * HDK;
#pragma unroll
    for (int nb = 0; nb < 4; ++nb)
#pragma unroll
        for (int r = 0; r < 16; ++r) out[(size_t)(32 * eb + crow(r, hi)) * HDK + 32 * nb + r32] = (bf16_t)f2bf(acc[nb][r]);
    __syncthreads();
}
DEV void hgrn_s2(const Params& P, const Ctx& C) {
    const int gt = C.bid * NTHREADS + C.tid, ngt = C.nblk * NTHREADS;
    constexpr int NG8 = HDV * HDK / 8;
    for (int i = gt; i < NSQH * NG8; i += ngt) {
        const int sq = i / NG8, g8 = i % NG8, dk0 = (g8 * 8) % HDK; float run[8];
#pragma unroll
        for (int q = 0; q < 8; ++q) run[q] = 0.f;
        u32x4* p = (u32x4*)(WSP(bf16_t, WS_CSTH) + (size_t)sq * NCH * HDV * HDK + (size_t)g8 * 8);
        const float* lam = WSP(float, WS_SMALL + SM_LAM) + (size_t)sq * NCH * HDK + dk0;
        for (int c = 0; c < NCH; ++c) {
            float kl[8]; unpack8(p[(size_t)c * NG8], kl);
            p[(size_t)c * NG8] = pack8(run);
#pragma unroll
            for (int q = 0; q < 8; ++q) run[q] = lam[(size_t)c * HDK + q] * run[q] + kl[q];
        }
    }
}
DEV void hgrn_s3_unit(const Params& P, const Ctx& C0, int l, int u) {
    const Ctx C = make_ctx(C0.lds);
    const int cc = u % NCH, h = (u / NCH) % HGH, b = u / (NCH * HGH), row0 = chunk_row0(b, cc);
    float* GL = (float*)C.lds;
    bf16_t* QH = (bf16_t*)(C.lds + CH * HDK * 4);
    bf16_t* KH = QH + CH * HQP;
    bf16_t* KTL = KH + CH * HQP;
    bf16_t* QP = KTL + 32 * HQP;
    bf16_t* VT = QP + CH * HQP;
    bf16_t* AT = VT + HDV * CP;
    float* HS = GL;
    const bf16_t* Pb = WSP(bf16_t, WS_P); const float* LB = WSP(float, WS_LB) + (size_t)l * HG_W + h * HDK;
    const int sq0 = (b * HGH + h) * 2;
    const int r32 = C.lane & 31, hi = C.lane >> 5, w = C.wave, tbo = w >> 2, eb = w & 3;
    for (int i = C.tid; i < CH * (HDV / 8); i += NTHREADS) {
        const int s = i / (HDV / 8), cg = i % (HDV / 8);
        const u32x4 vv = *(const u32x4*)(Pb + (size_t)(row0 + s) * NPB + PHI + h * HDV + cg * 8); const unsigned wv[4] = {vv.x, vv.y, vv.z, vv.w};
#pragma unroll
        for (int q = 0; q < 8; ++q) VT[(cg * 8 + q) * CP + s] = (bf16_t)((wv[q >> 1] >> ((q & 1) * 16)) & 0xffffu);
    }
    f32x16 oacc = (f32x16){0};
    for (int d = 0; d < 2; ++d) {
        const int zc = (d ? PHB : PHF) + h * HDK;
        if (C.tid < HDK) { const int dk = C.tid; const float lb = LB[dk]; float G = 0.f;
            for (int st = 0; st < CH; ++st) { const int j = d ? CH - 1 - st : st; G += logf(hg_f(bf2f(Pb[(size_t)(row0 + j) * NPB + zc + dk]), lb)); GL[j * HDK + dk] = G; } }
        __syncthreads();
        for (int i = C.tid; i < CH * HDK; i += NTHREADS) {
            const int j = i / HDK, dk = i % HDK, blk = j >> 5;
            const float q = siluf_(bf2f(Pb[(size_t)(row0 + j) * NPB + PHQ + h * HDK + dk])), k = 1.0f - hg_f(bf2f(Pb[(size_t)(row0 + j) * NPB + zc + dk]), LB[dk]);
            const float G = GL[j * HDK + dk], Gmid = d ? GL[32 * HDK + dk] : GL[31 * HDK + dk];
            const float Gref = d ? (blk == 1 ? 0.f : Gmid) : (blk == 0 ? 0.f : Gmid);
            QH[j * HQP + dk] = (bf16_t)f2bf(q * expf(G - Gref)); KH[j * HQP + dk] = (bf16_t)f2bf(k * expf(Gref - G)); QP[j * HQP + dk] = (bf16_t)f2bf(q * expf(G));
            if (d ? (blk == 1) : (blk == 0)) KTL[(j & 31) * HQP + dk] = (bf16_t)f2bf(k * expf(Gmid - G));
        }
        __syncthreads();
        if (w < 4) {
            const int tb = w >> 1, sb = w & 1; const bool diag = tb == sb, off = d ? (tb == 0 && sb == 1) : (tb == 1 && sb == 0);
            f32x16 sa = (f32x16){0};
            if (diag || off) {
                const bf16_t* kb = diag ? KH + (32 * sb) * HQP : KTL;
#pragma unroll
                for (int ks = 0; ks < HDK / 16; ++ks) {
                    const bf16x8 a = *(const bf16x8*)(QH + (32 * tb + r32) * HQP + 16 * ks + 8 * hi);
                    const bf16x8 bb = *(const bf16x8*)(kb + r32 * HQP + 16 * ks + 8 * hi);
                    sa = MFMA32(a, bb, sa);
                }
            }
#pragma unroll
            for (int r = 0; r < 16; ++r) { const int t = 32 * tb + crow(r, hi), s = 32 * sb + r32; const bool ok = d ? (s >= t) : (s <= t);
                AT[t * CP + s] = (bf16_t)f2bf((ok && (diag || off)) ? sa[r] : 0.f); }
        }
        __syncthreads();
#pragma unroll
        for (int ks = 0; ks < CH / 16; ++ks) {
            const bf16x8 a = *(const bf16x8*)(AT + (32 * tbo + r32) * CP + 16 * ks + 8 * hi);
            const bf16x8 bb = *(const bf16x8*)(VT + (32 * eb + r32) * CP + 16 * ks + 8 * hi);
            oacc = MFMA32(a, bb, oacc);
        }
        const bf16_t* sst = WSP(bf16_t, WS_CSTH) + ((size_t)(sq0 + d) * NCH + dir_chunk(cc, d)) * HDV * HDK + (size_t)(32 * eb + r32) * HDK + 8 * hi;
#pragma unroll
        for (int ks = 0; ks < HDK / 16; ++ks) {
            const bf16x8 a = *(const bf16x8*)(QP + (32 * tbo + r32) * HQP + 16 * ks + 8 * hi);
            const bf16x8 bb = *(const bf16x8*)(sst + 16 * ks);
            oacc = MFMA32(a, bb, oacc);
        }
        __syncthreads();
    }
#pragma unroll
    for (int r = 0; r < 16; ++r) HS[(32 * tbo + crow(r, hi)) * HDV + 32 * eb + r32] = oacc[r];
    __syncthreads();
    const float* ng = P.hg_norm_g + (size_t)l * HG_W + h * HDV;
    for (int t = w; t < CH; t += NWAVES) {
        const float v0 = HS[t * HDV + C.lane * 2], v1 = HS[t * HDV + C.lane * 2 + 1];
        const float rstd = 1.0f / sqrtf(wave_sum(v0 * v0 + v1 * v1) * (1.0f / HDV) + EPS);
        const int row = row0 + t; const unsigned gv = *(const unsigned*)(Pb + (size_t)row * NPB + PHG + h * HDV + C.lane * 2);
        const float g0 = bitsf(gv << 16), g1 = bitsf(gv & 0xffff0000u);
        *(unsigned*)(WSP(bf16_t, WS_Y) + ((size_t)2 * MT + row) * BW + h * HDV + C.lane * 2) = pk2(v0 * rstd * ng[C.lane * 2] * siluf_(g0), v1 * rstd * ng[C.lane * 2 + 1] * siluf_(g1));
    }
    __syncthreads();
}
DEV void phase_s1(const Params& P, const Ctx& C, int l) {
    for (int u = C.bid; u < NSQM * NCH; u += C.nblk) mlstm_s1_unit(P, C, l, u);
    for (int u = C.bid; u < NB * HGH * NCH; u += C.nblk) hgrn_s1_unit(P, C, l, u);
}
DEV void phase_s2(const Params& P, const Ctx& C) { mlstm_s2(P, C); hgrn_s2(P, C); }
DEV void phase_s3(const Params& P, const Ctx& C, int l, bool need_ctx) {
    const int c_lo = need_ctx ? 0 : NCHC, ncu = NCH - c_lo;
    for (int u = C.bid; u < NB * MLH * ncu; u += C.nblk) mlstm_s3_unit(P, C, l, (u / ncu) * NCH + c_lo + (u % ncu));
    for (int u = C.bid; u < NB * HGH * ncu; u += C.nblk) hgrn_s3_unit(P, C, l, (u / ncu) * NCH + c_lo + (u % ncu));
}

namespace pg8 {
constexpr int BM = 256, BK = 64, HALF = 128, HTB = HALF * BK * 2, STAGE_BYTES = 8 * HTB, NXCD = 8, WGM = 8;
struct Unit { int pm, pn, po; };
struct Gemm { const bf16_t* A; const bf16_t* Bt; int K; };
DEV int lds_byte(int r, int c) { const int st = (r >> 4) * 2 + (c >> 5), rr = r & 15, cc = c & 31, ob = rr * 64 + cc * 2; return st * 1024 + (ob ^ (((ob >> 9) & 1) << 5)); }
DEV void stage_rc(int b, int& R, int& C) { const int st = b / 1024, sb = b % 1024, swz = sb ^ (((sb >> 9) & 1) << 5); R = (st >> 1) * 16 + swz / 64; C = (st & 1) * 32 + (swz % 64) / 2; }
DEV int perm32(int rho) { const int n = rho >> 4, i = rho & 15; return 8 * (i >> 2) + 4 * n + (i & 3); }
struct PanelOrder {
    int nM, nN, nwg, G, c; const int* pe;
    DEV void init(int nM_, int nN_, int G_, int c_, const int* pe_) { nM = nM_; nN = nN_; nwg = nM * nN; G = G_; c = c_; pe = pe_; }
    DEV bool next(int i, Unit& u) const {
        const long L = (long)i * G + c; if (L >= nwg) return false;
        int wgid = (int)L; { const int q = nwg / NXCD, r = nwg % NXCD, xcd = wgid % NXCD, off = wgid / NXCD; wgid = (xcd < r ? xcd * (q + 1) : r * (q + 1) + (xcd - r) * q) + off; }
        const int nig = WGM * nN, gid = wgid / nig, fm = gid * WGM, gsz = (nM - fm) < WGM ? (nM - fm) : WGM;
        u.pm = fm + ((wgid % nig) % gsz); u.po = (wgid % nig) / gsz; u.pn = pe ? pe[u.pm] * nN + u.po : u.po; return true;
    }
    DEV void a_ready(const Unit&) const {}
    DEV void done(const Unit&) const {}
};
#ifndef HOST_EMU
#define PG8_LAS __attribute__((address_space(3)))
template <class Epi, class Sched, bool ALIGN_EPI = false, bool SP2 = false>
__device__ __forceinline__ void gemm_phase(PG8_LAS unsigned char* lds, const Gemm g, const Sched& S, const Epi& E) {
    const int tid = opaque_tid(), wid = __builtin_amdgcn_readfirstlane(tid >> 6), lane = tid & 63, wr = wid >> 2, wc = wid & 3, fr = lane & 15, fq = lane >> 4;
    const int K = g.K, nt = K / BK;
    unsigned voffA[2], voffB[2];
#pragma unroll
    for (int i = 0; i < 2; ++i) { int R, C; stage_rc(tid * 16 + i * 8192, R, C); const int Rb = Epi::PERM ? ((R & ~31) + perm32(R & 31)) : R;
        voffA[i] = (unsigned)(R * K + C) * 2u; voffB[i] = (unsigned)(Rb * K + C) * 2u; }
    const size_t kstep = (size_t)(BK * 2);
    const size_t hstep = (size_t)HALF * K * 2;
    const size_t tstep = 2 * hstep;
    const unsigned ldsw = (unsigned)wid * 1024u;
    const int aoff = lds_byte(wr * 64 + fr, fq * 8), boff = lds_byte(wc * 32 + fr, fq * 8);
#define PG8_SA(b, h) (((b) * 2 + (h)) * HTB)
#define PG8_SB(b, h) ((4 + (b) * 2 + (h)) * HTB)
#define PG8_STAGE(bufoff, gbase, voff) do { _Pragma("unroll") for (int _i = 0; _i < 2; ++_i) \
        __builtin_amdgcn_global_load_lds((const unsigned*)((const char*)(gbase) + (voff)[_i]), (PG8_LAS unsigned*)(lds + (bufoff) + ldsw + _i * 8192), 16, 0, 0); } while (0)
#define PG8_LDA(dst, b, h) do { _Pragma("unroll") for (int m = 0; m < 4; ++m) _Pragma("unroll") for (int k = 0; k < 2; ++k) dst[m][k] = *(const PG8_LAS bf16x8*)(lds + PG8_SA(b, h) + aoff + m * 2048 + k * 1024); } while (0)
#define PG8_LDB(dst, b, h) do { _Pragma("unroll") for (int n = 0; n < 2; ++n) _Pragma("unroll") for (int k = 0; k < 2; ++k) dst[n][k] = *(const PG8_LAS bf16x8*)(lds + PG8_SB(b, h) + boff + n * 2048 + k * 1024); } while (0)
#define PG8_MMA(ai, bj, At, Bt) do { __builtin_amdgcn_s_setprio(1); _Pragma("unroll") for (int m = 0; m < 4; ++m) _Pragma("unroll") for (int n = 0; n < 2; ++n) _Pragma("unroll") for (int k = 0; k < 2; ++k) \
        acc[ai][bj][m][n] = __builtin_amdgcn_mfma_f32_16x16x32_bf16(Bt[n][k], At[m][k], acc[ai][bj][m][n], 0, 0, 0); __builtin_amdgcn_s_setprio(0); } while (0)
#define PG8_WAIT_V(n) asm volatile("s_waitcnt vmcnt(" #n ")" ::: "memory")
#define PG8_WAIT_L(n) asm volatile("s_waitcnt lgkmcnt(" #n ")" ::: "memory")
#define PG8_BAR __builtin_amdgcn_s_barrier()
#define PG8_SCHED __builtin_amdgcn_sched_barrier(0)
    Unit cur, nxt; int ui = 0;
    if (!S.next(0, cur)) return;
    f32x4 acc[2][2][4][2];
#pragma unroll
    for (int a = 0; a < 2; ++a)
#pragma unroll
        for (int b = 0; b < 2; ++b)
#pragma unroll
            for (int m = 0; m < 4; ++m)
#pragma unroll
                for (int n = 0; n < 2; ++n) acc[a][b][m][n] = (f32x4){0.f, 0.f, 0.f, 0.f};
    bf16x8 At[4][2], B0[2][2], B1[2][2];
    const char* cA = (const char*)g.A + (size_t)cur.pm * tstep; const char* cB = (const char*)g.Bt + (size_t)cur.pn * tstep;
    S.a_ready(cur);
    if constexpr (SP2) {
        PG8_STAGE(PG8_SB(0, 0), cB, voffB); PG8_STAGE(PG8_SB(0, 1), cB + hstep, voffB); PG8_STAGE(PG8_SA(0, 0), cA, voffA); PG8_STAGE(PG8_SA(0, 1), cA + hstep, voffA);
        if (wr == 1) PG8_BAR;
        PG8_WAIT_V(2); PG8_BAR;
        PG8_STAGE(PG8_SB(1, 0), cB + kstep, voffB); PG8_STAGE(PG8_SA(1, 0), cA + kstep, voffA); PG8_STAGE(PG8_SB(1, 1), cB + hstep + kstep, voffB);
        PG8_WAIT_V(6); PG8_BAR;
    } else {
        PG8_STAGE(PG8_SB(0, 0), cB, voffB); PG8_STAGE(PG8_SA(0, 0), cA, voffA); PG8_STAGE(PG8_SB(0, 1), cB + hstep, voffB); PG8_STAGE(PG8_SA(0, 1), cA + hstep, voffA);
        if (wr == 1) PG8_BAR;
        PG8_WAIT_V(4); PG8_BAR;
        PG8_STAGE(PG8_SB(1, 0), cB + kstep, voffB); PG8_STAGE(PG8_SA(1, 0), cA + kstep, voffA); PG8_STAGE(PG8_SB(1, 1), cB + hstep + kstep, voffB);
        PG8_WAIT_V(6); PG8_BAR;
    }
    for (;;) {
        const bool has_next = S.next(ui + 1, nxt);
        const char* nA = has_next ? (const char*)g.A + (size_t)nxt.pm * tstep : cA; const char* nB = has_next ? (const char*)g.Bt + (size_t)nxt.pn * tstep : cB;
        for (int t = 0; t < nt; t += 2) {
            const bool last = (t == nt - 2);
            const char* a1 = cA + (size_t)(t + 1) * kstep;
            const char* a2 = last ? nA : cA + (size_t)(t + 2) * kstep; const char* b2 = last ? nB : cB + (size_t)(t + 2) * kstep;
            const char* a3 = a2 + kstep; const char* b3 = b2 + kstep;
            if (last && has_next) S.a_ready(nxt);
            if constexpr (SP2) {
            PG8_LDB(B0, 0, 0); PG8_LDB(B1, 0, 1); PG8_SCHED; PG8_LDA(At, 0, 0); PG8_STAGE(PG8_SA(1, 1), a1 + hstep, voffA);
            PG8_WAIT_V(8); PG8_WAIT_L(0); PG8_BAR; PG8_MMA(0, 0, At, B0); PG8_MMA(0, 1, At, B1); PG8_BAR; PG8_SCHED;
            PG8_LDA(At, 0, 1); PG8_STAGE(PG8_SB(0, 0), b2, voffB); PG8_STAGE(PG8_SB(0, 1), b2 + hstep, voffB); PG8_STAGE(PG8_SA(0, 0), a2, voffA);
            PG8_WAIT_V(8); PG8_WAIT_L(0); PG8_BAR; PG8_MMA(1, 0, At, B0); PG8_MMA(1, 1, At, B1); PG8_BAR; PG8_SCHED;
            PG8_LDB(B0, 1, 0); PG8_LDB(B1, 1, 1); PG8_SCHED; PG8_LDA(At, 1, 0); PG8_STAGE(PG8_SA(0, 1), a2 + hstep, voffA);
            PG8_WAIT_V(8); PG8_WAIT_L(0); PG8_BAR; PG8_MMA(0, 0, At, B0); PG8_MMA(0, 1, At, B1); PG8_BAR; PG8_SCHED;
            PG8_LDA(At, 1, 1); PG8_STAGE(PG8_SB(1, 0), b3, voffB); PG8_STAGE(PG8_SB(1, 1), b3 + hstep, voffB); PG8_STAGE(PG8_SA(1, 0), a3, voffA);
            PG8_WAIT_V(8); PG8_WAIT_L(0); PG8_BAR; PG8_MMA(1, 0, At, B0); PG8_MMA(1, 1, At, B1); PG8_BAR; PG8_SCHED;
            } else {
            PG8_LDB(B0, 0, 0); PG8_SCHED; PG8_LDA(At, 0, 0); PG8_STAGE(PG8_SA(1, 1), a1 + hstep, voffA);
            PG8_WAIT_L(8); PG8_BAR; PG8_WAIT_L(0); PG8_MMA(0, 0, At, B0); PG8_BAR; PG8_SCHED;
            PG8_LDB(B1, 0, 1); PG8_STAGE(PG8_SB(0, 0), b2, voffB);
            PG8_BAR; PG8_WAIT_L(0); PG8_MMA(0, 1, At, B1); PG8_BAR;
            PG8_LDA(At, 0, 1); PG8_STAGE(PG8_SA(0, 0), a2, voffA);
            PG8_BAR; PG8_WAIT_L(0); PG8_MMA(1, 0, At, B0); PG8_BAR; PG8_SCHED;
            PG8_STAGE(PG8_SB(0, 1), b2 + hstep, voffB);
            PG8_WAIT_V(6); PG8_BAR; PG8_MMA(1, 1, At, B1); PG8_BAR;
            PG8_LDB(B0, 1, 0); PG8_SCHED; PG8_LDA(At, 1, 0); PG8_STAGE(PG8_SA(0, 1), a2 + hstep, voffA);
            PG8_WAIT_L(8); PG8_BAR; PG8_WAIT_L(0); PG8_MMA(0, 0, At, B0); PG8_BAR; PG8_SCHED;
            PG8_LDB(B1, 1, 1); PG8_STAGE(PG8_SB(1, 0), b3, voffB);
            PG8_BAR; PG8_WAIT_L(0); PG8_MMA(0, 1, At, B1); PG8_BAR;
            PG8_LDA(At, 1, 1); PG8_STAGE(PG8_SA(1, 0), a3, voffA);
            PG8_BAR; PG8_WAIT_L(0); PG8_MMA(1, 0, At, B0); PG8_BAR; PG8_SCHED;
            PG8_STAGE(PG8_SB(1, 1), b3 + hstep, voffB);
            PG8_WAIT_V(6); PG8_BAR; PG8_MMA(1, 1, At, B1); PG8_BAR;
            }
        }
        if constexpr (ALIGN_EPI) { if (wr == 0) PG8_BAR; }
        E(acc, cur, wr, wc, fr, fq); S.done(cur);
        if (!has_next) break;
#pragma unroll
        for (int a = 0; a < 2; ++a)
#pragma unroll
            for (int b = 0; b < 2; ++b)
#pragma unroll
                for (int m = 0; m < 4; ++m)
#pragma unroll
                    for (int n = 0; n < 2; ++n) acc[a][b][m][n] = (f32x4){0.f, 0.f, 0.f, 0.f};
        cur = nxt; cA = nA; cB = nB; ++ui;
        if constexpr (ALIGN_EPI) { if (wr == 1) PG8_BAR; }
    }
    PG8_WAIT_V(0);
    if constexpr (!ALIGN_EPI) { if (wr == 0) PG8_BAR; }
    PG8_BAR;
#undef PG8_SA
#undef PG8_SB
#undef PG8_STAGE
#undef PG8_LDA
#undef PG8_LDB
#undef PG8_MMA
#undef PG8_WAIT_V
#undef PG8_WAIT_L
#undef PG8_BAR
#undef PG8_SCHED
}
#else
template <class Epi, class Sched, bool ALIGN_EPI = false, bool SP2 = false>
inline void gemm_phase(unsigned char*, const Gemm g, const Sched& S, const Epi& E) {
    const int tid = threadIdx.x, wid = tid >> 6, lane = tid & 63, wr = wid >> 2, wc = wid & 3, fr = lane & 15, fq = lane >> 4;
    Unit u;
    for (int i = 0; S.next(i, u); ++i) {
        f32x4 acc[2][2][4][2];
        for (int ai = 0; ai < 2; ++ai) for (int bj = 0; bj < 2; ++bj) for (int m = 0; m < 4; ++m) for (int n = 0; n < 2; ++n) for (int j = 0; j < 4; ++j) {
            const int row = 256 * u.pm + 128 * ai + 64 * wr + 16 * m + fr;
            const int cit = Epi::PERM ? 128 * bj + 32 * wc + 8 * fq + 4 * n + j : 128 * bj + 32 * wc + 16 * n + 4 * fq + j;
            const bf16_t* a = g.A + (size_t)row * g.K; const bf16_t* b = g.Bt + (size_t)(256 * u.pn + cit) * g.K; float s = 0.f;
            for (int k = 0; k < g.K; ++k) s += bf2f(a[k]) * bf2f(b[k]);
            acc[ai][bj][m][n][j] = s; }
        E(acc, u, wr, wc, fr, fq);
    }
}
#endif
}

typedef const f32x4 (&AccRef)[2][2][4][2];
struct EpiInProj {
    static constexpr bool PERM = true;
    bf16_t* Pb; float* G16;
    DEV void operator()(AccRef acc, const pg8::Unit& u, int wr, int wc, int fr, int fq) const {
        const int row0 = u.pm * 256 + wr * 64 + fr;
        if (u.po < NPB / 256) {
            const int col0 = u.po * 256 + wc * 32 + 8 * fq;
#pragma unroll
            for (int ai = 0; ai < 2; ++ai)
#pragma unroll
                for (int m = 0; m < 4; ++m) { bf16_t* rowp = Pb + (size_t)(row0 + ai * 128 + m * 16) * NPB + col0;
#pragma unroll
                    for (int bj = 0; bj < 2; ++bj) { const f32x4 v0 = acc[ai][bj][m][0], v1 = acc[ai][bj][m][1];
                        u32x4 w; w.x = pk2(v0[0], v0[1]); w.y = pk2(v0[2], v0[3]); w.z = pk2(v1[0], v1[1]); w.w = pk2(v1[2], v1[3]);
                        *(u32x4*)(rowp + bj * 128) = w; } }
        } else if (wc == 0 && fq < 2) {
#pragma unroll
            for (int ai = 0; ai < 2; ++ai)
#pragma unroll
                for (int m = 0; m < 4; ++m) { float* rowp = G16 + (size_t)(row0 + ai * 128 + m * 16) * 16 + 8 * fq;
                    *(f32x4*)rowp = acc[ai][0][m][0]; *(f32x4*)(rowp + 4) = acc[ai][0][m][1]; }
        }
    }
};
struct EpiBranch {
    static constexpr bool PERM = true;
    const bf16_t* Pb; float* MGF; bf16_t* MG; int n;
    DEV void operator()(AccRef acc, const pg8::Unit& u, int wr, int wc, int fr, int fq) const {
        const int row0 = u.pm * 256 + wr * 64 + fr, col0 = u.po * 256 + wc * 32 + 8 * fq;
#pragma unroll
        for (int ai = 0; ai < 2; ++ai)
#pragma unroll
            for (int m = 0; m < 4; ++m) { const int row = row0 + ai * 128 + m * 16;
#pragma unroll
                for (int bj = 0; bj < 2; ++bj) { const int col = col0 + bj * 128;
                    float gt[8]; unpack8(*(const u32x4*)(Pb + (size_t)row * NPB + PGATE + n * D + col), gt);
                    float v[8];
#pragma unroll
                    for (int q = 0; q < 8; ++q) v[q] = sigmoidf_(gt[q]) * acc[ai][bj][m][q >> 2][q & 3];
                    float* mp = MGF + (size_t)row * D + col;
                    if (n > 0) { const f32x4 p0 = *(const f32x4*)mp, p1 = *(const f32x4*)(mp + 4);
#pragma unroll
                        for (int q = 0; q < 4; ++q) { v[q] += p0[q]; v[4 + q] += p1[q]; } }
                    if (n < 2) { *(f32x4*)mp = (f32x4){v[0], v[1], v[2], v[3]}; *(f32x4*)(mp + 4) = (f32x4){v[4], v[5], v[6], v[7]}; }
                    else *(u32x4*)(MG + (size_t)row * D + col) = pack8(v); } }
    }
};
struct EpiResid {
    static constexpr bool PERM = false;
    const float* baseL; const float* baseC; float* outL; float* outC; const float* gate;
    bool moe; const int* rtok; const float* rw; const int* rslot; float* ys;
    DEV void operator()(AccRef acc, const pg8::Unit& u, int wr, int wc, int fr, int fq) const {
        const int row0 = u.pm * 256 + wr * 64 + fr, col0 = u.po * 256 + wc * 32 + 4 * fq;
#pragma unroll
        for (int ai = 0; ai < 2; ++ai)
#pragma unroll
            for (int m = 0; m < 4; ++m) { const int row = row0 + ai * 128 + m * 16;
                if (moe) {
                    const int tok = rtok[row]; if (tok < 0) continue;
                    const float w = rw[row]; float* o = ys + ((size_t)rslot[row] * MLAT + tok) * D + col0;
#pragma unroll
                    for (int bj = 0; bj < 2; ++bj)
#pragma unroll
                        for (int n = 0; n < 2; ++n) *(f32x4*)(o + bj * 128 + n * 16) = acc[ai][bj][m][n] * w;
                } else {
                    const bool lat = row < MLAT; const float* b = lat ? baseL + (size_t)row * D : baseC + (size_t)(row - MLAT) * D;
                    float* o = lat ? outL + (size_t)row * D : outC + (size_t)(row - MLAT) * D; const float* gv = gate + (size_t)row_vec(row) * 6 * D;
#pragma unroll
                    for (int bj = 0; bj < 2; ++bj)
#pragma unroll
                        for (int n = 0; n < 2; ++n) { const int c = col0 + bj * 128 + n * 16; *(f32x4*)(o + c) = *(const f32x4*)(b + c) + *(const f32x4*)(gv + c) * acc[ai][bj][m][n]; }
                } }
    }
};
struct EpiGU {
    static constexpr bool PERM = true;
    bf16_t* ACT;
    DEV void operator()(AccRef acc, const pg8::Unit& u, int wr, int wc, int fr, int fq) const {
        const int row0 = u.pm * 256 + wr * 64 + fr, col0 = u.po * 128 + wc * 32 + 8 * fq;
#pragma unroll
        for (int ai = 0; ai < 2; ++ai)
#pragma unroll
            for (int m = 0; m < 4; ++m) { float v[8];
#pragma unroll
                for (int q = 0; q < 8; ++q) v[q] = siluf_(acc[ai][0][m][q >> 2][q & 3]) * acc[ai][1][m][q >> 2][q & 3];
                *(u32x4*)(ACT + (size_t)(row0 + ai * 128 + m * 16) * DFF + col0) = pack8(v); }
    }
};

namespace att {
constexpr int NW = 8, QBLK = 32, KVBLK = 64, LDQ = ATT_W, LDK = KV_W, LDO = BW;
constexpr float SCALE = 0.088388347648318440f, THR = 8.f;
constexpr size_t SHM_V = KVBLK * HD * 2, SHM_K = KVBLK * HD * 2, SHM_ATTN = 2 * SHM_V + 2 * SHM_K + NW * 64 * 4;
#ifndef HOST_EMU
using s16x4 = __attribute__((ext_vector_type(4))) short;
#define KSWZ(row, colB) ((row) * 256 + ((colB) ^ (((row) & 7) << 4)))
#define SBAR() __builtin_amdgcn_sched_barrier(0)
__device__ __forceinline__ unsigned cvtpk(float lo, float hi) { unsigned r; asm volatile("v_cvt_pk_bf16_f32 %0, %1, %2" : "=v"(r) : "v"(lo), "v"(hi)); return r; }
__device__ __forceinline__ void partialSM(f32x16& p0, f32x16& p1, float& m_reg, float& mn, float& alpha) {
  constexpr float C = SCALE * 1.4426950408889634f;
  float pmax = p0[0]; for (int r = 1; r < 16; ++r) pmax = fmaxf(pmax, p0[r]); for (int r = 0; r < 16; ++r) pmax = fmaxf(pmax, p1[r]);
  { auto rr = __builtin_amdgcn_permlane32_swap(__float_as_uint(pmax), __float_as_uint(pmax), false, false);
    pmax = fmaxf(__uint_as_float(rr[0]), __uint_as_float(rr[1])); }
  if (__builtin_expect(__all(pmax - m_reg <= THR / SCALE), 1)) { mn = m_reg; alpha = 1.f; }
  else { mn = fmaxf(m_reg, pmax); alpha = __builtin_amdgcn_exp2f((m_reg - mn) * C); m_reg = mn; }
  float mnC = -mn * C;
  for (int r = 0; r < 16; ++r) p0[r] = fmaf(p0[r], C, mnC); for (int r = 0; r < 16; ++r) p1[r] = fmaf(p1[r], C, mnC);
  for (int r = 0; r < 16; ++r) p0[r] = __builtin_amdgcn_exp2f(p0[r]);
}
__device__ __forceinline__ void finishSM(f32x16& p0, f32x16& p1, float alpha, float& l_reg, bf16x8& pa0, bf16x8& pa1, bf16x8& pa2, bf16x8& pa3) {
  for (int r = 0; r < 16; ++r) p1[r] = __builtin_amdgcn_exp2f(p1[r]);
  float ps = 0; for (int r = 0; r < 16; ++r) ps += p0[r]; for (int r = 0; r < 16; ++r) ps += p1[r];
  { auto rr = __builtin_amdgcn_permlane32_swap(__float_as_uint(ps), __float_as_uint(ps), false, false);
    ps = __uint_as_float(rr[0]) + __uint_as_float(rr[1]); }
  l_reg = l_reg * alpha + ps;
#define PK4(P, BASE, OUT) do { unsigned a0 = cvtpk(P[BASE + 0], P[BASE + 1]), a1 = cvtpk(P[BASE + 2], P[BASE + 3]);   \
    unsigned b0 = cvtpk(P[BASE + 4], P[BASE + 5]), b1 = cvtpk(P[BASE + 6], P[BASE + 7]);                              \
    auto r0 = __builtin_amdgcn_permlane32_swap(a0, b0, false, false); auto r1 = __builtin_amdgcn_permlane32_swap(a1, b1, false, false); \
    u32x4 w = {r0[0], r1[0], r0[1], r1[1]}; OUT = *reinterpret_cast<bf16x8*>(&w); } while (0)
  PK4(p0, 0, pa0); PK4(p0, 8, pa1); PK4(p1, 0, pa2); PK4(p1, 8, pa3);
#undef PK4
}
__device__ __forceinline__ void qkt(f32x16& p0, f32x16& p1, const bf16_t* Ks, const bf16x8* qr, int r32, int hi) {
  p0 = f32x16{}; p1 = f32x16{};
  for (int d0 = 0; d0 < 8; ++d0) { int cb = (d0 * 16 + hi * 8) * 2;
    bf16x8 b0 = *reinterpret_cast<const bf16x8*>((const char*)Ks + KSWZ(r32, cb));
    bf16x8 b1 = *reinterpret_cast<const bf16x8*>((const char*)Ks + KSWZ(32 + r32, cb));
    p0 = __builtin_amdgcn_mfma_f32_32x32x16_bf16(b0, qr[d0], p0, 0, 0, 0);
    p1 = __builtin_amdgcn_mfma_f32_32x32x16_bf16(b1, qr[d0], p1, 0, 0, 0); }
}
__device__ __forceinline__ int v_st(int k, int c) { const int kk = (k & ~0xC) | ((k & 4) << 1) | ((k & 8) >> 1); return ((kk >> 3) * 4 + (c >> 5)) * 512 + ((kk & 7) * 32 + (c & 31)) * 2; }
__device__ __forceinline__ int v_rd_base(int lane) { return ((lane & 3) << 3) | (((lane >> 2) & 3) << 6) | (((lane >> 4) & 1) << 5) | (((lane >> 5) & 1) << 8); }
constexpr int v_rd_off(int d0, int ks, int half) { return d0 * 512 + ks * 4096 + half * 2048; }
template <int OFF> __device__ __forceinline__ s16x4 tr_read(int vb) {
  s16x4 r; asm volatile("ds_read_b64_tr_b16 %0, %1 offset:%2" : "=&v"(r) : "v"(vb), "i"(OFF) : "memory"); return r;
}
template <int D0> __device__ __forceinline__ void pv_one(f32x16& od, int vb, bf16x8 pa0, bf16x8 pa1, bf16x8 pa2, bf16x8 pa3) {
  const s16x4 l0 = tr_read<v_rd_off(D0, 0, 0)>(vb), h0 = tr_read<v_rd_off(D0, 0, 1)>(vb), l1 = tr_read<v_rd_off(D0, 1, 0)>(vb), h1 = tr_read<v_rd_off(D0, 1, 1)>(vb);
  const s16x4 l2 = tr_read<v_rd_off(D0, 2, 0)>(vb), h2 = tr_read<v_rd_off(D0, 2, 1)>(vb), l3 = tr_read<v_rd_off(D0, 3, 0)>(vb), h3 = tr_read<v_rd_off(D0, 3, 1)>(vb);
  asm volatile("s_waitcnt lgkmcnt(0)" ::: "memory"); SBAR();
#define PK(L, H) (bf16x8){L[0], L[1], L[2], L[3], H[0], H[1], H[2], H[3]}
  od = __builtin_amdgcn_mfma_f32_32x32x16_bf16(pa0, PK(l0, h0), od, 0, 0, 0);
  od = __builtin_amdgcn_mfma_f32_32x32x16_bf16(pa1, PK(l1, h1), od, 0, 0, 0);
  od = __builtin_amdgcn_mfma_f32_32x32x16_bf16(pa2, PK(l2, h2), od, 0, 0, 0);
  od = __builtin_amdgcn_mfma_f32_32x32x16_bf16(pa3, PK(l3, h3), od, 0, 0, 0);
#undef PK
}
__device__ __forceinline__ void pv_d0(f32x16* o, int vb, bf16x8 pa0, bf16x8 pa1, bf16x8 pa2, bf16x8 pa3) {
  pv_one<0>(o[0], vb, pa0, pa1, pa2, pa3); pv_one<1>(o[1], vb, pa0, pa1, pa2, pa3); pv_one<2>(o[2], vb, pa0, pa1, pa2, pa3); pv_one<3>(o[3], vb, pa0, pa1, pa2, pa3);
}
__device__ __forceinline__ void attn_dense_body(const bf16_t* __restrict__ Qb, const bf16_t* __restrict__ Kh, const bf16_t* __restrict__ Vh, bf16_t* __restrict__ Ob, int seq, char* lds) {
  const int tid = opaque_tid(), wid = tid >> 6, lane = tid & 63, r32 = lane & 31, hi = lane >> 5;
  bf16_t* V_lds = (bf16_t*)lds; bf16_t* K_lds = (bf16_t*)(lds + 2 * SHM_V);
  float* ws = (float*)(lds + 2 * SHM_V + 2 * SHM_K) + wid * 64; float* li_l = ws; float* al_l = ws + 32;
  float m_reg = -1e30f, l_reg = 0; f32x16 o[4] = {}; bf16x8 qr[8];
  const bf16_t* Qw = Qb + (long)(wid * QBLK + r32) * LDQ + hi * 8;
#pragma unroll
  for (int d0 = 0; d0 < 8; ++d0) qr[d0] = *reinterpret_cast<const bf16x8*>(Qw + d0 * 16);
  const int sr = tid >> 4, sc = (tid & 15) * 8, vst0 = v_st(sr, sc), vst1 = v_st(32 + sr, sc);
  const int vb0 = (int)(uintptr_t)V_lds + v_rd_base(lane);
  struct { bf16x8 vs0, vs1, ks0, ks1; } sr_[2];
#define SLOAD(i, k0) do { sr_[i].vs0 = *reinterpret_cast<const bf16x8*>(&Vh[(long)((k0) + sr) * LDK + sc]); sr_[i].vs1 = *reinterpret_cast<const bf16x8*>(&Vh[(long)((k0) + 32 + sr) * LDK + sc]); \
    sr_[i].ks0 = *reinterpret_cast<const bf16x8*>(&Kh[(long)((k0) + sr) * LDK + sc]); sr_[i].ks1 = *reinterpret_cast<const bf16x8*>(&Kh[(long)((k0) + 32 + sr) * LDK + sc]); } while (0)
#define SWRITE(b, i) do { *(bf16x8*)((char*)V_lds + (b) * SHM_V + vst0) = sr_[i].vs0;          \
    *(bf16x8*)((char*)V_lds + (b) * SHM_V + vst1) = sr_[i].vs1; int kc = sc * 2;               \
    *(bf16x8*)((char*)K_lds + (b) * SHM_K + KSWZ(sr, kc)) = sr_[i].ks0;                       \
    *(bf16x8*)((char*)K_lds + (b) * SHM_K + KSWZ(32 + sr, kc)) = sr_[i].ks1; } while (0)
#define SWAIT() asm volatile("s_waitcnt vmcnt(4)" ::: "memory")
#define RESC(a) do { if (__any((a) < 1.f)) { if (hi == 0) al_l[r32] = (a); asm volatile("s_waitcnt lgkmcnt(0)" ::: "memory"); \
    for (int d = 0; d < 4; ++d) for (int r = 0; r < 16; ++r) o[d][r] *= al_l[crow(r, hi)]; } } while (0)
  f32x16 pA0, pA1, pB0, pB1; float mnA, mnB, alA, alB; bf16x8 pa0, pa1, pa2, pa3; const int NT = seq / KVBLK;
  constexpr int SE = 0, SO = 1;
  SLOAD(SE, 0); asm volatile("s_waitcnt vmcnt(0)" ::: "memory"); SWRITE(0, SE); __syncthreads();
  qkt(pA0, pA1, K_lds, qr, r32, hi); partialSM(pA0, pA1, m_reg, mnA, alA);
  SLOAD(SO, KVBLK); if (2 < NT) SLOAD(SE, 2 * KVBLK);
  SWAIT(); SWRITE(1, SO); __syncthreads();
  for (int j = 1; j + 1 < NT; j += 2) {
    SBAR(); qkt(pB0, pB1, (bf16_t*)((char*)K_lds + SHM_K), qr, r32, hi);
    finishSM(pA0, pA1, alA, l_reg, pa0, pa1, pa2, pa3); SBAR();
    SLOAD(SO, (j + 2) * KVBLK); SBAR();
    pv_d0(o, vb0, pa0, pa1, pa2, pa3); partialSM(pB0, pB1, m_reg, mnB, alB);
    __syncthreads(); SWAIT(); SWRITE(0, SE);
    RESC(alB); __syncthreads();
    SBAR(); qkt(pA0, pA1, K_lds, qr, r32, hi);
    finishSM(pB0, pB1, alB, l_reg, pa0, pa1, pa2, pa3); SBAR();
    if (j + 3 < NT) SLOAD(SE, (j + 3) * KVBLK); SBAR();
    pv_d0(o, vb0 + (int)SHM_V, pa0, pa1, pa2, pa3); partialSM(pA0, pA1, m_reg, mnA, alA);
    __syncthreads(); SWAIT(); SWRITE(1, SO);
    RESC(alA); __syncthreads();
  }
  SBAR(); qkt(pB0, pB1, (bf16_t*)((char*)K_lds + SHM_K), qr, r32, hi);
  finishSM(pA0, pA1, alA, l_reg, pa0, pa1, pa2, pa3); SBAR();
  pv_d0(o, vb0, pa0, pa1, pa2, pa3); partialSM(pB0, pB1, m_reg, mnB, alB);
  __syncthreads(); RESC(alB);
  finishSM(pB0, pB1, alB, l_reg, pa0, pa1, pa2, pa3); SBAR();
  pv_d0(o, vb0 + (int)SHM_V, pa0, pa1, pa2, pa3);
  if (hi == 0) li_l[r32] = l_reg; asm volatile("s_waitcnt lgkmcnt(0)" ::: "memory");
  float rli[16];
#pragma unroll
  for (int r = 0; r < 16; ++r) rli[r] = __builtin_amdgcn_rcpf(li_l[crow(r, hi)]);
  bf16_t* Ow = Ob + (long)(wid * QBLK) * LDO;
#pragma unroll
  for (int r = 0; r < 16; ++r) { int orow = crow(r, hi);
    for (int d0 = 0; d0 < 4; ++d0) Ow[(long)orow * LDO + d0 * 32 + r32] = (bf16_t)f2bf(o[d0][r] * rli[r]); }
  __syncthreads();
#undef SLOAD
#undef SWRITE
#undef SWAIT
#undef RESC
}
#else
inline void attn_dense_body(const bf16_t* Qb, const bf16_t* Kh, const bf16_t* Vh, bf16_t* Ob, int seq, char*) {
  const int tid = threadIdx.x; if (tid >= 256) return;
  const bf16_t* q = Qb + (long)tid * LDQ; std::vector<float> sc(seq); float mx = -1e30f;
  for (int k = 0; k < seq; ++k) { float s = 0; for (int d = 0; d < HD; ++d) s += bf2f(q[d]) * bf2f(Kh[(long)k * LDK + d]); sc[k] = s * SCALE; mx = fmaxf(mx, sc[k]); }
  float l = 0; for (int k = 0; k < seq; ++k) { sc[k] = expf(sc[k] - mx); l += sc[k]; }
  for (int d = 0; d < HD; ++d) { float o = 0; for (int k = 0; k < seq; ++k) o += sc[k] * bf2f(Vh[(long)k * LDK + d]); Ob[(long)tid * LDO + d] = (bf16_t)f2bf(o / l); }
}
#endif
}
DEV void phase_attn(const Params& P, const Ctx& C, bool need_ctx) {
    constexpr int QBL = TL / 256, QBC = TC / 256, NUL = NB * AH * QBL;
    const int nu = NUL + (need_ctx ? NB * AH * QBC : 0);
    for (int u = C.bid; u < nu; u += C.nblk) {
        const bool lat = u < NUL; const int v = lat ? u : u - NUL, nqb = lat ? QBL : QBC;
        const int qb = v % nqb, h = (v / nqb) % AH, b = v / (nqb * AH), kvh = h / (AH / AKV);
        const int row0 = lat ? lat_row(b, qb * 256) : ctx_row(b, qb * 256);
        const bf16_t* Kh = WSP(bf16_t, WS_KCAT) + (size_t)b * TT * KV_W + kvh * HD; const bf16_t* Vh = WSP(bf16_t, WS_VCAT) + (size_t)b * TT * KV_W + kvh * HD;
        att::attn_dense_body(WSP(bf16_t, WS_QA) + (size_t)row0 * ATT_W + h * HD, Kh, Vh, WSP(bf16_t, WS_Y) + (size_t)row0 * BW + h * HD, lat ? TT : TC, (char*)C.lds);
    }
}

constexpr size_t SM2_PE = 0;
constexpr int CW_PE = 2048, CW_NPAN = 2047;
static_assert(CW_PE + MOE_PANELS <= CW_BAR, "panel table fits below the barrier words");
DEV void phase_moe_gather(const Params& P, const Ctx& C) {
    const unsigned* cnt = WSP(unsigned, WS_CTL) + CW_CNT;
    int poff[NE + 1]; poff[0] = 0;
#pragma unroll
    for (int e = 0; e < NE; ++e) poff[e + 1] = poff[e] + (int)((cnt[e] + 255u) / 256u) * 256;
    if (C.bid == 0 && C.tid < MOE_PANELS) { int e = -1;
#pragma unroll
        for (int q = 0; q < NE; ++q) if (C.tid * 256 >= poff[q] && C.tid * 256 < poff[q + 1]) e = q;
        WSP(int, WS_CTL)[CW_PE + C.tid] = e < 0 ? 0 : e; if (C.tid == 0) WSP(int, WS_CTL)[CW_NPAN] = poff[NE] / 256; }
    const int* te = WSP(int, WS_SMALL + SM_TE); const float* tw = WSP(float, WS_SMALL + SM_TW); const int* tp = WSP(int, WS_SMALL + SM_TP);
    for (int i = C.gw; i < MLAT * 2; i += C.ngw) {
        const int tok = i >> 1, k = i & 1, e = te[i]; int base = 0;
#pragma unroll
        for (int q = 0; q < NE; ++q) if (q == e) base = poff[q];
        const int r = base + tp[i];
        const u32x4* src = (const u32x4*)(WSP(bf16_t, WS_H) + (size_t)tok * D); u32x4* dst = (u32x4*)(WSP(bf16_t, WS_APERM) + (size_t)r * D);
        for (int q = C.lane; q < D / 8; q += 64) dst[q] = src[q];
        if (C.lane == 0) { WSP(int, WS_SMALL + SM_RTOK)[r] = tok; WSP(float, WS_SMALL + SM_RW)[r] = tw[i]; WSP(int, WS_SMALL + SM_RSLOT)[r] = k; }
    }
}
DEV void phase_moe_combine(const Params& P, const Ctx& C, int l) {
    const int gt = C.bid * NTHREADS + C.tid, ngt = C.nblk * NTHREADS;
    const float* ys = WSP(float, WS_YS);
    for (int i = gt; i < MLAT * (D / 4); i += ngt) {
        const int row = i / (D / 4), col = (i % (D / 4)) * 4;
        const f32x4 g = *(const f32x4*)(mod_vec(P, l, row_vec(row), 5) + col);
        *(f32x4*)(P.out + (size_t)row * D + col) = *(const f32x4*)(WSP(float, WS_X1) + (size_t)row * D + col) + g * (*(const f32x4*)(ys + (size_t)row * D + col) + *(const f32x4*)(ys + ((size_t)MLAT + row) * D + col));
    }
}

#ifndef HOST_EMU
#define LAS __attribute__((address_space(3)))
#define XB_TMO      128
#define XB_XCNT(j)  (256  + 64 * (j))
#define XB_XSUB(j)  (1280 + 64 * (j))
#define XB_XGEN(j)  (2304 + 64 * (j))
#define XB_TOP      3328
#define XB_TOPGEN   3392
#define XCD_BAR_WORDS 3456
#define XB_SPIN_CAP (1u << 18)
__device__ __forceinline__ unsigned xb_ld(unsigned* p)              { return __hip_atomic_load(p, __ATOMIC_RELAXED, __HIP_MEMORY_SCOPE_AGENT); }
__device__ __forceinline__ unsigned xb_add(unsigned* p, unsigned v) { return __hip_atomic_fetch_add(p, v, __ATOMIC_RELAXED, __HIP_MEMORY_SCOPE_AGENT); }
__device__ __forceinline__ unsigned xb_xcc_id() { return (unsigned)__builtin_amdgcn_s_getreg((3 << 11) | 20) & 0xFu; }
#define XB_SPIN(cond, bar) do { unsigned _sp = 0; while (cond) { __builtin_amdgcn_s_sleep(1); \
    if ((++_sp & 255u) == 0u) { if (xb_ld(&(bar)[XB_TMO])) break; if (_sp > XB_SPIN_CAP) { atomicAdd(&(bar)[XB_TMO], 1u); break; } } } } while (0)
struct XcdBarrier { unsigned* bar; unsigned x; volatile LAS unsigned* st; };
__device__ __forceinline__ XcdBarrier xcd_barrier_post(unsigned* bar, volatile LAS unsigned* st) {
    XcdBarrier b; b.bar = bar; b.x = xb_xcc_id(); b.st = st;
    if (threadIdx.x == 0) (void)xb_add(&bar[XB_XCNT(b.x)], 1u);
    return b;
}
__device__ __forceinline__ void xcd_barrier_complete(unsigned* bar, unsigned x, unsigned& nloc, unsigned& nx) {
    const unsigned G = gridDim.x * gridDim.y * gridDim.z;
    unsigned sum, cnt, mine, sp = 0u;
    for (;;) {
        sum = 0u; cnt = 0u; mine = 0u;
#pragma unroll
        for (unsigned j = 0; j < 16; ++j) { const unsigned c = xb_ld(&bar[XB_XCNT(j)]); sum += c; cnt += (c > 0u) ? 1u : 0u; mine = (j == x) ? c : mine; }
        if (sum == G) break;
        __builtin_amdgcn_s_sleep(1);
        if ((++sp & 255u) == 0u) { if (xb_ld(&bar[XB_TMO])) break; if (sp > XB_SPIN_CAP) { atomicAdd(&bar[XB_TMO], 1u); break; } }
    }
    nloc = mine > 0u ? mine : 1u; nx = cnt > 0u ? cnt : 1u;
}
__device__ __forceinline__ void xcd_barrier(const XcdBarrier& b) {
    asm volatile("s_waitcnt vmcnt(0)" ::: "memory");
    __syncthreads();
    if (threadIdx.x == 0) {
        unsigned* bar = b.bar;
        __builtin_amdgcn_s_waitcnt(0);
        unsigned nloc = b.st[0], nx = b.st[1];
        if (nloc == 0u) { xcd_barrier_complete(bar, b.x, nloc, nx); b.st[0] = nloc; b.st[1] = nx; }
        const unsigned old = xb_add(&bar[XB_XSUB(b.x)], 1u);
        const unsigned gen = old / nloc;
        if (old + 1u == (gen + 1u) * nloc) {
            __builtin_amdgcn_fence(__ATOMIC_RELEASE, "agent");
            asm volatile("s_waitcnt vmcnt(0)" ::: "memory");
            const unsigned og = xb_add(&bar[XB_TOP], 1u);
            const unsigned tg = og / nx;
            if (og + 1u == (tg + 1u) * nx) xb_add(&bar[XB_TOPGEN], 1u);
            else XB_SPIN(xb_ld(&bar[XB_TOPGEN]) == tg, bar);
            __builtin_amdgcn_fence(__ATOMIC_ACQUIRE, "agent");
            xb_add(&bar[XB_XGEN(b.x)], 1u);
            asm volatile("s_waitcnt vmcnt(0)" ::: "memory");
        } else {
            XB_SPIN(xb_ld(&bar[XB_XGEN(b.x)]) == gen, bar);
            __builtin_amdgcn_fence(__ATOMIC_ACQUIRE, "agent");
            asm volatile("s_waitcnt vmcnt(0)" ::: "memory");
        }
    }
    __syncthreads();
}
#define GEMM_LDS(C) ((PG8_LAS unsigned char*)(C).lds)
#else
struct XcdBarrier { int dummy; };
inline void xcd_barrier(const XcdBarrier&) {}
#define GEMM_LDS(C) ((C).lds)
#endif

constexpr int NPL = 13, NPHASES = 2 + DEPTH * NPL;
DEV void run_phases(const Params& P, unsigned char* ldsp, const int lo, const int hi, const XcdBarrier& bar) {
#define C make_ctx(ldsp)
#define IN(k) (lo <= (k) && (k) < hi)
#define SEAM(k) do { if (IN(k) && IN((k) + 1)) xcd_barrier(bar); } while (0)
    if (IN(0)) { phase_weights(P, C); phase_mod_partial(P, C); }
    SEAM(0);
    if (IN(1)) phase_mod_final(P, C);
    SEAM(1);
    for (int l = 0; l < DEPTH; ++l) {
        const int pb = 2 + l * NPL; const bool need_ctx = l < DEPTH - 1, moe = (l & 1) != 0;
        const int rows = need_ctx ? MT : MLAT;
        if (IN(pb + 0)) phase_hpass(P, C, l, 0, false);
        SEAM(pb + 0);
        if (IN(pb + 1)) {
            pg8::Gemm g{WSP(bf16_t, WS_H), WSP(bf16_t, WS_WIN) + (size_t)l * NP * D, D};
            pg8::PanelOrder S; S.init(MT / 256, NP / 256, C.nblk, C.bid, nullptr);
            EpiInProj E{WSP(bf16_t, WS_P), WSP(float, WS_G16)};
            pg8::gemm_phase<EpiInProj, pg8::PanelOrder, true, true>(GEMM_LDS(C), g, S, E);
        }
        SEAM(pb + 1);
        if (IN(pb + 2)) phase_fixup(P, C, l, need_ctx);
        SEAM(pb + 2);
        if (IN(pb + 3)) phase_s1(P, C, l);
        SEAM(pb + 3);
        if (IN(pb + 4)) phase_s2(P, C);
        SEAM(pb + 4);
        if (IN(pb + 5)) { phase_attn(P, C, need_ctx); phase_s3(P, C, l, need_ctx); }
        SEAM(pb + 5);
        if (IN(pb + 6)) {
            for (int n = 0; n < 3; ++n) {
                pg8::Gemm g{WSP(bf16_t, WS_Y) + (size_t)n * MT * BW, WSP(bf16_t, WS_WBR) + (size_t)(l * 3 + n) * D * BW, BW};
                pg8::PanelOrder S; S.init(rows / 256, D / 256, C.nblk, C.bid, nullptr);
                EpiBranch E{WSP(bf16_t, WS_P), WSP(float, WS_MGF), WSP(bf16_t, WS_MG), n};
                pg8::gemm_phase<EpiBranch, pg8::PanelOrder, true, true>(GEMM_LDS(C), g, S, E);
            }
        }
        SEAM(pb + 6);
        if (IN(pb + 7)) {
            pg8::Gemm g{WSP(bf16_t, WS_MG), WSP(bf16_t, WS_WOUT) + (size_t)l * D * D, D};
            pg8::PanelOrder S; S.init(rows / 256, D / 256, C.nblk, C.bid, nullptr);
            const float* bL = l == 0 ? P.x : WSP(float, WS_X2); const float* bC = l == 0 ? P.ctx : WSP(float, WS_X2) + (size_t)MLAT * D;
            EpiResid E{bL, bC, WSP(float, WS_X1), WSP(float, WS_X1) + (size_t)MLAT * D, mod_vec(P, l, 0, 2), false, nullptr, nullptr, nullptr, nullptr};
            pg8::gemm_phase<EpiResid, pg8::PanelOrder, true, true>(GEMM_LDS(C), g, S, E);
        }
        SEAM(pb + 7);
        if (IN(pb + 8)) phase_hpass(P, C, l, 1, moe);
        SEAM(pb + 8);
        if (IN(pb + 9)) { if (moe) phase_moe_gather(P, C); }
        SEAM(pb + 9);
        if (IN(pb + 10)) {
            pg8::Gemm g{moe ? WSP(bf16_t, WS_APERM) : WSP(bf16_t, WS_H), moe ? WSP(bf16_t, WS_WMGU) + (size_t)(l / 2) * NE * 2 * DFF * D : WSP(bf16_t, WS_WGU) + (size_t)(l / 2) * 2 * DFF * D, D};
            pg8::PanelOrder S; S.init(moe ? WSP(int, WS_CTL)[CW_NPAN] : rows / 256, 2 * DFF / 256, C.nblk, C.bid, moe ? WSP(int, WS_CTL) + CW_PE : nullptr);
            EpiGU E{WSP(bf16_t, WS_ACT)};
            pg8::gemm_phase<EpiGU, pg8::PanelOrder, true, true>(GEMM_LDS(C), g, S, E);
        }
        SEAM(pb + 10);
        if (IN(pb + 11)) {
            pg8::Gemm g{WSP(bf16_t, WS_ACT), moe ? WSP(bf16_t, WS_WMDN) + (size_t)(l / 2) * NE * D * DFF : WSP(bf16_t, WS_WDN) + (size_t)(l / 2) * D * DFF, DFF};
            pg8::PanelOrder S; S.init(moe ? WSP(int, WS_CTL)[CW_NPAN] : rows / 256, D / 256, C.nblk, C.bid, moe ? WSP(int, WS_CTL) + CW_PE : nullptr);
            float* oL = (l == DEPTH - 1) ? P.out : WSP(float, WS_X2);
            EpiResid E{WSP(float, WS_X1), WSP(float, WS_X1) + (size_t)MLAT * D, oL, WSP(float, WS_X2) + (size_t)MLAT * D, mod_vec(P, l, 0, 5), moe,
                       WSP(int, WS_SMALL + SM_RTOK), WSP(float, WS_SMALL + SM_RW), WSP(int, WS_SMALL + SM_RSLOT), WSP(float, WS_YS)};
            pg8::gemm_phase<EpiResid, pg8::PanelOrder, true, true>(GEMM_LDS(C), g, S, E);
        }
        SEAM(pb + 11);
        if (IN(pb + 12)) { if (moe) phase_moe_combine(P, C, l); }
        if (l + 1 < DEPTH) SEAM(pb + 12);
    }
#undef IN
#undef SEAM
#undef C
}

struct Args { Params P; int ph_lo, ph_hi; };
#if !defined(HOST_EMU) && !defined(NO_MAIN_KERNEL)
constexpr int MISC_OFF = 131072 + 320;
__global__ void __launch_bounds__(NTHREADS, 2) hybrid_fwd(Args a) {
    extern __shared__ __attribute__((aligned(16))) unsigned char lds[];
    volatile LAS unsigned* MISC = (volatile LAS unsigned*)((LAS unsigned char*)lds + MISC_OFF);
    if (threadIdx.x < 32) MISC[threadIdx.x] = 0u;
    __syncthreads();
    XcdBarrier bar = xcd_barrier_post((unsigned*)(a.P.ws + WS_CTL) + CW_BAR, MISC + 8);
    run_phases(a.P, lds, a.ph_lo, a.ph_hi, bar);
}

#ifndef N_LAUNCH_MODE
#define N_LAUNCH_MODE 0
#endif
extern "C" void kernel_launch(void* const* d_in, const int* in_sizes, int n_in, void* d_out, int out_size, void* d_ws, size_t ws_size, hipStream_t stream) {
    static int grid = 0;
    if (grid == 0) {
        if (n_in != 25 || in_sizes[0] != MLAT * D || out_size != MLAT * D || ws_size < WS_END) {
            fprintf(stderr, "kernel_launch: unexpected shapes: n_in %d in0 %d out %d ws %zu (need %zu)\n", n_in, n_in > 0 ? in_sizes[0] : -1, out_size, ws_size, (size_t)WS_END); grid = -1; return; }
        int dev = 0, cus = 0, per_cu = 0;
        if (hipGetDevice(&dev) != hipSuccess || hipDeviceGetAttribute(&cus, hipDeviceAttributeMultiprocessorCount, dev) != hipSuccess) { grid = -1; return; }
        if (hipFuncSetAttribute((const void*)hybrid_fwd, hipFuncAttributeMaxDynamicSharedMemorySize, LDS_BYTES) != hipSuccess) { fprintf(stderr, "kernel_launch: hipFuncSetAttribute failed\n"); grid = -1; return; }
        if (hipOccupancyMaxActiveBlocksPerMultiprocessor(&per_cu, (const void*)hybrid_fwd, NTHREADS, LDS_BYTES) != hipSuccess || per_cu < 1) fprintf(stderr, "kernel_launch: occupancy query says %d\n", per_cu);
        (void)hipGetLastError();
        grid = cus;
    }
    if (grid < 0) return;
    (void)hipMemsetAsync((char*)d_ws + WS_CTL, 0, CTL_BYTES, stream);
    Args a{};
    const float** pp = (const float**)&a.P;
    for (int i = 0; i < 25; ++i) pp[i] = (const float*)d_in[i];
    a.P.out = (float*)d_out; a.P.ws = (unsigned char*)d_ws;
    if (N_LAUNCH_MODE == 1) { a.ph_lo = 0; a.ph_hi = NPHASES; hipLaunchKernelGGL(hybrid_fwd, dim3(grid), dim3(NTHREADS), LDS_BYTES, stream, a); }
    else for (int ph = 0; ph < NPHASES; ++ph) { a.ph_lo = ph; a.ph_hi = ph + 1; hipLaunchKernelGGL(hybrid_fwd, dim3(grid), dim3(NTHREADS), LDS_BYTES, stream, a); }
    const hipError_t le = hipPeekAtLastError();
    if (le != hipSuccess) fprintf(stderr, "kernel_launch: launch failed: %s\n", hipGetErrorName(le));
}
#endif
```

```cpp
#ifdef HOST_EMU
#include "emu.h"
#define DEV inline
#define WAVE_LDS_SYNC() emu::wave_barrier()
#define MFMA32(a, b, c) emu_mfma_32x32x16_bf16((a), (b), (c))
#define LDS_BASE() EMU_LDS_BASE()
#else
#include <hip/hip_runtime.h>
#include <cstdio>
#define DEV __device__ __forceinline__
#define WAVE_LDS_SYNC() asm volatile("s_waitcnt lgkmcnt(0)" ::: "memory")
#define MFMA32(a, b, c) __builtin_amdgcn_mfma_f32_32x32x16_bf16((a), (b), (c), 0, 0, 0)
typedef short bf16x8 __attribute__((ext_vector_type(8)));
typedef float f32x16 __attribute__((ext_vector_type(16)));
typedef float f32x4 __attribute__((ext_vector_type(4)));
#endif
typedef unsigned short bf16_t;
typedef unsigned u32x4 __attribute__((ext_vector_type(4)));
typedef unsigned u32x2 __attribute__((ext_vector_type(2)));
typedef float f32x2 __attribute__((ext_vector_type(2)));

#ifdef SMALL_CFG
constexpr int D = 512, NB = 2, TL = 256, TC = 256, AH = 4, AKV = 2, MLH = 2, HGH = 4, DFF = 768;
#else
constexpr int D = 2048, NB = 2, TL = 4096, TC = 256, AH = 8, AKV = 2, MLH = 4, HGH = 8, DFF = 5632;
#endif
constexpr int DEPTH = 2, GRIDW = 64, HD = 128, ATT_W = AH * HD, KV_W = AKV * HD, MDK = 256, MDV = 256, ML_W = MLH * MDV, HDK = 128, HDV = 128, HG_W = HGH * HDV;
constexpr int BW = ATT_W, NE = 8, CH = 64, NV = NB + 1;
constexpr float EPS = 1e-6f;
constexpr int MLAT = NB * TL, MCTX = NB * TC, MT = MLAT + MCTX, TT = TC + TL, NCH = TT / CH, NCHC = TC / CH;
constexpr int NG = 4 * MLH;
static_assert(ML_W == BW && HG_W == BW && NG <= 16 && TC % 256 == 0 && TL % 256 == 0 && D % 256 == 0 && DFF % 128 == 0, "config");
constexpr int OQ = 0, OK_ = OQ + ATT_W, OV = OK_ + KV_W, OMQ = OV + KV_W, OMK = OMQ + ML_W, OMV = OMK + ML_W, OMO = OMV + ML_W, OMG = OMO + ML_W;
constexpr int OHQ = OMG + NG, OHF = OHQ + HG_W, OHB = OHF + HG_W, OHI = OHB + HG_W, OHG = OHI + HG_W, OGATE = OHG + HG_W, N_IN = OGATE + 3 * D;
constexpr int PQ = OQ, PK = OK_, PV = OV, PMQ = OMQ, PMK = OMK, PMV = OMV, PMO = OMO, PHQ = OMG, PHF = PHQ + HG_W, PHB = PHF + HG_W, PHI = PHB + HG_W, PHG = PHI + HG_W, PGATE = PHG + HG_W;
constexpr int NPB = N_IN - NG, NP = NPB + 256;
static_assert(NPB % 256 == 0 && PGATE + 3 * D == NPB, "projection layout");
constexpr int MOE_ROWS = MLAT * 2 + NE * 256, MOE_PANELS = MOE_ROWS / 256;
constexpr int NSQM = NB * MLH * 2, NSQH = NB * HGH * 2;

constexpr size_t al256(size_t x) { return (x + 255) / 256 * 256; }
constexpr size_t WS_CTL = 0, CTL_BYTES = 1u << 20;
constexpr size_t WS_MODP = WS_CTL + CTL_BYTES;
constexpr size_t WS_MOD = WS_MODP + al256((size_t)(D / 64) * DEPTH * NV * 6 * D * 4);
constexpr size_t WS_LB = WS_MOD + al256((size_t)DEPTH * NV * 6 * D * 4);
constexpr size_t WS_WIN = WS_LB + al256((size_t)DEPTH * HG_W * 4);
constexpr size_t WS_WBR = WS_WIN + al256((size_t)DEPTH * NP * D * 2);
constexpr size_t WS_WOUT = WS_WBR + al256((size_t)DEPTH * 3 * D * BW * 2);
constexpr size_t WS_WGU = WS_WOUT + al256((size_t)DEPTH * D * D * 2);
constexpr size_t WS_WDN = WS_WGU + al256((size_t)2 * DFF * D * 2);
constexpr size_t WS_WMGU = WS_WDN + al256((size_t)D * DFF * 2);
constexpr size_t WS_WMDN = WS_WMGU + al256((size_t)NE * 2 * DFF * D * 2);
constexpr size_t WS_H = WS_WMDN + al256((size_t)NE * D * DFF * 2);
constexpr size_t WS_G16 = WS_H + al256((size_t)MT * D * 2);
constexpr size_t WS_QA = WS_G16 + al256((size_t)MT * 16 * 4);
constexpr size_t WS_KCAT = WS_QA + al256((size_t)MT * ATT_W * 2);
constexpr size_t WS_VCAT = WS_KCAT + al256((size_t)NB * TT * KV_W * 2);
constexpr size_t WS_QM = WS_VCAT + al256((size_t)NB * TT * KV_W * 2);
constexpr size_t WS_KM = WS_QM + al256((size_t)MT * ML_W * 2);
constexpr size_t WS_Y = WS_KM + al256((size_t)MT * ML_W * 2);
constexpr size_t WS_MGF = WS_Y + al256((size_t)3 * MT * BW * 2);
constexpr size_t WS_MG = WS_MGF + al256((size_t)MT * D * 4);
constexpr size_t WS_X1 = WS_MG + al256((size_t)MT * D * 2);
constexpr size_t WS_X2 = WS_X1 + al256((size_t)MT * D * 4);
constexpr size_t WS_SMALL = WS_X2 + al256((size_t)MT * D * 4);
constexpr size_t SM_FL = 0;
constexpr size_t SM_MLOC = SM_FL + al256((size_t)NSQM * NCH * 4);
constexpr size_t SM_MST = SM_MLOC + al256((size_t)NSQM * NCH * 4);
constexpr size_t SM_NLOC = SM_MST + al256((size_t)NSQM * NCH * 4);
constexpr size_t SM_LAM = SM_NLOC + al256((size_t)NSQM * NCH * MDK * 4);
constexpr size_t SM_TE = SM_LAM + al256((size_t)NSQH * NCH * HDK * 4);
constexpr size_t SM_TW = SM_TE + al256((size_t)MLAT * 2 * 4);
constexpr size_t SM_TP = SM_TW + al256((size_t)MLAT * 2 * 4);
constexpr size_t SM_RTOK = SM_TP + al256((size_t)MLAT * 2 * 4);
constexpr size_t SM_RW = SM_RTOK + al256((size_t)MOE_ROWS * 4);
constexpr size_t SM_RSLOT = SM_RW + al256((size_t)MOE_ROWS * 4);
constexpr size_t SM_END = SM_RSLOT + al256((size_t)MOE_ROWS * 4);
constexpr size_t WS_BIG = WS_SMALL + SM_END;
constexpr size_t WS_P = WS_BIG;
constexpr size_t WS_ACT = WS_BIG;
constexpr size_t WS_APERM = WS_ACT + al256((size_t)MOE_ROWS * DFF * 2);
constexpr size_t BIG_BYTES = al256((size_t)MT * NPB * 2) > al256((size_t)MOE_ROWS * DFF * 2) + al256((size_t)MOE_ROWS * D * 2) ? al256((size_t)MT * NPB * 2) : al256((size_t)MOE_ROWS * DFF * 2) + al256((size_t)MOE_ROWS * D * 2);
constexpr size_t WS_ST = WS_BIG + BIG_BYTES;
constexpr size_t WS_CSTM = WS_ST;
constexpr size_t WS_CSTH = WS_CSTM + al256((size_t)NSQM * NCH * MDV * MDK * 2);
constexpr size_t WS_YS = WS_ST;
constexpr size_t ST_BYTES = al256((size_t)NSQM * NCH * MDV * MDK * 2) + al256((size_t)NSQH * NCH * HDV * HDK * 2) > al256((size_t)2 * MLAT * D * 4) ? al256((size_t)NSQM * NCH * MDV * MDK * 2) + al256((size_t)NSQH * NCH * HDV * HDK * 2) : al256((size_t)2 * MLAT * D * 4);
constexpr size_t WS_END = WS_ST + ST_BYTES;
constexpr int CW_BAR = 4096;
constexpr int CW_CNT = 1024;

constexpr int NTHREADS = 512, NWAVES = 8;
constexpr int LDS_BYTES = 147456;

struct Params {
    const float *x, *c, *ctx, *c_ctx, *w_mod, *b_mod, *norm1_g, *norm2_g, *w_in, *qn_g, *kn_g, *conv_w, *gate_b, *ml_norm_g, *lb_logits, *hg_norm_g,
        *w_branch, *w_out, *ffn_wg, *ffn_wu, *ffn_wd, *moe_wr, *moe_wg, *moe_wu, *moe_wd;
    float* out; unsigned char* ws;
};

DEV unsigned fbits(float f) { return __builtin_bit_cast(unsigned, f); }
DEV float bitsf(unsigned u) { return __builtin_bit_cast(float, u); }
DEV float bf2f(bf16_t h) { return bitsf(((unsigned)h) << 16); }
DEV unsigned f2bf(float f) { const unsigned u = fbits(f); return (u + 0x7fffu + ((u >> 16) & 1u)) >> 16; }
DEV unsigned pk2(float lo, float hi) { return f2bf(lo) | (f2bf(hi) << 16); }
#ifdef HOST_EMU
DEV float fexp(float x) { return expf(x); }
#else
DEV float fexp(float x) { return __builtin_amdgcn_exp2f(x * 1.4426950408889634f); }
#endif
DEV float sigmoidf_(float x) { return 1.0f / (1.0f + expf(-x)); }
DEV float siluf_(float x) { return x * sigmoidf_(x); }
DEV float logsigmoidf_(float x) { return fminf(x, 0.f) - log1pf(expf(-fabsf(x))); }
DEV float wave_sum(float v) {
#pragma unroll
    for (int o = 1; o < 64; o <<= 1) v += __shfl_xor(v, o);
    return v;
}
DEV int crow(int r, int hi) { return (r & 3) + 8 * (r >> 2) + 4 * hi; }
DEV void unpack8(const u32x4 w, float (&f)[8]) {
    f[0] = bitsf(w.x << 16); f[1] = bitsf(w.x & 0xffff0000u); f[2] = bitsf(w.y << 16); f[3] = bitsf(w.y & 0xffff0000u);
    f[4] = bitsf(w.z << 16); f[5] = bitsf(w.z & 0xffff0000u); f[6] = bitsf(w.w << 16); f[7] = bitsf(w.w & 0xffff0000u);
}
DEV u32x4 pack8(const float (&f)[8]) { u32x4 w; w.x = pk2(f[0], f[1]); w.y = pk2(f[2], f[3]); w.z = pk2(f[4], f[5]); w.w = pk2(f[6], f[7]); return w; }
DEV int lat_row(int b, int t) { return b * TL + t; }
DEV int ctx_row(int b, int t) { return MLAT + b * TC + t; }
DEV int seq_row(int b, int d, int p) {
    if (p < TC) return ctx_row(b, d ? TC - 1 - p : p);
    const int t = p - TC; return lat_row(b, d ? TL - 1 - t : t);
}
DEV int dir_chunk(int cc, int d) { if (!d) return cc; return cc < NCHC ? NCHC - 1 - cc : NCH - 1 - (cc - NCHC); }
DEV int chunk_row0(int b, int cc) { return cc < NCHC ? ctx_row(b, cc * CH) : lat_row(b, (cc - NCHC) * CH); }
DEV int row_vec(int row) { return row < MLAT ? row / TL : NB; }

#ifdef HOST_EMU
DEV int opaque_tid() { return threadIdx.x; }
#else
DEV int opaque_tid() { int t = threadIdx.x; asm volatile("" : "+v"(t)); return t; }
#endif
struct Ctx {
    int tid, lane, wave, gw, ngw, bid, nblk; unsigned char* lds;
};
DEV Ctx make_ctx(unsigned char* lds) {
    Ctx c; c.tid = opaque_tid(); c.lane = c.tid & 63; c.wave = c.tid >> 6; c.bid = blockIdx.x; c.nblk = gridDim.x; c.gw = c.bid * NWAVES + c.wave; c.ngw = c.nblk * NWAVES; c.lds = lds; return c;
}
#define WSP(T, off) ((T*)(P.ws + (off)))

struct Job { const float* src; int K, ld, c0, nc; bf16_t* dst; int r0, mode; };
constexpr int NJOBS = DEPTH * 6 + 3 + NE * 3;
DEV Job get_job(const Params& P, int j) {
    Job J; J.mode = 0; J.r0 = 0; J.c0 = 0;
    if (j < DEPTH * 6) {
        const int l = j / 6, k = j % 6;
        if (k == 0) { J.src = P.w_in + (size_t)l * D * N_IN; J.K = D; J.ld = N_IN; J.c0 = 0; J.nc = OMG; J.dst = WSP(bf16_t, WS_WIN) + (size_t)l * NP * D; J.r0 = 0; }
        else if (k == 1) { J.src = P.w_in + (size_t)l * D * N_IN; J.K = D; J.ld = N_IN; J.c0 = OMG + NG; J.nc = N_IN - OMG - NG; J.dst = WSP(bf16_t, WS_WIN) + (size_t)l * NP * D; J.r0 = OMG; }
        else if (k < 5) { const int n = k - 2; J.src = P.w_branch + (size_t)(l * 3 + n) * BW * D; J.K = BW; J.ld = D; J.nc = D; J.dst = WSP(bf16_t, WS_WBR) + (size_t)(l * 3 + n) * D * BW; }
        else { J.src = P.w_out + (size_t)l * D * D; J.K = D; J.ld = D; J.nc = D; J.dst = WSP(bf16_t, WS_WOUT) + (size_t)l * D * D; }
        return J;
    }
    j -= DEPTH * 6;
    if (j < 3) {
        if (j == 0) { J.src = P.ffn_wg; J.K = D; J.ld = DFF; J.nc = DFF; J.dst = WSP(bf16_t, WS_WGU); J.r0 = 0; J.mode = 1; }
        else if (j == 1) { J.src = P.ffn_wu; J.K = D; J.ld = DFF; J.nc = DFF; J.dst = WSP(bf16_t, WS_WGU); J.r0 = 128; J.mode = 1; }
        else { J.src = P.ffn_wd; J.K = DFF; J.ld = D; J.nc = D; J.dst = WSP(bf16_t, WS_WDN); }
        return J;
    }
    j -= 3; const int e = j / 3, k = j % 3;
    if (k == 0) { J.src = P.moe_wg + (size_t)e * D * DFF; J.K = D; J.ld = DFF; J.nc = DFF; J.dst = WSP(bf16_t, WS_WMGU) + (size_t)e * 2 * DFF * D; J.r0 = 0; J.mode = 1; }
    else if (k == 1) { J.src = P.moe_wu + (size_t)e * D * DFF; J.K = D; J.ld = DFF; J.nc = DFF; J.dst = WSP(bf16_t, WS_WMGU) + (size_t)e * 2 * DFF * D; J.r0 = 128; J.mode = 1; }
    else { J.src = P.moe_wd + (size_t)e * DFF * D; J.K = DFF; J.ld = D; J.nc = D; J.dst = WSP(bf16_t, WS_WMDN) + (size_t)e * D * DFF; }
    return J;
}
DEV int job_items(const Job& J) { return (J.K / 64) * (J.nc / 32); }
DEV void transpose_item(const Job& J, int item, float* scr, int lane) {
    const int nblk = J.nc / 32, kb = item / nblk, nb = item % nblk, k0 = 64 * kb, n0 = 32 * nb;
#pragma unroll 8
    for (int i = 0; i < 32; ++i) { const int kk = 2 * i + (lane >> 5); scr[kk * 33 + (lane & 31)] = J.src[(size_t)(k0 + kk) * J.ld + J.c0 + n0 + (lane & 31)]; }
    WAVE_LDS_SYNC();
    const int c = lane & 7;
#pragma unroll
    for (int jj = 0; jj < 4; ++jj) { const int n = (lane >> 3) + 8 * jj; const float* s = scr + (8 * c) * 33 + n; const int nn = n0 + n;
        u32x4 o; o.x = pk2(s[0 * 33], s[1 * 33]); o.y = pk2(s[2 * 33], s[3 * 33]); o.z = pk2(s[4 * 33], s[5 * 33]); o.w = pk2(s[6 * 33], s[7 * 33]);
        const int row = J.mode ? J.r0 + 256 * (nn / 128) + (nn % 128) : J.r0 + nn;
        *(u32x4*)(J.dst + (size_t)row * J.K + k0 + 8 * c) = o; }
    WAVE_LDS_SYNC();
}
DEV void phase_weights(const Params& P, const Ctx& C) {
    float* scr = (float*)(C.lds + C.wave * 16384);
    int total = 0;
    for (int j = 0; j < NJOBS; ++j) total += job_items(get_job(P, j));
    for (int it = C.gw; it < total; it += C.ngw) {
        int r = it, j = 0; Job J = get_job(P, 0);
        for (;;) { const int n = job_items(J); if (r < n) break; r -= n; ++j; J = get_job(P, j); }
        transpose_item(J, r, scr, C.lane);
    }
    const int gt = C.bid * NTHREADS + C.tid, ngt = C.nblk * NTHREADS;
    for (int i = gt; i < DEPTH * 256 * (D / 8); i += ngt) {
        const int l = i / (256 * (D / 8)), r = (i / (D / 8)) % 256, k8 = (i % (D / 8)) * 8;
        float f[8];
#pragma unroll
        for (int q = 0; q < 8; ++q) f[q] = r < NG ? P.w_in[((size_t)l * D + k8 + q) * N_IN + OMG + r] : 0.f;
        *(u32x4*)(WSP(bf16_t, WS_WIN) + ((size_t)l * NP + NPB + r) * D + k8) = pack8(f);
    }
}
DEV const float* cvec_ptr(const Params& P, int v) { return v < NB ? P.c + (size_t)v * D : P.c_ctx; }
DEV void phase_mod_partial(const Params& P, const Ctx& C) {
    constexpr int NCG = 6 * D / 256, NKS = D / 64;
    for (int it = C.gw; it < DEPTH * NKS * NCG; it += C.ngw) {
        const int cg = it % NCG, ks = (it / NCG) % NKS, l = it / (NCG * NKS), col = cg * 256 + C.lane * 4;
        f32x4 acc[NV];
#pragma unroll
        for (int v = 0; v < NV; ++v) acc[v] = (f32x4){0.f, 0.f, 0.f, 0.f};
        for (int k = ks * 64; k < ks * 64 + 64; ++k) {
            const f32x4 w = *(const f32x4*)(P.w_mod + ((size_t)l * D + k) * 6 * D + col);
#pragma unroll
            for (int v = 0; v < NV; ++v) { const float s = siluf_(cvec_ptr(P, v)[k]); acc[v] += w * s; }
        }
#pragma unroll
        for (int v = 0; v < NV; ++v) *(f32x4*)(WSP(float, WS_MODP) + (((size_t)ks * DEPTH + l) * NV + v) * 6 * D + col) = acc[v];
    }
}
DEV void phase_mod_final(const Params& P, const Ctx& C) {
    constexpr int NKS = D / 64;
    const int gt = C.bid * NTHREADS + C.tid, ngt = C.nblk * NTHREADS;
    for (int i = gt; i < DEPTH * NV * 6 * D; i += ngt) {
        const int col = i % (6 * D), v = (i / (6 * D)) % NV, l = i / (6 * D * NV);
        float s = P.b_mod[(size_t)l * 6 * D + col];
        for (int ks = 0; ks < NKS; ++ks) s += WSP(float, WS_MODP)[(((size_t)ks * DEPTH + l) * NV + v) * 6 * D + col];
        WSP(float, WS_MOD)[((size_t)l * NV + v) * 6 * D + col] = s;
    }
    for (int i = gt; i < HG_W; i += ngt) {
        float mx = -1e30f; for (int l = 0; l < DEPTH; ++l) mx = fmaxf(mx, P.lb_logits[(size_t)l * HG_W + i]);
        float den = 0.f; for (int l = 0; l < DEPTH; ++l) den += expf(P.lb_logits[(size_t)l * HG_W + i] - mx);
        float cum = 0.f;
        for (int l = 0; l < DEPTH; ++l) { if (l > 0) cum += expf(P.lb_logits[(size_t)l * HG_W + i] - mx) / den; WSP(float, WS_LB)[(size_t)l * HG_W + i] = cum; }
    }
}
DEV const float* mod_vec(const Params& P, int l, int v, int idx) { return WSP(float, WS_MOD) + ((size_t)l * NV + v) * 6 * D + (size_t)idx * D; }

DEV void phase_hpass(const Params& P, const Ctx& C, int l, int which, bool router) {
    constexpr int NJ = D / 256;
    const int nrows = (which == 1 && l == DEPTH - 1) ? MLAT : MT;
    const float* g = (which ? P.norm2_g : P.norm1_g) + (size_t)l * D;
    for (int row = C.gw; row < nrows; row += C.ngw) {
        const float* src;
        if (which) src = WSP(float, WS_X1) + (size_t)row * D;
        else if (l == 0) src = row < MLAT ? P.x + (size_t)row * D : P.ctx + (size_t)(row - MLAT) * D;
        else src = WSP(float, WS_X2) + (size_t)row * D;
        const int v = row_vec(row);
        const float* sh = mod_vec(P, l, v, which ? 3 : 0); const float* sc = mod_vec(P, l, v, which ? 4 : 1);
        f32x4 x[NJ]; float ss = 0.f;
#pragma unroll
        for (int j = 0; j < NJ; ++j) { x[j] = *(const f32x4*)(src + 256 * j + 4 * C.lane); ss += (x[j].x * x[j].x + x[j].y * x[j].y) + (x[j].z * x[j].z + x[j].w * x[j].w); }
        const float rstd = 1.0f / sqrtf(wave_sum(ss) * (1.0f / D) + EPS);
        float lg[NE];
#pragma unroll
        for (int e = 0; e < NE; ++e) lg[e] = 0.f;
#pragma unroll
        for (int j = 0; j < NJ; ++j) {
            const int col = 256 * j + 4 * C.lane;
            const f32x4 gg = *(const f32x4*)(g + col), s1 = *(const f32x4*)(sc + col), s0 = *(const f32x4*)(sh + col);
            f32x4 y = x[j] * rstd * gg * (s1 + 1.0f) + s0;
            u32x2 o; o.x = pk2(y.x, y.y); o.y = pk2(y.z, y.w);
            *(u32x2*)(WSP(bf16_t, WS_H) + (size_t)row * D + col) = o;
            if (router) {
                const float* wr = P.moe_wr + (size_t)(l / 2) * D * NE + (size_t)col * NE;
#pragma unroll
                for (int q = 0; q < 4; ++q)
#pragma unroll
                    for (int e = 0; e < NE; ++e) lg[e] += y[q] * wr[q * NE + e];
            }
        }
        if (router) {
#pragma unroll
            for (int e = 0; e < NE; ++e) lg[e] = wave_sum(lg[e]);
            if (C.lane == 0) {
                int i0 = 0; float v0 = lg[0];
#pragma unroll
                for (int e = 1; e < NE; ++e) if (lg[e] > v0) { v0 = lg[e]; i0 = e; }
                int i1 = -1; float v1 = -3.0e38f;
#pragma unroll
                for (int e = 0; e < NE; ++e) if (e != i0 && lg[e] > v1) { v1 = lg[e]; i1 = e; }
                const float w1 = 1.0f / (1.0f + expf(v0 - v1)), w0 = 1.0f - w1;
                int* te = WSP(int, WS_SMALL + SM_TE) + row * 2; float* tw = WSP(float, WS_SMALL + SM_TW) + row * 2; int* tp = WSP(int, WS_SMALL + SM_TP) + row * 2;
                unsigned* cnt = WSP(unsigned, WS_CTL) + CW_CNT;
                te[0] = i0; te[1] = i1; tw[0] = w0; tw[1] = w1;
                tp[0] = (int)atomicAdd(cnt + i0, 1u); tp[1] = (int)atomicAdd(cnt + i1, 1u);
            }
        }
    }
    if (router) {
        const int gt = C.bid * NTHREADS + C.tid, ngt = C.nblk * NTHREADS;
        for (int i = gt; i < MOE_ROWS; i += ngt) WSP(int, WS_SMALL + SM_RTOK)[i] = -1;
    }
}

DEV void phase_fixup(const Params& P, const Ctx& C, int l, bool need_ctx) {
    const bf16_t* Pb = WSP(bf16_t, WS_P);
    const float* qg = P.qn_g + (size_t)l * HD; const float* kg = P.kn_g + (size_t)l * HD;
    const float* cw = P.conv_w + (size_t)l * 3 * 2 * ML_W;
    const int lane = C.lane, jf = lane & 31;
    const float invf = expf(-logf(10000.0f) * (float)(2 * jf) / 64.0f);
    for (int row = C.gw; row < MT; row += C.ngw) {
        const bool lat = row < MLAT;
        const int b = lat ? row / TL : (row - MLAT) / TC, t = lat ? row % TL : (row - MLAT) % TC, tseg = lat ? TL : TC;
        const bf16_t* pr = Pb + (size_t)row * NPB;
        float c0 = 1.f, s0 = 0.f, c1 = 1.f, s1 = 0.f;
        if (lat) { const float a0 = (float)(t / GRIDW) * invf, a1 = (float)(t % GRIDW) * invf; c0 = cosf(a0); s0 = sinf(a0); c1 = cosf(a1); s1 = sinf(a1); }
        const int pos = lat ? TC + t : t;
        for (int hh = 0; hh < AH + AKV; ++hh) {
            const bool isq = hh < AH;
            if (isq && !lat && !need_ctx) continue;
            const int col = isq ? PQ + hh * HD : PK + (hh - AH) * HD;
            float e0 = bf2f(pr[col + lane]), e1 = bf2f(pr[col + 64 + lane]);
            const float r = 1.0f / sqrtf(wave_sum(e0 * e0 + e1 * e1) * (1.0f / HD) + EPS);
            const float* gg = isq ? qg : kg;
            e0 *= r * gg[lane]; e1 *= r * gg[64 + lane];
            if (lat) {
                const float p0 = __shfl_xor(e0, 32), p1 = __shfl_xor(e1, 32);
                e0 = lane < 32 ? e0 * c0 - p0 * s0 : e0 * c0 + p0 * s0;
                e1 = lane < 32 ? e1 * c1 - p1 * s1 : e1 * c1 + p1 * s1;
            }
            bf16_t* dst = isq ? WSP(bf16_t, WS_QA) + (size_t)row * ATT_W + hh * HD : WSP(bf16_t, WS_KCAT) + ((size_t)b * TT + pos) * KV_W + (hh - AH) * HD;
            dst[lane] = (bf16_t)f2bf(e0); dst[64 + lane] = (bf16_t)f2bf(e1);
        }
        for (int cidx = lane * 4; cidx < KV_W; cidx += 256) *(u32x2*)(WSP(bf16_t, WS_VCAT) + ((size_t)b * TT + pos) * KV_W + cidx) = *(const u32x2*)(pr + PV + cidx);
        for (int cidx = lane * 8; cidx < 2 * ML_W; cidx += 512) {
            const bool isk = cidx >= ML_W; const int pc = isk ? PMK + (cidx - ML_W) : PMQ + cidx;
            float xm[8], x0[8], xp[8], o[8];
            unpack8(*(const u32x4*)(pr + pc), x0);
            if (t > 0) unpack8(*(const u32x4*)(pr - NPB + pc), xm); else { for (int q = 0; q < 8; ++q) xm[q] = 0.f; }
            if (t + 1 < tseg) unpack8(*(const u32x4*)(pr + NPB + pc), xp); else { for (int q = 0; q < 8; ++q) xp[q] = 0.f; }
            const float sc = isk ? 0.0625f : 1.0f;
#pragma unroll
            for (int q = 0; q < 8; ++q) o[q] = (xm[q] * cw[cidx + q] + x0[q] * cw[2 * ML_W + cidx + q] + xp[q] * cw[4 * ML_W + cidx + q]) * sc;
            bf16_t* dst = (isk ? WSP(bf16_t, WS_KM) + (size_t)row * ML_W + (cidx - ML_W) : WSP(bf16_t, WS_QM) + (size_t)row * ML_W + cidx);
            *(u32x4*)dst = pack8(o);
        }
    }
}

constexpr int MQP = MDK + 8, CP = CH + 8;
DEV void mlstm_s1_unit(const Params& P, const Ctx& C0, int l, int u) {
    const Ctx C = make_ctx(C0.lds);
    const int c = u % NCH, sq = u / NCH, d = sq & 1, h = (sq >> 1) % MLH, b = sq / (2 * MLH);
    bf16_t* KT = (bf16_t*)C.lds;
    bf16_t* VT = KT + MDK * CP;
    float* vec = (float*)(VT + MDV * CP);
    float* lf = vec, *li = vec + 64, *wsv = vec + 128;
    const float* G16 = WSP(float, WS_G16); const float* gb = P.gate_b + (size_t)l * NG;
    if (C.tid < CH) {
        const int row = seq_row(b, d, c * CH + C.tid);
        li[C.tid] = G16[(size_t)row * 16 + d * MLH + h] + gb[d * MLH + h];
        lf[C.tid] = logsigmoidf_(G16[(size_t)row * 16 + (2 + d) * MLH + h] + gb[(2 + d) * MLH + h]);
    }
    __syncthreads();
    if (C.tid == 0) {
        float fc = 0.f, tot = 0.f; for (int j = 0; j < CH; ++j) tot += lf[j];
        float mx = -3.0e38f;
        for (int j = 0; j < CH; ++j) { fc += lf[j]; const float gj = tot - fc + li[j]; wsv[j] = gj; mx = fmaxf(mx, gj); }
        for (int j = 0; j < CH; ++j) wsv[j] = expf(wsv[j] - mx);
        WSP(float, WS_SMALL + SM_FL)[sq * NCH + c] = tot; WSP(float, WS_SMALL + SM_MLOC)[sq * NCH + c] = mx;
    }
    __syncthreads();
    for (int i = C.tid; i < CH * (MDK / 8); i += NTHREADS) {
        const int s = i / (MDK / 8), cg = i % (MDK / 8), row = seq_row(b, d, c * CH + s);
        float kk[8], vv[8];
        unpack8(*(const u32x4*)(WSP(bf16_t, WS_KM) + (size_t)row * ML_W + h * MDK + cg * 8), kk);
        unpack8(*(const u32x4*)(WSP(bf16_t, WS_P) + (size_t)row * NPB + PMV + h * MDV + cg * 8), vv);
        const float w = wsv[s];
#pragma unroll
        for (int q = 0; q < 8; ++q) { KT[(cg * 8 + q) * CP + s] = (bf16_t)f2bf(kk[q]); VT[(cg * 8 + q) * CP + s] = (bf16_t)f2bf(vv[q] * w); }
    }
    __syncthreads();
    const int r32 = C.lane & 31, hi = C.lane >> 5, w = C.wave;
    f32x16 acc[8];
#pragma unroll
    for (int nb = 0; nb < 8; ++nb) acc[nb] = (f32x16){0};
#pragma unroll
    for (int ks = 0; ks < CH / 16; ++ks) {
        const bf16x8 a = *(const bf16x8*)(VT + (32 * w + r32) * CP + 16 * ks + 8 * hi);
#pragma unroll
        for (int nb = 0; nb < 8; ++nb) { const bf16x8 bb = *(const bf16x8*)(KT + (32 * nb + r32) * CP + 16 * ks + 8 * hi); acc[nb] = MFMA32(a, bb, acc[nb]); }
    }
    bf16_t* out = WSP(bf16_t, WS_CSTM) + ((size_t)sq * NCH + c) * MDV * MDK;
#pragma unroll
    for (int nb = 0; nb < 8; ++nb)
#pragma unroll
        for (int r = 0; r < 16; ++r) out[(size_t)(32 * w + crow(r, hi)) * MDK + 32 * nb + r32] = (bf16_t)f2bf(acc[nb][r]);
    if (C.tid < MDK) { float s = 0.f; for (int j = 0; j < CH; ++j) s += wsv[j] * bf2f(KT[C.tid * CP + j]); WSP(float, WS_SMALL + SM_NLOC)[((size_t)sq * NCH + c) * MDK + C.tid] = s; }
    __syncthreads();
}
DEV void mlstm_s2(const Params& P, const Ctx& C) {
    const int gt = C.bid * NTHREADS + C.tid, ngt = C.nblk * NTHREADS;
    constexpr int NG8 = MDV * MDK / 8;
    const float* FL = WSP(float, WS_SMALL + SM_FL); const float* MLOC = WSP(float, WS_SMALL + SM_MLOC);
    for (int i = gt; i < NSQM * NG8; i += ngt) {
        const int sq = i / NG8, g8 = i % NG8; float run[8];
#pragma unroll
        for (int q = 0; q < 8; ++q) run[q] = 0.f;
        float m_run = -1e30f;
        u32x4* p = (u32x4*)(WSP(bf16_t, WS_CSTM) + (size_t)sq * NCH * MDV * MDK + (size_t)g8 * 8);
        for (int c = 0; c < NCH; ++c) {
            float kl[8]; unpack8(p[(size_t)c * NG8], kl);
            p[(size_t)c * NG8] = pack8(run);
            const float fl = FL[sq * NCH + c], ml = MLOC[sq * NCH + c], mn = fmaxf(fl + m_run, ml), dec = expf(fl + m_run - mn), sl = expf(ml - mn);
#pragma unroll
            for (int q = 0; q < 8; ++q) run[q] = dec * run[q] + sl * kl[q];
            m_run = mn;
        }
    }
    for (int i = gt; i < NSQM * MDK; i += ngt) {
        const int sq = i / MDK, dk = i % MDK; float run = 0.f, m_run = -1e30f;
        float* p = WSP(float, WS_SMALL + SM_NLOC) + (size_t)sq * NCH * MDK + dk;
        for (int c = 0; c < NCH; ++c) {
            const float nl = p[(size_t)c * MDK]; p[(size_t)c * MDK] = run;
            const float fl = FL[sq * NCH + c], ml = MLOC[sq * NCH + c], mn = fmaxf(fl + m_run, ml), dec = expf(fl + m_run - mn), sl = expf(ml - mn);
            run = dec * run + sl * nl;
            if (dk == 0) WSP(float, WS_SMALL + SM_MST)[sq * NCH + c] = m_run;
            m_run = mn;
        }
    }
}
DEV void mlstm_s3_unit(const Params& P, const Ctx& C0, int l, int u) {
    const Ctx C = make_ctx(C0.lds);
    const int cc = u % NCH, h = (u / NCH) % MLH, b = u / (NCH * MLH);
    const int row0 = chunk_row0(b, cc);
    bf16_t* Qs = (bf16_t*)C.lds;
    bf16_t* Ks = Qs + CH * MQP;
    bf16_t* VT = Ks + CH * MQP;
    bf16_t* SC = VT + MDV * CP;
    float* vec = (float*)(SC + 2 * CH * CP);
    float* lfv = vec;
    float* liv = vec + 128;
    float* fcv = vec + 256;
    float* mtv = vec + 384;
    float* av = vec + 512;
    float* qnv = vec + 640;
    float* rinv = vec + 768;
    float* mst = vec + 896;
    float* HS = (float*)C.lds;
    const float* G16 = WSP(float, WS_G16); const float* gb = P.gate_b + (size_t)l * NG;
    const int sq0 = (b * MLH + h) * 2, c0 = dir_chunk(cc, 0), c1 = dir_chunk(cc, 1);
    if (C.tid < 2 * CH) {
        const int d = C.tid >> 6, j = C.tid & 63, row = row0 + j;
        liv[C.tid] = G16[(size_t)row * 16 + d * MLH + h] + gb[d * MLH + h];
        lfv[C.tid] = logsigmoidf_(G16[(size_t)row * 16 + (2 + d) * MLH + h] + gb[(2 + d) * MLH + h]);
        if (j == 0) mst[d] = WSP(float, WS_SMALL + SM_MST)[(sq0 + d) * NCH + (d ? c1 : c0)];
    }
    for (int i = C.tid; i < CH * (MDK / 8); i += NTHREADS) {
        const int s = i / (MDK / 8), cg = i % (MDK / 8), row = row0 + s;
        *(u32x4*)(Qs + s * MQP + cg * 8) = *(const u32x4*)(WSP(bf16_t, WS_QM) + (size_t)row * ML_W + h * MDK + cg * 8);
        *(u32x4*)(Ks + s * MQP + cg * 8) = *(const u32x4*)(WSP(bf16_t, WS_KM) + (size_t)row * ML_W + h * MDK + cg * 8);
        const u32x4 vv = *(const u32x4*)(WSP(bf16_t, WS_P) + (size_t)row * NPB + PMV + h * MDV + cg * 8);
        const unsigned wv[4] = {vv.x, vv.y, vv.z, vv.w};
#pragma unroll
        for (int q = 0; q < 8; ++q) VT[(cg * 8 + q) * CP + s] = (bf16_t)((wv[q >> 1] >> ((q & 1) * 16)) & 0xffffu);
    }
    __syncthreads();
    const int r32 = C.lane & 31, hi = C.lane >> 5, w = C.wave;
    f32x16 sacc = (f32x16){0};
    if (w < 4) {
        const int tb = w >> 1, sb = w & 1;
#pragma unroll
        for (int ks = 0; ks < MDK / 16; ++ks) {
            const bf16x8 a = *(const bf16x8*)(Qs + (32 * tb + r32) * MQP + 16 * ks + 8 * hi);
            const bf16x8 bb = *(const bf16x8*)(Ks + (32 * sb + r32) * MQP + 16 * ks + 8 * hi);
            sacc = MFMA32(a, bb, sacc);
        }
    } else if (C.tid == 256 || C.tid == 320) {
        const int d = (C.tid - 256) >> 6; const float ms = mst[d];
        float fc = 0.f, pm = -3.0e38f;
        for (int st = 0; st < CH; ++st) { const int j = d ? CH - 1 - st : st;
            fc += lfv[d * 64 + j]; fcv[d * 64 + j] = fc; pm = fmaxf(pm, liv[d * 64 + j] - fc);
            const float mt = fc + fmaxf(ms, pm); mtv[d * 64 + j] = mt; av[d * 64 + j] = expf(fc + ms - mt); }
    } else if (w >= 6) {
        const int d = w - 6, j = C.lane; const float* nst = WSP(float, WS_SMALL + SM_NLOC) + ((size_t)(sq0 + d) * NCH + (d ? c1 : c0)) * MDK;
        float s = 0.f; for (int k = 0; k < MDK; ++k) s += bf2f(Qs[j * MQP + k]) * nst[k];
        qnv[d * 64 + j] = s;
    }
    __syncthreads();
    if (w < 4) {
        const int tb = w >> 1, sb = w & 1, s = 32 * sb + r32;
#pragma unroll
        for (int d = 0; d < 2; ++d) { const float fs = fcv[d * 64 + s], ls = liv[d * 64 + s];
#pragma unroll
            for (int r = 0; r < 16; ++r) { const int t = 32 * tb + crow(r, hi); const bool ok = d ? (s >= t) : (s <= t);
                const float wgt = ok ? fexp(fcv[d * 64 + t] - fs + ls - mtv[d * 64 + t]) : 0.f;
                SC[(d * CH + t) * CP + s] = (bf16_t)f2bf(ok ? sacc[r] * wgt : 0.f);
                if ((r & 3) == 3) asm volatile("" ::: "memory"); } }
    }
    __syncthreads();
    if (C.tid < 2 * CH) { const int d = C.tid >> 6, t = C.tid & 63; float s = 0.f; for (int k = 0; k < CH; ++k) s += bf2f(SC[(d * CH + t) * CP + k]);
        const float den = s + av[C.tid] * qnv[C.tid]; rinv[C.tid] = 1.0f / fmaxf(fabsf(den), expf(-mtv[C.tid])); }
    __syncthreads();
    f32x16 hs[2]; hs[0] = (f32x16){0}; hs[1] = (f32x16){0};
#pragma unroll 1
    for (int d = 0; d < 2; ++d) {
        { f32x16 a1[2]; a1[0] = (f32x16){0}; a1[1] = (f32x16){0};
#pragma unroll
        for (int ks = 0; ks < CH / 16; ++ks) {
            const bf16x8 bb = *(const bf16x8*)(VT + (32 * w + r32) * CP + 16 * ks + 8 * hi);
            const bf16x8 x0 = *(const bf16x8*)(SC + (d * CH + r32) * CP + 16 * ks + 8 * hi), x1 = *(const bf16x8*)(SC + (d * CH + 32 + r32) * CP + 16 * ks + 8 * hi);
            a1[0] = MFMA32(x0, bb, a1[0]); a1[1] = MFMA32(x1, bb, a1[1]);
        }
#pragma unroll
        for (int r = 0; r < 16; ++r) { const int t = crow(r, hi); hs[0][r] += a1[0][r] * rinv[d * 64 + t]; hs[1][r] += a1[1][r] * rinv[d * 64 + 32 + t]; } }
        f32x16 a2[2]; a2[0] = (f32x16){0}; a2[1] = (f32x16){0};
        const bf16_t* cst = WSP(bf16_t, WS_CSTM) + ((size_t)(sq0 + d) * NCH + (d ? c1 : c0)) * MDV * MDK + (size_t)(32 * w + r32) * MDK + 8 * hi;
#pragma unroll 4
        for (int ks = 0; ks < MDK / 16; ++ks) {
            const bf16x8 bb = *(const bf16x8*)(cst + 16 * ks);
            const bf16x8 x0 = *(const bf16x8*)(Qs + r32 * MQP + 16 * ks + 8 * hi), x1 = *(const bf16x8*)(Qs + (32 + r32) * MQP + 16 * ks + 8 * hi);
            a2[0] = MFMA32(x0, bb, a2[0]); a2[1] = MFMA32(x1, bb, a2[1]);
        }
#pragma unroll
        for (int r = 0; r < 16; ++r) { const int t = crow(r, hi);
            hs[0][r] += av[d * 64 + t] * a2[0][r] * rinv[d * 64 + t];
            hs[1][r] += av[d * 64 + 32 + t] * a2[1][r] * rinv[d * 64 + 32 + t]; }
    }
    __syncthreads();
#pragma unroll
    for (int tb = 0; tb < 2; ++tb)
#pragma unroll
        for (int r = 0; r < 16; ++r) HS[(32 * tb + crow(r, hi)) * 257 + 32 * w + r32] = hs[tb][r];
    __syncthreads();
    const float* ng = P.ml_norm_g + (size_t)l * ML_W + h * MDV;
    for (int t = w; t < CH; t += NWAVES) {
        float v[4], ss = 0.f;
#pragma unroll
        for (int q = 0; q < 4; ++q) { v[q] = HS[t * 257 + C.lane * 4 + q]; ss += v[q] * v[q]; }
        const float rstd = 1.0f / sqrtf(wave_sum(ss) * (1.0f / MDV) + EPS);
        const int row = row0 + t; const u32x2 ov = *(const u32x2*)(WSP(bf16_t, WS_P) + (size_t)row * NPB + PMO + h * MDV + C.lane * 4);
        const float o0 = bitsf(ov.x << 16), o1 = bitsf(ov.x & 0xffff0000u), o2 = bitsf(ov.y << 16), o3 = bitsf(ov.y & 0xffff0000u);
        u32x2 y; y.x = pk2(v[0] * rstd * ng[C.lane * 4 + 0] * sigmoidf_(o0), v[1] * rstd * ng[C.lane * 4 + 1] * sigmoidf_(o1));
        y.y = pk2(v[2] * rstd * ng[C.lane * 4 + 2] * sigmoidf_(o2), v[3] * rstd * ng[C.lane * 4 + 3] * sigmoidf_(o3));
        *(u32x2*)(WSP(bf16_t, WS_Y) + ((size_t)1 * MT + row) * BW + h * MDV + C.lane * 4) = y;
    }
    __syncthreads();
}

constexpr int HQP = HDK + 8;
DEV float hg_f(float z, float lb) { return lb + (1.0f - lb) * sigmoidf_(z); }
DEV void hgrn_s1_unit(const Params& P, const Ctx& C0, int l, int u) {
    const Ctx C = make_ctx(C0.lds);
    const int cc = u % NCH, h = (u / NCH) % HGH, b = u / (NCH * HGH), row0 = chunk_row0(b, cc);
    bf16_t* KT = (bf16_t*)C.lds;
    bf16_t* VT = KT + 2 * HDK * CP;
    const bf16_t* Pb = WSP(bf16_t, WS_P); const float* LB = WSP(float, WS_LB) + (size_t)l * HG_W + h * HDK;
    const int sq0 = (b * HGH + h) * 2;
    if (C.tid < 2 * HDK) {
        const int d = C.tid >> 7, dk = C.tid & 127; const float lb = LB[dk]; const int zc = (d ? PHB : PHF) + h * HDK + dk;
        float R = 0.f;
        for (int st = 0; st < CH; ++st) { const int j = d ? st : CH - 1 - st;
            const float f = hg_f(bf2f(Pb[(size_t)(row0 + j) * NPB + zc]), lb);
            KT[(d * HDK + dk) * CP + j] = (bf16_t)f2bf((1.0f - f) * expf(R)); R += logf(f); }
        WSP(float, WS_SMALL + SM_LAM)[((size_t)(sq0 + d) * NCH + dir_chunk(cc, d)) * HDK + dk] = expf(R);
    }
    for (int i = C.tid; i < CH * (HDV / 8); i += NTHREADS) {
        const int s = i / (HDV / 8), cg = i % (HDV / 8);
        const u32x4 vv = *(const u32x4*)(Pb + (size_t)(row0 + s) * NPB + PHI + h * HDV + cg * 8); const unsigned wv[4] = {vv.x, vv.y, vv.z, vv.w};
#pragma unroll
        for (int q = 0; q < 8; ++q) VT[(cg * 8 + q) * CP + s] = (bf16_t)((wv[q >> 1] >> ((q & 1) * 16)) & 0xffffu);
    }
    __syncthreads();
    const int r32 = C.lane & 31, hi = C.lane >> 5, w = C.wave, d = w >> 2, eb = w & 3;
    f32x16 acc[4];
#pragma unroll
    for (int nb = 0; nb < 4; ++nb) acc[nb] = (f32x16){0};
#pragma unroll
    for (int ks = 0; ks < CH / 16; ++ks) {
        const bf16x8 a = *(const bf16x8*)(VT + (32 * eb + r32) * CP + 16 * ks + 8 * hi);
#pragma unroll
        for (int nb = 0; nb < 4; ++nb) { const bf16x8 bb = *(const bf16x8*)(KT + (d * HDK + 32 * nb + r32) * CP + 16 * ks + 8 * hi); acc[nb] = MFMA32(a, bb, acc[nb]); }
    }
    bf16_t* out = WSP(bf16_t, WS_CSTH) + ((size_t)(sq0 + d) * NCH + dir_chunk(cc, d)) * HDV * HDK;
#pragma unroll
    for (int nb = 0; nb < 4; ++nb)
#pragma unroll
        for (int r = 0; r < 16; ++r) out[(size_t)(32 * eb + crow(r, hi)) * HDK + 32 * nb + r32] = (bf16_t)f2bf(acc[nb][r]);
    __syncthreads();
}
DEV void hgrn_s2(const Params& P, const Ctx& C) {
    const int gt = C.bid * NTHREADS + C.tid, ngt = C.nblk * NTHREADS;
    constexpr int NG8 = HDV * HDK / 8;
    for (int i = gt; i < NSQH * NG8; i += ngt) {
        const int sq = i / NG8, g8 = i % NG8, dk0 = (g8 * 8) % HDK; float run[8];
#pragma unroll
        for (int q = 0; q < 8; ++q) run[q] = 0.f;
        u32x4* p = (u32x4*)(WSP(bf16_t, WS_CSTH) + (size_t)sq * NCH * HDV * HDK + (size_t)g8 * 8);
        const float* lam = WSP(float, WS_SMALL + SM_LAM) + (size_t)sq * NCH * HDK + dk0;
        for (int c = 0; c < NCH; ++c) {
            float kl[8]; unpack8(p[(size_t)c * NG8], kl);
            p[(size_t)c * NG8] = pack8(run);
#pragma unroll
            for (int q = 0; q < 8; ++q) run[q] = lam[(size_t)c * HDK + q] * run[q] + kl[q];
        }
    }
}
DEV void hgrn_s3_unit(const Params& P, const Ctx& C0, int l, int u) {
    const Ctx C = make_ctx(C0.lds);
    const int cc = u % NCH, h = (u / NCH) % HGH, b = u / (NCH * HGH), row0 = chunk_row0(b, cc);
    float* GL = (float*)C.lds;
    bf16_t* QH = (bf16_t*)(C.lds + CH * HDK * 4);
    bf16_t* KH = QH + CH * HQP;
    bf16_t* KTL = KH + CH * HQP;
    bf16_t* QP = KTL + 32 * HQP;
    bf16_t* VT = QP + CH * HQP;
    bf16_t* AT = VT + HDV * CP;
    float* HS = GL;
    const bf16_t* Pb = WSP(bf16_t, WS_P); const float* LB = WSP(float, WS_LB) + (size_t)l * HG_W + h * HDK;
    const int sq0 = (b * HGH + h) * 2;
    const int r32 = C.lane & 31, hi = C.lane >> 5, w = C.wave, tbo = w >> 2, eb = w & 3;
    for (int i = C.tid; i < CH * (HDV / 8); i += NTHREADS) {
        const int s = i / (HDV / 8), cg = i % (HDV / 8);
        const u32x4 vv = *(const u32x4*)(Pb + (size_t)(row0 + s) * NPB + PHI + h * HDV + cg * 8); const unsigned wv[4] = {vv.x, vv.y, vv.z, vv.w};
#pragma unroll
        for (int q = 0; q < 8; ++q) VT[(cg * 8 + q) * CP + s] = (bf16_t)((wv[q >> 1] >> ((q & 1) * 16)) & 0xffffu);
    }
    f32x16 oacc = (f32x16){0};
    for (int d = 0; d < 2; ++d) {
        const int zc = (d ? PHB : PHF) + h * HDK;
        if (C.tid < HDK) { const int dk = C.tid; const float lb = LB[dk]; float G = 0.f;
            for (int st = 0; st < CH; ++st) { const int j = d ? CH - 1 - st : st; G += logf(hg_f(bf2f(Pb[(size_t)(row0 + j) * NPB + zc + dk]), lb)); GL[j * HDK + dk] = G; } }
        __syncthreads();
        for (int i = C.tid; i < CH * HDK; i += NTHREADS) {
            const int j = i / HDK, dk = i % HDK, blk = j >> 5;
            const float q = siluf_(bf2f(Pb[(size_t)(row0 + j) * NPB + PHQ + h * HDK + dk])), k = 1.0f - hg_f(bf2f(Pb[(size_t)(row0 + j) * NPB + zc + dk]), LB[dk]);
            const float G = GL[j * HDK + dk], Gmid = d ? GL[32 * HDK + dk] : GL[31 * HDK + dk];
            const float Gref = d ? (blk == 1 ? 0.f : Gmid) : (blk == 0 ? 0.f : Gmid);
            QH[j * HQP + dk] = (bf16_t)f2bf(q * expf(G - Gref)); KH[j * HQP + dk] = (bf16_t)f2bf(k * expf(Gref - G)); QP[j * HQP + dk] = (bf16_t)f2bf(q * expf(G));
            if (d ? (blk == 1) : (blk == 0)) KTL[(j & 31) * HQP + dk] = (bf16_t)f2bf(k * expf(Gmid - G));
        }
        __syncthreads();
        if (w < 4) {
            const int tb = w >> 1, sb = w & 1; const bool diag = tb == sb, off = d ? (tb == 0 && sb == 1) : (tb == 1 && sb == 0);
            f32x16 sa = (f32x16){0};
            if (diag || off) {
                const bf16_t* kb = diag ? KH + (32 * sb) * HQP : KTL;
#pragma unroll
                for (int ks = 0; ks < HDK / 16; ++ks) {
                    const bf16x8 a = *(const bf16x8*)(QH + (32 * tb + r32) * HQP + 16 * ks + 8 * hi);
                    const bf16x8 bb = *(const bf16x8*)(kb + r32 * HQP + 16 * ks + 8 * hi);
                    sa = MFMA32(a, bb, sa);
                }
            }
#pragma unroll
            for (int r = 0; r < 16; ++r) { const int t = 32 * tb + crow(r, hi), s = 32 * sb + r32; const bool ok = d ? (s >= t) : (s <= t);
                AT[t * CP + s] = (bf16_t)f2bf((ok && (diag || off)) ? sa[r] : 0.f); }
        }
        __syncthreads();
#pragma unroll
        for (int ks = 0; ks < CH / 16; ++ks) {
            const bf16x8 a = *(const bf16x8*)(AT + (32 * tbo + r32) * CP + 16 * ks + 8 * hi);
            const bf16x8 bb = *(const bf16x8*)(VT + (32 * eb + r32) * CP + 16 * ks + 8 * hi);
            oacc = MFMA32(a, bb, oacc);
        }
        const bf16_t* sst = WSP(bf16_t, WS_CSTH) + ((size_t)(sq0 + d) * NCH + dir_chunk(cc, d)) * HDV * HDK + (size_t)(32 * eb + r32) * HDK + 8 * hi;
#pragma unroll
        for (int ks = 0; ks < HDK / 16; ++ks) {
            const bf16x8 a = *(const bf16x8*)(QP + (32 * tbo + r32) * HQP + 16 * ks + 8 * hi);
            const bf16x8 bb = *(const bf16x8*)(sst + 16 * ks);
            oacc = MFMA32(a, bb, oacc);
        }
        __syncthreads();
    }
#pragma unroll
    for (int r = 0; r < 16; ++r) HS[(32 * tbo + crow(r, hi)) * HDV + 32 * eb + r32] = oacc[r];
    __syncthreads();
    const float* ng = P.hg_norm_g + (size_t)l * HG_W + h * HDV;
    for (int t = w; t < CH; t += NWAVES) {
        const float v0 = HS[t * HDV + C.lane * 2], v1 = HS[t * HDV + C.lane * 2 + 1];
        const float rstd = 1.0f / sqrtf(wave_sum(v0 * v0 + v1 * v1) * (1.0f / HDV) + EPS);
        const int row = row0 + t; const unsigned gv = *(const unsigned*)(Pb + (size_t)row * NPB + PHG + h * HDV + C.lane * 2);
        const float g0 = bitsf(gv << 16), g1 = bitsf(gv & 0xffff0000u);
        *(unsigned*)(WSP(bf16_t, WS_Y) + ((size_t)2 * MT + row) * BW + h * HDV + C.lane * 2) = pk2(v0 * rstd * ng[C.lane * 2] * siluf_(g0), v1 * rstd * ng[C.lane * 2 + 1] * siluf_(g1));
    }
    __syncthreads();
}
DEV void phase_s1(const Params& P, const Ctx& C, int l) {
    for (int u = C.bid; u < NSQM * NCH; u += C.nblk) mlstm_s1_unit(P, C, l, u);
    for (int u = C.bid; u < NB * HGH * NCH; u += C.nblk) hgrn_s1_unit(P, C, l, u);
}
DEV void phase_s2(const Params& P, const Ctx& C) { mlstm_s2(P, C); hgrn_s2(P, C); }
DEV void phase_s3(const Params& P, const Ctx& C, int l, bool need_ctx) {
    const int c_lo = need_ctx ? 0 : NCHC, ncu = NCH - c_lo;
    for (int u = C.bid; u < NB * MLH * ncu; u += C.nblk) mlstm_s3_unit(P, C, l, (u / ncu) * NCH + c_lo + (u % ncu));
    for (int u = C.bid; u < NB * HGH * ncu; u += C.nblk) hgrn_s3_unit(P, C, l, (u / ncu) * NCH + c_lo + (u % ncu));
}

namespace pg8 {
constexpr int BM = 256, BK = 64, HALF = 128, HTB = HALF * BK * 2, STAGE_BYTES = 8 * HTB, NXCD = 8, WGM = 8;
struct Unit { int pm, pn, po; };
struct Gemm { const bf16_t* A; const bf16_t* Bt; int K; };
DEV int lds_byte(int r, int c) { const int st = (r >> 4) * 2 + (c >> 5), rr = r & 15, cc = c & 31, ob = rr * 64 + cc * 2; return st * 1024 + (ob ^ (((ob >> 9) & 1) << 5)); }
DEV void stage_rc(int b, int& R, int& C) { const int st = b / 1024, sb = b % 1024, swz = sb ^ (((sb >> 9) & 1) << 5); R = (st >> 1) * 16 + swz / 64; C = (st & 1) * 32 + (swz % 64) / 2; }
DEV int perm32(int rho) { const int n = rho >> 4, i = rho & 15; return 8 * (i >> 2) + 4 * n + (i & 3); }
struct PanelOrder {
    int nM, nN, nwg, G, c; const int* pe;
    DEV void init(int nM_, int nN_, int G_, int c_, const int* pe_) { nM = nM_; nN = nN_; nwg = nM * nN; G = G_; c = c_; pe = pe_; }
    DEV bool next(int i, Unit& u) const {
        const long L = (long)i * G + c; if (L >= nwg) return false;
        int wgid = (int)L; { const int q = nwg / NXCD, r = nwg % NXCD, xcd = wgid % NXCD, off = wgid / NXCD; wgid = (xcd < r ? xcd * (q + 1) : r * (q + 1) + (xcd - r) * q) + off; }
        const int nig = WGM * nN, gid = wgid / nig, fm = gid * WGM, gsz = (nM - fm) < WGM ? (nM - fm) : WGM;
        u.pm = fm + ((wgid % nig) % gsz); u.po = (wgid % nig) / gsz; u.pn = pe ? pe[u.pm] * nN + u.po : u.po; return true;
    }
    DEV void a_ready(const Unit&) const {}
    DEV void done(const Unit&) const {}
};
#ifndef HOST_EMU
#define PG8_LAS __attribute__((address_space(3)))
template <class Epi, class Sched, bool ALIGN_EPI = false, bool SP2 = false>
__device__ __forceinline__ void gemm_phase(PG8_LAS unsigned char* lds, const Gemm g, const Sched& S, const Epi& E) {
    const int tid = opaque_tid(), wid = __builtin_amdgcn_readfirstlane(tid >> 6), lane = tid & 63, wr = wid >> 2, wc = wid & 3, fr = lane & 15, fq = lane >> 4;
    const int K = g.K, nt = K / BK;
    unsigned voffA[2], voffB[2];
#pragma unroll
    for (int i = 0; i < 2; ++i) { int R, C; stage_rc(tid * 16 + i * 8192, R, C); const int Rb = Epi::PERM ? ((R & ~31) + perm32(R & 31)) : R;
        voffA[i] = (unsigned)(R * K + C) * 2u; voffB[i] = (unsigned)(Rb * K + C) * 2u; }
    const size_t kstep = (size_t)(BK * 2);
    const size_t hstep = (size_t)HALF * K * 2;
    const size_t tstep = 2 * hstep;
    const unsigned ldsw = (unsigned)wid * 1024u;
    const int aoff = lds_byte(wr * 64 + fr, fq * 8), boff = lds_byte(wc * 32 + fr, fq * 8);
#define PG8_SA(b, h) (((b) * 2 + (h)) * HTB)
#define PG8_SB(b, h) ((4 + (b) * 2 + (h)) * HTB)
#define PG8_STAGE(bufoff, gbase, voff) do { _Pragma("unroll") for (int _i = 0; _i < 2; ++_i) \
        __builtin_amdgcn_global_load_lds((const unsigned*)((const char*)(gbase) + (voff)[_i]), (PG8_LAS unsigned*)(lds + (bufoff) + ldsw + _i * 8192), 16, 0, 0); } while (0)
#define PG8_LDA(dst, b, h) do { _Pragma("unroll") for (int m = 0; m < 4; ++m) _Pragma("unroll") for (int k = 0; k < 2; ++k) dst[m][k] = *(const PG8_LAS bf16x8*)(lds + PG8_SA(b, h) + aoff + m * 2048 + k * 1024); } while (0)
#define PG8_LDB(dst, b, h) do { _Pragma("unroll") for (int n = 0; n < 2; ++n) _Pragma("unroll") for (int k = 0; k < 2; ++k) dst[n][k] = *(const PG8_LAS bf16x8*)(lds + PG8_SB(b, h) + boff + n * 2048 + k * 1024); } while (0)
#define PG8_MMA(ai, bj, At, Bt) do { __builtin_amdgcn_s_setprio(1); _Pragma("unroll") for (int m = 0; m < 4; ++m) _Pragma("unroll") for (int n = 0; n < 2; ++n) _Pragma("unroll") for (int k = 0; k < 2; ++k) \
        acc[ai][bj][m][n] = __builtin_amdgcn_mfma_f32_16x16x32_bf16(Bt[n][k], At[m][k], acc[ai][bj][m][n], 0, 0, 0); __builtin_amdgcn_s_setprio(0); } while (0)
#define PG8_WAIT_V(n) asm volatile("s_waitcnt vmcnt(" #n ")" ::: "memory")
#define PG8_WAIT_L(n) asm volatile("s_waitcnt lgkmcnt(" #n ")" ::: "memory")
#define PG8_BAR __builtin_amdgcn_s_barrier()
#define PG8_SCHED __builtin_amdgcn_sched_barrier(0)
    Unit cur, nxt; int ui = 0;
    if (!S.next(0, cur)) return;
    f32x4 acc[2][2][4][2];
#pragma unroll
    for (int a = 0; a < 2; ++a)
#pragma unroll
        for (int b = 0; b < 2; ++b)
#pragma unroll
            for (int m = 0; m < 4; ++m)
#pragma unroll
                for (int n = 0; n < 2; ++n) acc[a][b][m][n] = (f32x4){0.f, 0.f, 0.f, 0.f};
    bf16x8 At[4][2], B0[2][2], B1[2][2];
    const char* cA = (const char*)g.A + (size_t)cur.pm * tstep; const char* cB = (const char*)g.Bt + (size_t)cur.pn * tstep;
    S.a_ready(cur);
    if constexpr (SP2) {
        PG8_STAGE(PG8_SB(0, 0), cB, voffB); PG8_STAGE(PG8_SB(0, 1), cB + hstep, voffB); PG8_STAGE(PG8_SA(0, 0), cA, voffA); PG8_STAGE(PG8_SA(0, 1), cA + hstep, voffA);
        if (wr == 1) PG8_BAR;
        PG8_WAIT_V(2); PG8_BAR;
        PG8_STAGE(PG8_SB(1, 0), cB + kstep, voffB); PG8_STAGE(PG8_SA(1, 0), cA + kstep, voffA); PG8_STAGE(PG8_SB(1, 1), cB + hstep + kstep, voffB);
        PG8_WAIT_V(6); PG8_BAR;
    } else {
        PG8_STAGE(PG8_SB(0, 0), cB, voffB); PG8_STAGE(PG8_SA(0, 0), cA, voffA); PG8_STAGE(PG8_SB(0, 1), cB + hstep, voffB); PG8_STAGE(PG8_SA(0, 1), cA + hstep, voffA);
        if (wr == 1) PG8_BAR;
        PG8_WAIT_V(4); PG8_BAR;
        PG8_STAGE(PG8_SB(1, 0), cB + kstep, voffB); PG8_STAGE(PG8_SA(1, 0), cA + kstep, voffA); PG8_STAGE(PG8_SB(1, 1), cB + hstep + kstep, voffB);
        PG8_WAIT_V(6); PG8_BAR;
    }
    for (;;) {
        const bool has_next = S.next(ui + 1, nxt);
        const char* nA = has_next ? (const char*)g.A + (size_t)nxt.pm * tstep : cA; const char* nB = has_next ? (const char*)g.Bt + (size_t)nxt.pn * tstep : cB;
        for (int t = 0; t < nt; t += 2) {
            const bool last = (t == nt - 2);
            const char* a1 = cA + (size_t)(t + 1) * kstep;
            const char* a2 = last ? nA : cA + (size_t)(t + 2) * kstep; const char* b2 = last ? nB : cB + (size_t)(t + 2) * kstep;
            const char* a3 = a2 + kstep; const char* b3 = b2 + kstep;
            if (last && has_next) S.a_ready(nxt);
            if constexpr (SP2) {
            PG8_LDB(B0, 0, 0); PG8_LDB(B1, 0, 1); PG8_SCHED; PG8_LDA(At, 0, 0); PG8_STAGE(PG8_SA(1, 1), a1 + hstep, voffA);
            PG8_WAIT_V(8); PG8_WAIT_L(0); PG8_BAR; PG8_MMA(0, 0, At, B0); PG8_MMA(0, 1, At, B1); PG8_BAR; PG8_SCHED;
            PG8_LDA(At, 0, 1); PG8_STAGE(PG8_SB(0, 0), b2, voffB); PG8_STAGE(PG8_SB(0, 1), b2 + hstep, voffB); PG8_STAGE(PG8_SA(0, 0), a2, voffA);
            PG8_WAIT_V(8); PG8_WAIT_L(0); PG8_BAR; PG8_MMA(1, 0, At, B0); PG8_MMA(1, 1, At, B1); PG8_BAR; PG8_SCHED;
            PG8_LDB(B0, 1, 0); PG8_LDB(B1, 1, 1); PG8_SCHED; PG8_LDA(At, 1, 0); PG8_STAGE(PG8_SA(0, 1), a2 + hstep, voffA);
            PG8_WAIT_V(8); PG8_WAIT_L(0); PG8_BAR; PG8_MMA(0, 0, At, B0); PG8_MMA(0, 1, At, B1); PG8_BAR; PG8_SCHED;
            PG8_LDA(At, 1, 1); PG8_STAGE(PG8_SB(1, 0), b3, voffB); PG8_STAGE(PG8_SB(1, 1), b3 + hstep, voffB); PG8_STAGE(PG8_SA(1, 0), a3, voffA);
            PG8_WAIT_V(8); PG8_WAIT_L(0); PG8_BAR; PG8_MMA(1, 0, At, B0); PG8_MMA(1, 1, At, B1); PG8_BAR; PG8_SCHED;
            } else {
            PG8_LDB(B0, 0, 0); PG8_SCHED; PG8_LDA(At, 0, 0); PG8_STAGE(PG8_SA(1, 1), a1 + hstep, voffA);
            PG8_WAIT_L(8); PG8_BAR; PG8_WAIT_L(0); PG8_MMA(0, 0, At, B0); PG8_BAR; PG8_SCHED;
            PG8_LDB(B1, 0, 1); PG8_STAGE(PG8_SB(0, 0), b2, voffB);
            PG8_BAR; PG8_WAIT_L(0); PG8_MMA(0, 1, At, B1); PG8_BAR;
            PG8_LDA(At, 0, 1); PG8_STAGE(PG8_SA(0, 0), a2, voffA);
            PG8_BAR; PG8_WAIT_L(0); PG8_MMA(1, 0, At, B0); PG8_BAR; PG8_SCHED;
            PG8_STAGE(PG8_SB(0, 1), b2 + hstep, voffB);
            PG8_WAIT_V(6); PG8_BAR; PG8_MMA(1, 1, At, B1); PG8_BAR;
            PG8_LDB(B0, 1, 0); PG8_SCHED; PG8_LDA(At, 1, 0); PG8_STAGE(PG8_SA(0, 1), a2 + hstep, voffA);
            PG8_WAIT_L(8); PG8_BAR; PG8_WAIT_L(0); PG8_MMA(0, 0, At, B0); PG8_BAR; PG8_SCHED;
            PG8_LDB(B1, 1, 1); PG8_STAGE(PG8_SB(1, 0), b3, voffB);
            PG8_BAR; PG8_WAIT_L(0); PG8_MMA(0, 1, At, B1); PG8_BAR;
            PG8_LDA(At, 1, 1); PG8_STAGE(PG8_SA(1, 0), a3, voffA);
            PG8_BAR; PG8_WAIT_L(0); PG8_MMA(1, 0, At, B0); PG8_BAR; PG8_SCHED;
            PG8_STAGE(PG8_SB(1, 1), b3 + hstep, voffB);
            PG8_WAIT_V(6); PG8_BAR; PG8_MMA(1, 1, At, B1); PG8_BAR;
            }
        }
        if constexpr (ALIGN_EPI) { if (wr == 0) PG8_BAR; }
        E(acc, cur, wr, wc, fr, fq); S.done(cur);
        if (!has_next) break;
#pragma unroll
        for (int a = 0; a < 2; ++a)
#pragma unroll
            for (int b = 0; b < 2; ++b)
#pragma unroll
                for (int m = 0; m < 4; ++m)
#pragma unroll
                    for (int n = 0; n < 2; ++n) acc[a][b][m][n] = (f32x4){0.f, 0.f, 0.f, 0.f};
        cur = nxt; cA = nA; cB = nB; ++ui;
        if constexpr (ALIGN_EPI) { if (wr == 1) PG8_BAR; }
    }
    PG8_WAIT_V(0);
    if constexpr (!ALIGN_EPI) { if (wr == 0) PG8_BAR; }
    PG8_BAR;
#undef PG8_SA
#undef PG8_SB
#undef PG8_STAGE
#undef PG8_LDA
#undef PG8_LDB
#undef PG8_MMA
#undef PG8_WAIT_V
#undef PG8_WAIT_L
#undef PG8_BAR
#undef PG8_SCHED
}
#else
template <class Epi, class Sched, bool ALIGN_EPI = false, bool SP2 = false>
inline void gemm_phase(unsigned char*, const Gemm g, const Sched& S, const Epi& E) {
    const int tid = threadIdx.x, wid = tid >> 6, lane = tid & 63, wr = wid >> 2, wc = wid & 3, fr = lane & 15, fq = lane >> 4;
    Unit u;
    for (int i = 0; S.next(i, u); ++i) {
        f32x4 acc[2][2][4][2];
        for (int ai = 0; ai < 2; ++ai) for (int bj = 0; bj < 2; ++bj) for (int m = 0; m < 4; ++m) for (int n = 0; n < 2; ++n) for (int j = 0; j < 4; ++j) {
            const int row = 256 * u.pm + 128 * ai + 64 * wr + 16 * m + fr;
            const int cit = Epi::PERM ? 128 * bj + 32 * wc + 8 * fq + 4 * n + j : 128 * bj + 32 * wc + 16 * n + 4 * fq + j;
            const bf16_t* a = g.A + (size_t)row * g.K; const bf16_t* b = g.Bt + (size_t)(256 * u.pn + cit) * g.K; float s = 0.f;
            for (int k = 0; k < g.K; ++k) s += bf2f(a[k]) * bf2f(b[k]);
            acc[ai][bj][m][n][j] = s; }
        E(acc, u, wr, wc, fr, fq);
    }
}
#endif
}

typedef const f32x4 (&AccRef)[2][2][4][2];
struct EpiInProj {
    static constexpr bool PERM = true;
    bf16_t* Pb; float* G16;
    DEV void operator()(AccRef acc, const pg8::Unit& u, int wr, int wc, int fr, int fq) const {
        const int row0 = u.pm * 256 + wr * 64 + fr;
        if (u.po < NPB / 256) {
            const int col0 = u.po * 256 + wc * 32 + 8 * fq;
#pragma unroll
            for (int ai = 0; ai < 2; ++ai)
#pragma unroll
                for (int m = 0; m < 4; ++m) { bf16_t* rowp = Pb + (size_t)(row0 + ai * 128 + m * 16) * NPB + col0;
#pragma unroll
                    for (int bj = 0; bj < 2; ++bj) { const f32x4 v0 = acc[ai][bj][m][0], v1 = acc[ai][bj][m][1];
                        u32x4 w; w.x = pk2(v0[0], v0[1]); w.y = pk2(v0[2], v0[3]); w.z = pk2(v1[0], v1[1]); w.w = pk2(v1[2], v1[3]);
                        *(u32x4*)(rowp + bj * 128) = w; } }
        } else if (wc == 0 && fq < 2) {
#pragma unroll
            for (int ai = 0; ai < 2; ++ai)
#pragma unroll
                for (int m = 0; m < 4; ++m) { float* rowp = G16 + (size_t)(row0 + ai * 128 + m * 16) * 16 + 8 * fq;
                    *(f32x4*)rowp = acc[ai][0][m][0]; *(f32x4*)(rowp + 4) = acc[ai][0][m][1]; }
        }
    }
};
struct EpiBranch {
    static constexpr bool PERM = true;
    const bf16_t* Pb; float* MGF; bf16_t* MG; int n;
    DEV void operator()(AccRef acc, const pg8::Unit& u, int wr, int wc, int fr, int fq) const {
        const int row0 = u.pm * 256 + wr * 64 + fr, col0 = u.po * 256 + wc * 32 + 8 * fq;
#pragma unroll
        for (int ai = 0; ai < 2; ++ai)
#pragma unroll
            for (int m = 0; m < 4; ++m) { const int row = row0 + ai * 128 + m * 16;
#pragma unroll
                for (int bj = 0; bj < 2; ++bj) { const int col = col0 + bj * 128;
                    float gt[8]; unpack8(*(const u32x4*)(Pb + (size_t)row * NPB + PGATE + n * D + col), gt);
                    float v[8];
#pragma unroll
                    for (int q = 0; q < 8; ++q) v[q] = sigmoidf_(gt[q]) * acc[ai][bj][m][q >> 2][q & 3];
                    float* mp = MGF + (size_t)row * D + col;
                    if (n > 0) { const f32x4 p0 = *(const f32x4*)mp, p1 = *(const f32x4*)(mp + 4);
#pragma unroll
                        for (int q = 0; q < 4; ++q) { v[q] += p0[q]; v[4 + q] += p1[q]; } }
                    if (n < 2) { *(f32x4*)mp = (f32x4){v[0], v[1], v[2], v[3]}; *(f32x4*)(mp + 4) = (f32x4){v[4], v[5], v[6], v[7]}; }
                    else *(u32x4*)(MG + (size_t)row * D + col) = pack8(v); } }
    }
};
struct EpiResid {
    static constexpr bool PERM = false;
    const float* baseL; const float* baseC; float* outL; float* outC; const float* gate;
    bool moe; const int* rtok; const float* rw; const int* rslot; float* ys;
    DEV void operator()(AccRef acc, const pg8::Unit& u, int wr, int wc, int fr, int fq) const {
        const int row0 = u.pm * 256 + wr * 64 + fr, col0 = u.po * 256 + wc * 32 + 4 * fq;
#pragma unroll
        for (int ai = 0; ai < 2; ++ai)
#pragma unroll
            for (int m = 0; m < 4; ++m) { const int row = row0 + ai * 128 + m * 16;
                if (moe) {
                    const int tok = rtok[row]; if (tok < 0) continue;
                    const float w = rw[row]; float* o = ys + ((size_t)rslot[row] * MLAT + tok) * D + col0;
#pragma unroll
                    for (int bj = 0; bj < 2; ++bj)
#pragma unroll
                        for (int n = 0; n < 2; ++n) *(f32x4*)(o + bj * 128 + n * 16) = acc[ai][bj][m][n] * w;
                } else {
                    const bool lat = row < MLAT; const float* b = lat ? baseL + (size_t)row * D : baseC + (size_t)(row - MLAT) * D;
                    float* o = lat ? outL + (size_t)row * D : outC + (size_t)(row - MLAT) * D; const float* gv = gate + (size_t)row_vec(row) * 6 * D;
#pragma unroll
                    for (int bj = 0; bj < 2; ++bj)
#pragma unroll
                        for (int n = 0; n < 2; ++n) { const int c = col0 + bj * 128 + n * 16; *(f32x4*)(o + c) = *(const f32x4*)(b + c) + *(const f32x4*)(gv + c) * acc[ai][bj][m][n]; }
                } }
    }
};
struct EpiGU {
    static constexpr bool PERM = true;
    bf16_t* ACT;
    DEV void operator()(AccRef acc, const pg8::Unit& u, int wr, int wc, int fr, int fq) const {
        const int row0 = u.pm * 256 + wr * 64 + fr, col0 = u.po * 128 + wc * 32 + 8 * fq;
#pragma unroll
        for (int ai = 0; ai < 2; ++ai)
#pragma unroll
            for (int m = 0; m < 4; ++m) { float v[8];
#pragma unroll
                for (int q = 0; q < 8; ++q) v[q] = siluf_(acc[ai][0][m][q >> 2][q & 3]) * acc[ai][1][m][q >> 2][q & 3];
                *(u32x4*)(ACT + (size_t)(row0 + ai * 128 + m * 16) * DFF + col0) = pack8(v); }
    }
};

namespace att {
constexpr int NW = 8, QBLK = 32, KVBLK = 64, LDQ = ATT_W, LDK = KV_W, LDO = BW;
constexpr float SCALE = 0.088388347648318440f, THR = 8.f;
constexpr size_t SHM_V = KVBLK * HD * 2, SHM_K = KVBLK * HD * 2, SHM_ATTN = 2 * SHM_V + 2 * SHM_K + NW * 64 * 4;
#ifndef HOST_EMU
using s16x4 = __attribute__((ext_vector_type(4))) short;
#define KSWZ(row, colB) ((row) * 256 + ((colB) ^ (((row) & 7) << 4)))
#define SBAR() __builtin_amdgcn_sched_barrier(0)
__device__ __forceinline__ unsigned cvtpk(float lo, float hi) { unsigned r; asm volatile("v_cvt_pk_bf16_f32 %0, %1, %2" : "=v"(r) : "v"(lo), "v"(hi)); return r; }
__device__ __forceinline__ void partialSM(f32x16& p0, f32x16& p1, float& m_reg, float& mn, float& alpha) {
  constexpr float C = SCALE * 1.4426950408889634f;
  float pmax = p0[0]; for (int r = 1; r < 16; ++r) pmax = fmaxf(pmax, p0[r]); for (int r = 0; r < 16; ++r) pmax = fmaxf(pmax, p1[r]);
  { auto rr = __builtin_amdgcn_permlane32_swap(__float_as_uint(pmax), __float_as_uint(pmax), false, false);
    pmax = fmaxf(__uint_as_float(rr[0]), __uint_as_float(rr[1])); }
  if (__builtin_expect(__all(pmax - m_reg <= THR / SCALE), 1)) { mn = m_reg; alpha = 1.f; }
  else { mn = fmaxf(m_reg, pmax); alpha = __builtin_amdgcn_exp2f((m_reg - mn) * C); m_reg = mn; }
  float mnC = -mn * C;
  for (int r = 0; r < 16; ++r) p0[r] = fmaf(p0[r], C, mnC); for (int r = 0; r < 16; ++r) p1[r] = fmaf(p1[r], C, mnC);
  for (int r = 0; r < 16; ++r) p0[r] = __builtin_amdgcn_exp2f(p0[r]);
}
__device__ __forceinline__ void finishSM(f32x16& p0, f32x16& p1, float alpha, float& l_reg, bf16x8& pa0, bf16x8& pa1, bf16x8& pa2, bf16x8& pa3) {
  for (int r = 0; r < 16; ++r) p1[r] = __builtin_amdgcn_exp2f(p1[r]);
  float ps = 0; for (int r = 0; r < 16; ++r) ps += p0[r]; for (int r = 0; r < 16; ++r) ps += p1[r];
  { auto rr = __builtin_amdgcn_permlane32_swap(__float_as_uint(ps), __float_as_uint(ps), false, false);
    ps = __uint_as_float(rr[0]) + __uint_as_float(rr[1]); }
  l_reg = l_reg * alpha + ps;
#define PK4(P, BASE, OUT) do { unsigned a0 = cvtpk(P[BASE + 0], P[BASE + 1]), a1 = cvtpk(P[BASE + 2], P[BASE + 3]);   \
    unsigned b0 = cvtpk(P[BASE + 4], P[BASE + 5]), b1 = cvtpk(P[BASE + 6], P[BASE + 7]);                              \
    auto r0 = __builtin_amdgcn_permlane32_swap(a0, b0, false, false); auto r1 = __builtin_amdgcn_permlane32_swap(a1, b1, false, false); \
    u32x4 w = {r0[0], r1[0], r0[1], r1[1]}; OUT = *reinterpret_cast<bf16x8*>(&w); } while (0)
  PK4(p0, 0, pa0); PK4(p0, 8, pa1); PK4(p1, 0, pa2); PK4(p1, 8, pa3);
#undef PK4
}
__device__ __forceinline__ void qkt(f32x16& p0, f32x16& p1, const bf16_t* Ks, const bf16x8* qr, int r32, int hi) {
  p0 = f32x16{}; p1 = f32x16{};
  for (int d0 = 0; d0 < 8; ++d0) { int cb = (d0 * 16 + hi * 8) * 2;
    bf16x8 b0 = *reinterpret_cast<const bf16x8*>((const char*)Ks + KSWZ(r32, cb));
    bf16x8 b1 = *reinterpret_cast<const bf16x8*>((const char*)Ks + KSWZ(32 + r32, cb));
    p0 = __builtin_amdgcn_mfma_f32_32x32x16_bf16(b0, qr[d0], p0, 0, 0, 0);
    p1 = __builtin_amdgcn_mfma_f32_32x32x16_bf16(b1, qr[d0], p1, 0, 0, 0); }
}
__device__ __forceinline__ int v_st(int k, int c) { const int kk = (k & ~0xC) | ((k & 4) << 1) | ((k & 8) >> 1); return ((kk >> 3) * 4 + (c >> 5)) * 512 + ((kk & 7) * 32 + (c & 31)) * 2; }
__device__ __forceinline__ int v_rd_base(int lane) { return ((lane & 3) << 3) | (((lane >> 2) & 3) << 6) | (((lane >> 4) & 1) << 5) | (((lane >> 5) & 1) << 8); }
constexpr int v_rd_off(int d0, int ks, int half) { return d0 * 512 + ks * 4096 + half * 2048; }
template <int OFF> __device__ __forceinline__ s16x4 tr_read(int vb) {
  s16x4 r; asm volatile("ds_read_b64_tr_b16 %0, %1 offset:%2" : "=&v"(r) : "v"(vb), "i"(OFF) : "memory"); return r;
}
template <int D0> __device__ __forceinline__ void pv_one(f32x16& od, int vb, bf16x8 pa0, bf16x8 pa1, bf16x8 pa2, bf16x8 pa3) {
  const s16x4 l0 = tr_read<v_rd_off(D0, 0, 0)>(vb), h0 = tr_read<v_rd_off(D0, 0, 1)>(vb), l1 = tr_read<v_rd_off(D0, 1, 0)>(vb), h1 = tr_read<v_rd_off(D0, 1, 1)>(vb);
  const s16x4 l2 = tr_read<v_rd_off(D0, 2, 0)>(vb), h2 = tr_read<v_rd_off(D0, 2, 1)>(vb), l3 = tr_read<v_rd_off(D0, 3, 0)>(vb), h3 = tr_read<v_rd_off(D0, 3, 1)>(vb);
  asm volatile("s_waitcnt lgkmcnt(0)" ::: "memory"); SBAR();
#define PK(L, H) (bf16x8){L[0], L[1], L[2], L[3], H[0], H[1], H[2], H[3]}
  od = __builtin_amdgcn_mfma_f32_32x32x16_bf16(pa0, PK(l0, h0), od, 0, 0, 0);
  od = __builtin_amdgcn_mfma_f32_32x32x16_bf16(pa1, PK(l1, h1), od, 0, 0, 0);
  od = __builtin_amdgcn_mfma_f32_32x32x16_bf16(pa2, PK(l2, h2), od, 0, 0, 0);
  od = __builtin_amdgcn_mfma_f32_32x32x16_bf16(pa3, PK(l3, h3), od, 0, 0, 0);
#undef PK
}
__device__ __forceinline__ void pv_d0(f32x16* o, int vb, bf16x8 pa0, bf16x8 pa1, bf16x8 pa2, bf16x8 pa3) {
  pv_one<0>(o[0], vb, pa0, pa1, pa2, pa3); pv_one<1>(o[1], vb, pa0, pa1, pa2, pa3); pv_one<2>(o[2], vb, pa0, pa1, pa2, pa3); pv_one<3>(o[3], vb, pa0, pa1, pa2, pa3);
}
__device__ __forceinline__ void attn_dense_body(const bf16_t* __restrict__ Qb, const bf16_t* __restrict__ Kh, const bf16_t* __restrict__ Vh, bf16_t* __restrict__ Ob, int seq, char* lds) {
  const int tid = opaque_tid(), wid = tid >> 6, lane = tid & 63, r32 = lane & 31, hi = lane >> 5;
  bf16_t* V_lds = (bf16_t*)lds; bf16_t* K_lds = (bf16_t*)(lds + 2 * SHM_V);
  float* ws = (float*)(lds + 2 * SHM_V + 2 * SHM_K) + wid * 64; float* li_l = ws; float* al_l = ws + 32;
  float m_reg = -1e30f, l_reg = 0; f32x16 o[4] = {}; bf16x8 qr[8];
  const bf16_t* Qw = Qb + (long)(wid * QBLK + r32) * LDQ + hi * 8;
#pragma unroll
  for (int d0 = 0; d0 < 8; ++d0) qr[d0] = *reinterpret_cast<const bf16x8*>(Qw + d0 * 16);
  const int sr = tid >> 4, sc = (tid & 15) * 8, vst0 = v_st(sr, sc), vst1 = v_st(32 + sr, sc);
  const int vb0 = (int)(uintptr_t)V_lds + v_rd_base(lane);
  struct { bf16x8 vs0, vs1, ks0, ks1; } sr_[2];
#define SLOAD(i, k0) do { sr_[i].vs0 = *reinterpret_cast<const bf16x8*>(&Vh[(long)((k0) + sr) * LDK + sc]); sr_[i].vs1 = *reinterpret_cast<const bf16x8*>(&Vh[(long)((k0) + 32 + sr) * LDK + sc]); \
    sr_[i].ks0 = *reinterpret_cast<const bf16x8*>(&Kh[(long)((k0) + sr) * LDK + sc]); sr_[i].ks1 = *reinterpret_cast<const bf16x8*>(&Kh[(long)((k0) + 32 + sr) * LDK + sc]); } while (0)
#define SWRITE(b, i) do { *(bf16x8*)((char*)V_lds + (b) * SHM_V + vst0) = sr_[i].vs0;          \
    *(bf16x8*)((char*)V_lds + (b) * SHM_V + vst1) = sr_[i].vs1; int kc = sc * 2;               \
    *(bf16x8*)((char*)K_lds + (b) * SHM_K + KSWZ(sr, kc)) = sr_[i].ks0;                       \
    *(bf16x8*)((char*)K_lds + (b) * SHM_K + KSWZ(32 + sr, kc)) = sr_[i].ks1; } while (0)
#define SWAIT() asm volatile("s_waitcnt vmcnt(4)" ::: "memory")
#define RESC(a) do { if (__any((a) < 1.f)) { if (hi == 0) al_l[r32] = (a); asm volatile("s_waitcnt lgkmcnt(0)" ::: "memory"); \
    for (int d = 0; d < 4; ++d) for (int r = 0; r < 16; ++r) o[d][r] *= al_l[crow(r, hi)]; } } while (0)
  f32x16 pA0, pA1, pB0, pB1; float mnA, mnB, alA, alB; bf16x8 pa0, pa1, pa2, pa3; const int NT = seq / KVBLK;
  constexpr int SE = 0, SO = 1;
  SLOAD(SE, 0); asm volatile("s_waitcnt vmcnt(0)" ::: "memory"); SWRITE(0, SE); __syncthreads();
  qkt(pA0, pA1, K_lds, qr, r32, hi); partialSM(pA0, pA1, m_reg, mnA, alA);
  SLOAD(SO, KVBLK); if (2 < NT) SLOAD(SE, 2 * KVBLK);
  SWAIT(); SWRITE(1, SO); __syncthreads();
  for (int j = 1; j + 1 < NT; j += 2) {
    SBAR(); qkt(pB0, pB1, (bf16_t*)((char*)K_lds + SHM_K), qr, r32, hi);
    finishSM(pA0, pA1, alA, l_reg, pa0, pa1, pa2, pa3); SBAR();
    SLOAD(SO, (j + 2) * KVBLK); SBAR();
    pv_d0(o, vb0, pa0, pa1, pa2, pa3); partialSM(pB0, pB1, m_reg, mnB, alB);
    __syncthreads(); SWAIT(); SWRITE(0, SE);
    RESC(alB); __syncthreads();
    SBAR(); qkt(pA0, pA1, K_lds, qr, r32, hi);
    finishSM(pB0, pB1, alB, l_reg, pa0, pa1, pa2, pa3); SBAR();
    if (j + 3 < NT) SLOAD(SE, (j + 3) * KVBLK); SBAR();
    pv_d0(o, vb0 + (int)SHM_V, pa0, pa1, pa2, pa3); partialSM(pA0, pA1, m_reg, mnA, alA);
    __syncthreads(); SWAIT(); SWRITE(1, SO);
    RESC(alA); __syncthreads();
  }
  SBAR(); qkt(pB0, pB1, (bf16_t*)((char*)K_lds + SHM_K), qr, r32, hi);
  finishSM(pA0, pA1, alA, l_reg, pa0, pa1, pa2, pa3); SBAR();
  pv_d0(o, vb0, pa0, pa1, pa2, pa3); partialSM(pB0, pB1, m_reg, mnB, alB);
  __syncthreads(); RESC(alB);
  finishSM(pB0, pB1, alB, l_reg, pa0, pa1, pa2, pa3); SBAR();
  pv_d0(o, vb0 + (int)SHM_V, pa0, pa1, pa2, pa3);
  if (hi == 0) li_l[r32] = l_reg; asm volatile("s_waitcnt lgkmcnt(0)" ::: "memory");
  float rli[16];
#pragma unroll
  for (int r = 0; r < 16; ++r) rli[r] = __builtin_amdgcn_rcpf(li_l[crow(r, hi)]);
  bf16_t* Ow = Ob + (long)(wid * QBLK) * LDO;
#pragma unroll
  for (int r = 0; r < 16; ++r) { int orow = crow(r, hi);
    for (int d0 = 0; d0 < 4; ++d0) Ow[(long)orow * LDO + d0 * 32 + r32] = (bf16_t)f2bf(o[d0][r] * rli[r]); }
  __syncthreads();
#undef SLOAD
#undef SWRITE
#undef SWAIT
#undef RESC
}
#else
inline void attn_dense_body(const bf16_t* Qb, const bf16_t* Kh, const bf16_t* Vh, bf16_t* Ob, int seq, char*) {
  const int tid = threadIdx.x; if (tid >= 256) return;
  const bf16_t* q = Qb + (long)tid * LDQ; std::vector<float> sc(seq); float mx = -1e30f;
  for (int k = 0; k < seq; ++k) { float s = 0; for (int d = 0; d < HD; ++d) s += bf2f(q[d]) * bf2f(Kh[(long)k * LDK + d]); sc[k] = s * SCALE; mx = fmaxf(mx, sc[k]); }
  float l = 0; for (int k = 0; k < seq; ++k) { sc[k] = expf(sc[k] - mx); l += sc[k]; }
  for (int d = 0; d < HD; ++d) { float o = 0; for (int k = 0; k < seq; ++k) o += sc[k] * bf2f(Vh[(long)k * LDK + d]); Ob[(long)tid * LDO + d] = (bf16_t)f2bf(o / l); }
}
#endif
}
DEV void phase_attn(const Params& P, const Ctx& C, bool need_ctx) {
    constexpr int QBL = TL / 256, QBC = TC / 256, NUL = NB * AH * QBL;
    const int nu = NUL + (need_ctx ? NB * AH * QBC : 0);
    for (int u = C.bid; u < nu; u += C.nblk) {
        const bool lat = u < NUL; const int v = lat ? u : u - NUL, nqb = lat ? QBL : QBC;
        const int qb = v % nqb, h = (v / nqb) % AH, b = v / (nqb * AH), kvh = h / (AH / AKV);
        const int row0 = lat ? lat_row(b, qb * 256) : ctx_row(b, qb * 256);
        const bf16_t* Kh = WSP(bf16_t, WS_KCAT) + (size_t)b * TT * KV_W + kvh * HD; const bf16_t* Vh = WSP(bf16_t, WS_VCAT) + (size_t)b * TT * KV_W + kvh * HD;
        att::attn_dense_body(WSP(bf16_t, WS_QA) + (size_t)row0 * ATT_W + h * HD, Kh, Vh, WSP(bf16_t, WS_Y) + (size_t)row0 * BW + h * HD, lat ? TT : TC, (char*)C.lds);
    }
}

constexpr size_t SM2_PE = 0;
constexpr int CW_PE = 2048, CW_NPAN = 2047;
static_assert(CW_PE + MOE_PANELS <= CW_BAR, "panel table fits below the barrier words");
DEV void phase_moe_gather(const Params& P, const Ctx& C) {
    const unsigned* cnt = WSP(unsigned, WS_CTL) + CW_CNT;
    int poff[NE + 1]; poff[0] = 0;
#pragma unroll
    for (int e = 0; e < NE; ++e) poff[e + 1] = poff[e] + (int)((cnt[e] + 255u) / 256u) * 256;
    if (C.bid == 0 && C.tid < MOE_PANELS) { int e = -1;
#pragma unroll
        for (int q = 0; q < NE; ++q) if (C.tid * 256 >= poff[q] && C.tid * 256 < poff[q + 1]) e = q;
        WSP(int, WS_CTL)[CW_PE + C.tid] = e < 0 ? 0 : e; if (C.tid == 0) WSP(int, WS_CTL)[CW_NPAN] = poff[NE] / 256; }
    const int* te = WSP(int, WS_SMALL + SM_TE); const float* tw = WSP(float, WS_SMALL + SM_TW); const int* tp = WSP(int, WS_SMALL + SM_TP);
    for (int i = C.gw; i < MLAT * 2; i += C.ngw) {
        const int tok = i >> 1, k = i & 1, e = te[i]; int base = 0;
#pragma unroll
        for (int q = 0; q < NE; ++q) if (q == e) base = poff[q];
        const int r = base + tp[i];
        const u32x4* src = (const u32x4*)(WSP(bf16_t, WS_H) + (size_t)tok * D); u32x4* dst = (u32x4*)(WSP(bf16_t, WS_APERM) + (size_t)r * D);
        for (int q = C.lane; q < D / 8; q += 64) dst[q] = src[q];
        if (C.lane == 0) { WSP(int, WS_SMALL + SM_RTOK)[r] = tok; WSP(float, WS_SMALL + SM_RW)[r] = tw[i]; WSP(int, WS_SMALL + SM_RSLOT)[r] = k; }
    }
}
DEV void phase_moe_combine(const Params& P, const Ctx& C, int l) {
    const int gt = C.bid * NTHREADS + C.tid, ngt = C.nblk * NTHREADS;
    const float* ys = WSP(float, WS_YS);
    for (int i = gt; i < MLAT * (D / 4); i += ngt) {
        const int row = i / (D / 4), col = (i % (D / 4)) * 4;
        const f32x4 g = *(const f32x4*)(mod_vec(P, l, row_vec(row), 5) + col);
        *(f32x4*)(P.out + (size_t)row * D + col) = *(const f32x4*)(WSP(float, WS_X1) + (size_t)row * D + col) + g * (*(const f32x4*)(ys + (size_t)row * D + col) + *(const f32x4*)(ys + ((size_t)MLAT + row) * D + col));
    }
}

#ifndef HOST_EMU
#define LAS __attribute__((address_space(3)))
#define XB_TMO      128
#define XB_XCNT(j)  (256  + 64 * (j))
#define XB_XSUB(j)  (1280 + 64 * (j))
#define XB_XGEN(j)  (2304 + 64 * (j))
#define XB_TOP      3328
#define XB_TOPGEN   3392
#define XCD_BAR_WORDS 3456
#define XB_SPIN_CAP (1u << 18)
__device__ __forceinline__ unsigned xb_ld(unsigned* p)              { return __hip_atomic_load(p, __ATOMIC_RELAXED, __HIP_MEMORY_SCOPE_AGENT); }
__device__ __forceinline__ unsigned xb_add(unsigned* p, unsigned v) { return __hip_atomic_fetch_add(p, v, __ATOMIC_RELAXED, __HIP_MEMORY_SCOPE_AGENT); }
__device__ __forceinline__ unsigned xb_xcc_id() { return (unsigned)__builtin_amdgcn_s_getreg((3 << 11) | 20) & 0xFu; }
#define XB_SPIN(cond, bar) do { unsigned _sp = 0; while (cond) { __builtin_amdgcn_s_sleep(1); \
    if ((++_sp & 255u) == 0u) { if (xb_ld(&(bar)[XB_TMO])) break; if (_sp > XB_SPIN_CAP) { atomicAdd(&(bar)[XB_TMO], 1u); break; } } } } while (0)
struct XcdBarrier { unsigned* bar; unsigned x; volatile LAS unsigned* st; };
__device__ __forceinline__ XcdBarrier xcd_barrier_post(unsigned* bar, volatile LAS unsigned* st) {
    XcdBarrier b; b.bar = bar; b.x = xb_xcc_id(); b.st = st;
    if (threadIdx.x == 0) (void)xb_add(&bar[XB_XCNT(b.x)], 1u);
    return b;
}
__device__ __forceinline__ void xcd_barrier_complete(unsigned* bar, unsigned x, unsigned& nloc, unsigned& nx) {
    const unsigned G = gridDim.x * gridDim.y * gridDim.z;
    unsigned sum, cnt, mine, sp = 0u;
    for (;;) {
        sum = 0u; cnt = 0u; mine = 0u;
#pragma unroll
        for (unsigned j = 0; j < 16; ++j) { const unsigned c = xb_ld(&bar[XB_XCNT(j)]); sum += c; cnt += (c > 0u) ? 1u : 0u; mine = (j == x) ? c : mine; }
        if (sum == G) break;
        __builtin_amdgcn_s_sleep(1);
        if ((++sp & 255u) == 0u) { if (xb_ld(&bar[XB_TMO])) break; if (sp > XB_SPIN_CAP) { atomicAdd(&bar[XB_TMO], 1u); break; } }
    }
    nloc = mine > 0u ? mine : 1u; nx = cnt > 0u ? cnt : 1u;
}
__device__ __forceinline__ void xcd_barrier(const XcdBarrier& b) {
    asm volatile("s_waitcnt vmcnt(0)" ::: "memory");
    __syncthreads();
    if (threadIdx.x == 0) {
        unsigned* bar = b.bar;
        __builtin_amdgcn_s_waitcnt(0);
        unsigned nloc = b.st[0], nx = b.st[1];
        if (nloc == 0u) { xcd_barrier_complete(bar, b.x, nloc, nx); b.st[0] = nloc; b.st[1] = nx; }
        const unsigned old = xb_add(&bar[XB_XSUB(b.x)], 1u);
        const unsigned gen = old / nloc;
        if (old + 1u == (gen + 1u) * nloc) {
            __builtin_amdgcn_fence(__ATOMIC_RELEASE, "agent");
            asm volatile("s_waitcnt vmcnt(0)" ::: "memory");
            const unsigned og = xb_add(&bar[XB_TOP], 1u);
            const unsigned tg = og / nx;
            if (og + 1u == (tg + 1u) * nx) xb_add(&bar[XB_TOPGEN], 1u);
            else XB_SPIN(xb_ld(&bar[XB_TOPGEN]) == tg, bar);
            __builtin_amdgcn_fence(__ATOMIC_ACQUIRE, "agent");
            xb_add(&bar[XB_XGEN(b.x)], 1u);
            asm volatile("s_waitcnt vmcnt(0)" ::: "memory");
        } else {
            XB_SPIN(xb_ld(&bar[XB_XGEN(b.x)]) == gen, bar);
            __builtin_amdgcn_fence(__ATOMIC_ACQUIRE, "agent");
            asm volatile("s_waitcnt vmcnt(0)" ::: "memory");
        }
    }
    __syncthreads();
}
#define GEMM_LDS(C) ((PG8_LAS unsigned char*)(C).lds)
#else
struct XcdBarrier { int dummy; };
inline void xcd_barrier(const XcdBarrier&) {}
#define GEMM_LDS(C) ((C).lds)
#endif

constexpr int NPL = 13, NPHASES = 2 + DEPTH * NPL;
DEV void run_phases(const Params& P, unsigned char* ldsp, const int lo, const int hi, const XcdBarrier& bar) {
#define C make_ctx(ldsp)
#define IN(k) (lo <= (k) && (k) < hi)
#define SEAM(k) do { if (IN(k) && IN((k) + 1)) xcd_barrier(bar); } while (0)
    if (IN(0)) { phase_weights(P, C); phase_mod_partial(P, C); }
    SEAM(0);
    if (IN(1)) phase_mod_final(P, C);
    SEAM(1);
    for (int l = 0; l < DEPTH; ++l) {
        const int pb = 2 + l * NPL; const bool need_ctx = l < DEPTH - 1, moe = (l & 1) != 0;
        const int rows = need_ctx ? MT : MLAT;
        if (IN(pb + 0)) phase_hpass(P, C, l, 0, false);
        SEAM(pb + 0);
        if (IN(pb + 1)) {
            pg8::Gemm g{WSP(bf16_t, WS_H), WSP(bf16_t, WS_WIN) + (size_t)l * NP * D, D};
            pg8::PanelOrder S; S.init(MT / 256, NP / 256, C.nblk, C.bid, nullptr);
            EpiInProj E{WSP(bf16_t, WS_P), WSP(float, WS_G16)};
            pg8::gemm_phase<EpiInProj, pg8::PanelOrder, true, true>(GEMM_LDS(C), g, S, E);
        }
        SEAM(pb + 1);
        if (IN(pb + 2)) phase_fixup(P, C, l, need_ctx);
        SEAM(pb + 2);
        if (IN(pb + 3)) phase_s1(P, C, l);
        SEAM(pb + 3);
        if (IN(pb + 4)) phase_s2(P, C);
        SEAM(pb + 4);
        if (IN(pb + 5)) { phase_attn(P, C, need_ctx); phase_s3(P, C, l, need_ctx); }
        SEAM(pb + 5);
        if (IN(pb + 6)) {
            for (int n = 0; n < 3; ++n) {
                pg8::Gemm g{WSP(bf16_t, WS_Y) + (size_t)n * MT * BW, WSP(bf16_t, WS_WBR) + (size_t)(l * 3 + n) * D * BW, BW};
                pg8::PanelOrder S; S.init(rows / 256, D / 256, C.nblk, C.bid, nullptr);
                EpiBranch E{WSP(bf16_t, WS_P), WSP(float, WS_MGF), WSP(bf16_t, WS_MG), n};
                pg8::gemm_phase<EpiBranch, pg8::PanelOrder, true, true>(GEMM_LDS(C), g, S, E);
            }
        }
        SEAM(pb + 6);
        if (IN(pb + 7)) {
            pg8::Gemm g{WSP(bf16_t, WS_MG), WSP(bf16_t, WS_WOUT) + (size_t)l * D * D, D};
            pg8::PanelOrder S; S.init(rows / 256, D / 256, C.nblk, C.bid, nullptr);
            const float* bL = l == 0 ? P.x : WSP(float, WS_X2); const float* bC = l == 0 ? P.ctx : WSP(float, WS_X2) + (size_t)MLAT * D;
            EpiResid E{bL, bC, WSP(float, WS_X1), WSP(float, WS_X1) + (size_t)MLAT * D, mod_vec(P, l, 0, 2), false, nullptr, nullptr, nullptr, nullptr};
            pg8::gemm_phase<EpiResid, pg8::PanelOrder, true, true>(GEMM_LDS(C), g, S, E);
        }
        SEAM(pb + 7);
        if (IN(pb + 8)) phase_hpass(P, C, l, 1, moe);
        SEAM(pb + 8);
        if (IN(pb + 9)) { if (moe) phase_moe_gather(P, C); }
        SEAM(pb + 9);
        if (IN(pb + 10)) {
            pg8::Gemm g{moe ? WSP(bf16_t, WS_APERM) : WSP(bf16_t, WS_H), moe ? WSP(bf16_t, WS_WMGU) + (size_t)(l / 2) * NE * 2 * DFF * D : WSP(bf16_t, WS_WGU) + (size_t)(l / 2) * 2 * DFF * D, D};
            pg8::PanelOrder S; S.init(moe ? WSP(int, WS_CTL)[CW_NPAN] : rows / 256, 2 * DFF / 256, C.nblk, C.bid, moe ? WSP(int, WS_CTL) + CW_PE : nullptr);
            EpiGU E{WSP(bf16_t, WS_ACT)};
            pg8::gemm_phase<EpiGU, pg8::PanelOrder, true, true>(GEMM_LDS(C), g, S, E);
        }
        SEAM(pb + 10);
        if (IN(pb + 11)) {
            pg8::Gemm g{WSP(bf16_t, WS_ACT), moe ? WSP(bf16_t, WS_WMDN) + (size_t)(l / 2) * NE * D * DFF : WSP(bf16_t, WS_WDN) + (size_t)(l / 2) * D * DFF, DFF};
            pg8::PanelOrder S; S.init(moe ? WSP(int, WS_CTL)[CW_NPAN] : rows / 256, D / 256, C.nblk, C.bid, moe ? WSP(int, WS_CTL) + CW_PE : nullptr);
            float* oL = (l == DEPTH - 1) ? P.out : WSP(float, WS_X2);
            EpiResid E{WSP(float, WS_X1), WSP(float, WS_X1) + (size_t)MLAT * D, oL, WSP(float, WS_X2) + (size_t)MLAT * D, mod_vec(P, l, 0, 5), moe,
                       WSP(int, WS_SMALL + SM_RTOK), WSP(float, WS_SMALL + SM_RW), WSP(int, WS_SMALL + SM_RSLOT), WSP(float, WS_YS)};
            pg8::gemm_phase<EpiResid, pg8::PanelOrder, true, true>(GEMM_LDS(C), g, S, E);
        }
        SEAM(pb + 11);
        if (IN(pb + 12)) { if (moe) phase_moe_combine(P, C, l); }
        if (l + 1 < DEPTH) SEAM(pb + 12);
    }
#undef IN
#undef SEAM
#undef C
}

struct Args { Params P; int ph_lo, ph_hi; };
#if !defined(HOST_EMU) && !defined(NO_MAIN_KERNEL)
constexpr int MISC_OFF = 131072 + 320;
__global__ void __launch_bounds__(NTHREADS, 2) hybrid_fwd(Args a) {
    extern __shared__ __attribute__((aligned(16))) unsigned char lds[];
    volatile LAS unsigned* MISC = (volatile LAS unsigned*)((LAS unsigned char*)lds + MISC_OFF);
    if (threadIdx.x < 32) MISC[threadIdx.x] = 0u;
    __syncthreads();
    XcdBarrier bar = xcd_barrier_post((unsigned*)(a.P.ws + WS_CTL) + CW_BAR, MISC + 8);
    run_phases(a.P, lds, a.ph_lo, a.ph_hi, bar);
}

#ifndef N_LAUNCH_MODE
#define N_LAUNCH_MODE 1
#endif
extern "C" void kernel_launch(void* const* d_in, const int* in_sizes, int n_in, void* d_out, int out_size, void* d_ws, size_t ws_size, hipStream_t stream) {
    static int grid = 0;
    if (grid == 0) {
        if (n_in != 25 || in_sizes[0] != MLAT * D || out_size != MLAT * D || ws_size < WS_END) {
            fprintf(stderr, "kernel_launch: unexpected shapes: n_in %d in0 %d out %d ws %zu (need %zu)\n", n_in, n_in > 0 ? in_sizes[0] : -1, out_size, ws_size, (size_t)WS_END); grid = -1; return; }
        int dev = 0, cus = 0, per_cu = 0;
        if (hipGetDevice(&dev) != hipSuccess || hipDeviceGetAttribute(&cus, hipDeviceAttributeMultiprocessorCount, dev) != hipSuccess) { grid = -1; return; }
        if (hipFuncSetAttribute((const void*)hybrid_fwd, hipFuncAttributeMaxDynamicSharedMemorySize, LDS_BYTES) != hipSuccess) { fprintf(stderr, "kernel_launch: hipFuncSetAttribute failed\n"); grid = -1; return; }
        if (hipOccupancyMaxActiveBlocksPerMultiprocessor(&per_cu, (const void*)hybrid_fwd, NTHREADS, LDS_BYTES) != hipSuccess || per_cu < 1) fprintf(stderr, "kernel_launch: occupancy query says %d\n", per_cu);
        (void)hipGetLastError();
        grid = cus;
    }
    if (grid < 0) return;
    (void)hipMemsetAsync((char*)d_ws + WS_CTL, 0, CTL_BYTES, stream);
    Args a{};
    const float** pp = (const float**)&a.P;
    for (int i = 0; i < 25; ++i) pp[i] = (const float*)d_in[i];
    a.P.out = (float*)d_out; a.P.ws = (unsigned char*)d_ws;
    if (N_LAUNCH_MODE == 1) { a.ph_lo = 0; a.ph_hi = NPHASES; hipLaunchKernelGGL(hybrid_fwd, dim3(grid), dim3(NTHREADS), LDS_BYTES, stream, a); }
    else for (int ph = 0; ph < NPHASES; ++ph) { a.ph_lo = ph; a.ph_hi = ph + 1; hipLaunchKernelGGL(hybrid_fwd, dim3(grid), dim3(NTHREADS), LDS_BYTES, stream, a); }
    const hipError_t le = hipPeekAtLastError();
    if (le != hipSuccess) fprintf(stderr, "kernel_launch: launch failed: %s\n", hipGetErrorName(le));
}
#endif
```

```cpp
#ifdef HOST_EMU
#include "emu.h"
#define DEV inline
#define WAVE_LDS_SYNC() emu::wave_barrier()
#define MFMA32(a, b, c) emu_mfma_32x32x16_bf16((a), (b), (c))
#define LDS_BASE() EMU_LDS_BASE()
#else
#include <hip/hip_runtime.h>
#include <cstdio>
#define DEV __device__ __forceinline__
#define WAVE_LDS_SYNC() asm volatile("s_waitcnt lgkmcnt(0)" ::: "memory")
#define MFMA32(a, b, c) __builtin_amdgcn_mfma_f32_32x32x16_bf16((a), (b), (c), 0, 0, 0)
typedef short bf16x8 __attribute__((ext_vector_type(8)));
typedef float f32x16 __attribute__((ext_vector_type(16)));
typedef float f32x4 __attribute__((ext_vector_type(4)));
#endif
typedef unsigned short bf16_t;
typedef unsigned u32x4 __attribute__((ext_vector_type(4)));
typedef unsigned u32x2 __attribute__((ext_vector_type(2)));
typedef float f32x2 __attribute__((ext_vector_type(2)));

#ifdef SMALL_CFG
constexpr int D = 512, NB = 2, TL = 256, TC = 256, AH = 4, AKV = 2, MLH = 2, HGH = 4, DFF = 768;
#else
constexpr int D = 2048, NB = 2, TL = 4096, TC = 256, AH = 8, AKV = 2, MLH = 4, HGH = 8, DFF = 5632;
#endif
constexpr int DEPTH = 2, GRIDW = 64, HD = 128, ATT_W = AH * HD, KV_W = AKV * HD, MDK = 256, MDV = 256, ML_W = MLH * MDV, HDK = 128, HDV = 128, HG_W = HGH * HDV;
constexpr int BW = ATT_W, NE = 8, CH = 64, NV = NB + 1;
constexpr float EPS = 1e-6f;
constexpr int MLAT = NB * TL, MCTX = NB * TC, MT = MLAT + MCTX, TT = TC + TL, NCH = TT / CH, NCHC = TC / CH;
constexpr int NG = 4 * MLH;
static_assert(ML_W == BW && HG_W == BW && NG <= 16 && TC % 256 == 0 && TL % 256 == 0 && D % 256 == 0 && DFF % 128 == 0, "config");
constexpr int OQ = 0, OK_ = OQ + ATT_W, OV = OK_ + KV_W, OMQ = OV + KV_W, OMK = OMQ + ML_W, OMV = OMK + ML_W, OMO = OMV + ML_W, OMG = OMO + ML_W;
constexpr int OHQ = OMG + NG, OHF = OHQ + HG_W, OHB = OHF + HG_W, OHI = OHB + HG_W, OHG = OHI + HG_W, OGATE = OHG + HG_W, N_IN = OGATE + 3 * D;
constexpr int PQ = OQ, PK = OK_, PV = OV, PMQ = OMQ, PMK = OMK, PMV = OMV, PMO = OMO, PHQ = OMG, PHF = PHQ + HG_W, PHB = PHF + HG_W, PHI = PHB + HG_W, PHG = PHI + HG_W, PGATE = PHG + HG_W;
constexpr int NPB = N_IN - NG, NP = NPB + 256;
static_assert(NPB % 256 == 0 && PGATE + 3 * D == NPB, "projection layout");
constexpr int MOE_ROWS = MLAT * 2 + NE * 256, MOE_PANELS = MOE_ROWS / 256;
constexpr int NSQM = NB * MLH * 2, NSQH = NB * HGH * 2;

constexpr size_t al256(size_t x) { return (x + 255) / 256 * 256; }
constexpr size_t WS_CTL = 0, CTL_BYTES = 1u << 20;
constexpr size_t WS_MODP = WS_CTL + CTL_BYTES;
constexpr size_t WS_MOD = WS_MODP + al256((size_t)(D / 64) * DEPTH * NV * 6 * D * 4);
constexpr size_t WS_LB = WS_MOD + al256((size_t)DEPTH * NV * 6 * D * 4);
constexpr size_t WS_WIN = WS_LB + al256((size_t)DEPTH * HG_W * 4);
constexpr size_t WS_WBR = WS_WIN + al256((size_t)DEPTH * NP * D * 2);
constexpr size_t WS_WOUT = WS_WBR + al256((size_t)DEPTH * 3 * D * BW * 2);
constexpr size_t WS_WGU = WS_WOUT + al256((size_t)DEPTH * D * D * 2);
constexpr size_t WS_WDN = WS_WGU + al256((size_t)2 * DFF * D * 2);
constexpr size_t WS_WMGU = WS_WDN + al256((size_t)D * DFF * 2);
constexpr size_t WS_WMDN = WS_WMGU + al256((size_t)NE * 2 * DFF * D * 2);
constexpr size_t WS_H = WS_WMDN + al256((size_t)NE * D * DFF * 2);
constexpr size_t WS_G16 = WS_H + al256((size_t)MT * D * 2);
constexpr size_t WS_QA = WS_G16 + al256((size_t)MT * 16 * 4);
constexpr size_t WS_KCAT = WS_QA + al256((size_t)MT * ATT_W * 2);
constexpr size_t WS_VCAT = WS_KCAT + al256((size_t)NB * TT * KV_W * 2);
constexpr size_t WS_QM = WS_VCAT + al256((size_t)NB * TT * KV_W * 2);
constexpr size_t WS_KM = WS_QM + al256((size_t)MT * ML_W * 2);
constexpr size_t WS_Y = WS_KM + al256((size_t)MT * ML_W * 2);
constexpr size_t WS_MGF = WS_Y + al256((size_t)3 * MT * BW * 2);
constexpr size_t WS_MG = WS_MGF + al256((size_t)MT * D * 4);
constexpr size_t WS_X1 = WS_MG + al256((size_t)MT * D * 2);
constexpr size_t WS_X2 = WS_X1 + al256((size_t)MT * D * 4);
constexpr size_t WS_SMALL = WS_X2 + al256((size_t)MT * D * 4);
constexpr size_t SM_FL = 0;
constexpr size_t SM_MLOC = SM_FL + al256((size_t)NSQM * NCH * 4);
constexpr size_t SM_MST = SM_MLOC + al256((size_t)NSQM * NCH * 4);
constexpr size_t SM_NLOC = SM_MST + al256((size_t)NSQM * NCH * 4);
constexpr size_t SM_LAM = SM_NLOC + al256((size_t)NSQM * NCH * MDK * 4);
constexpr size_t SM_TE = SM_LAM + al256((size_t)NSQH * NCH * HDK * 4);
constexpr size_t SM_TW = SM_TE + al256((size_t)MLAT * 2 * 4);
constexpr size_t SM_TP = SM_TW + al256((size_t)MLAT * 2 * 4);
constexpr size_t SM_RTOK = SM_TP + al256((size_t)MLAT * 2 * 4);
constexpr size_t SM_RW = SM_RTOK + al256((size_t)MOE_ROWS * 4);
constexpr size_t SM_RSLOT = SM_RW + al256((size_t)MOE_ROWS * 4);
constexpr size_t SM_END = SM_RSLOT + al256((size_t)MOE_ROWS * 4);
constexpr size_t WS_BIG = WS_SMALL + SM_END;
constexpr size_t WS_P = WS_BIG;
constexpr size_t WS_ACT = WS_BIG;
constexpr size_t WS_APERM = WS_ACT + al256((size_t)MOE_ROWS * DFF * 2);
constexpr size_t BIG_BYTES = al256((size_t)MT * NPB * 2) > al256((size_t)MOE_ROWS * DFF * 2) + al256((size_t)MOE_ROWS * D * 2) ? al256((size_t)MT * NPB * 2) : al256((size_t)MOE_ROWS * DFF * 2) + al256((size_t)MOE_ROWS * D * 2);
constexpr size_t WS_ST = WS_BIG + BIG_BYTES;
constexpr size_t WS_CSTM = WS_ST;
constexpr size_t WS_CSTH = WS_CSTM + al256((size_t)NSQM * NCH * MDV * MDK * 2);
constexpr size_t WS_YS = WS_ST;
constexpr size_t ST_BYTES = al256((size_t)NSQM * NCH * MDV * MDK * 2) + al256((size_t)NSQH * NCH * HDV * HDK * 2) > al256((size_t)2 * MLAT * D * 4) ? al256((size_t)NSQM * NCH * MDV * MDK * 2) + al256((size_t)NSQH * NCH * HDV * HDK * 2) : al256((size_t)2 * MLAT * D * 4);
constexpr size_t WS_END = WS_ST + ST_BYTES;
constexpr int CW_BAR = 4096;
constexpr int CW_CNT = 1024;

constexpr int NTHREADS = 512, NWAVES = 8;
constexpr int LDS_BYTES = 147456;

struct Params {
    const float *x, *c, *ctx, *c_ctx, *w_mod, *b_mod, *norm1_g, *norm2_g, *w_in, *qn_g, *kn_g, *conv_w, *gate_b, *ml_norm_g, *lb_logits, *hg_norm_g,
        *w_branch, *w_out, *ffn_wg, *ffn_wu, *ffn_wd, *moe_wr, *moe_wg, *moe_wu, *moe_wd;
    float* out; unsigned char* ws;
};

DEV unsigned fbits(float f) { return __builtin_bit_cast(unsigned, f); }
DEV float bitsf(unsigned u) { return __builtin_bit_cast(float, u); }
DEV float bf2f(bf16_t h) { return bitsf(((unsigned)h) << 16); }
DEV unsigned f2bf(float f) { const unsigned u = fbits(f); return (u + 0x7fffu + ((u >> 16) & 1u)) >> 16; }
DEV unsigned pk2(float lo, float hi) { return f2bf(lo) | (f2bf(hi) << 16); }
#ifdef HOST_EMU
DEV float fexp(float x) { return expf(x); }
#else
DEV float fexp(float x) { return __builtin_amdgcn_exp2f(x * 1.4426950408889634f); }
#endif
DEV float sigmoidf_(float x) { return 1.0f / (1.0f + expf(-x)); }
DEV float siluf_(float x) { return x * sigmoidf_(x); }
DEV float logsigmoidf_(float x) { return fminf(x, 0.f) - log1pf(expf(-fabsf(x))); }
DEV float wave_sum(float v) {
#pragma unroll
    for (int o = 1; o < 64; o <<= 1) v += __shfl_xor(v, o);
    return v;
}
DEV int crow(int r, int hi) { return (r & 3) + 8 * (r >> 2) + 4 * hi; }
#ifdef HOST_EMU
typedef s16x4_emu s16x4;
DEV void tr_issue(s16x4& lo, s16x4& hi4, const bf16_t* X, int px, int k0, int n0, int lane) {
    const bf16_t* a = X + (size_t)(k0 + 8 * (lane >> 5) + ((lane & 15) >> 2)) * px + n0 + 16 * ((lane >> 4) & 1) + 4 * (lane & 3);
    lo = emu_tr_read(a); hi4 = emu_tr_read(a + 4 * px);
}
#define TR_WAIT2(a, b) do {} while (0)
#define TR_WAIT4(a, b, c, d) do {} while (0)
#define TR_WAIT8(a, b, c, d, e, f, g, h) do {} while (0)
#else
typedef short s16x4 __attribute__((ext_vector_type(4)));
DEV void tr_issue(s16x4& lo, s16x4& hi4, const bf16_t* X, int px, int k0, int n0, int lane) {
    const bf16_t* a = X + (size_t)(k0 + 8 * (lane >> 5) + ((lane & 15) >> 2)) * px + n0 + 16 * ((lane >> 4) & 1) + 4 * (lane & 3);
    const unsigned a0 = (unsigned)(uintptr_t)a, a1 = (unsigned)(uintptr_t)(a + 4 * px);
    asm volatile("ds_read_b64_tr_b16 %0, %1" : "=&v"(lo) : "v"(a0) : "memory");
    asm volatile("ds_read_b64_tr_b16 %0, %1" : "=&v"(hi4) : "v"(a1) : "memory");
}
#define TR_WAIT2(a, b) asm volatile("s_waitcnt lgkmcnt(0)" : "+v"(a), "+v"(b) :: "memory")
#define TR_WAIT4(a, b, c, d) asm volatile("s_waitcnt lgkmcnt(0)" : "+v"(a), "+v"(b), "+v"(c), "+v"(d) :: "memory")
#define TR_WAIT8(a, b, c, d, e, f, g, h) asm volatile("s_waitcnt lgkmcnt(0)" : "+v"(a), "+v"(b), "+v"(c), "+v"(d), "+v"(e), "+v"(f), "+v"(g), "+v"(h) :: "memory")
#endif
#define TR_PK(L, H) ((bf16x8){(L)[0], (L)[1], (L)[2], (L)[3], (H)[0], (H)[1], (H)[2], (H)[3]})
DEV float wave_max(float v) {
#pragma unroll
    for (int o = 1; o < 64; o <<= 1) v = fmaxf(v, __shfl_xor(v, o));
    return v;
}
DEV float wave_scan_add(float v, int lane) {
#pragma unroll
    for (int o = 1; o < 64; o <<= 1) { const float t = __shfl(v, (lane - o) & 63); if (lane >= o) v += t; }
    return v;
}
DEV float wave_scan_max(float v, int lane) {
#pragma unroll
    for (int o = 1; o < 64; o <<= 1) { const float t = __shfl(v, (lane - o) & 63); if (lane >= o) v = fmaxf(v, t); }
    return v;
}
DEV void unpack8(const u32x4 w, float (&f)[8]) {
    f[0] = bitsf(w.x << 16); f[1] = bitsf(w.x & 0xffff0000u); f[2] = bitsf(w.y << 16); f[3] = bitsf(w.y & 0xffff0000u);
    f[4] = bitsf(w.z << 16); f[5] = bitsf(w.z & 0xffff0000u); f[6] = bitsf(w.w << 16); f[7] = bitsf(w.w & 0xffff0000u);
}
DEV u32x4 pack8(const float (&f)[8]) { u32x4 w; w.x = pk2(f[0], f[1]); w.y = pk2(f[2], f[3]); w.z = pk2(f[4], f[5]); w.w = pk2(f[6], f[7]); return w; }
DEV int lat_row(int b, int t) { return b * TL + t; }
DEV int ctx_row(int b, int t) { return MLAT + b * TC + t; }
DEV int seq_row(int b, int d, int p) {
    if (p < TC) return ctx_row(b, d ? TC - 1 - p : p);
    const int t = p - TC; return lat_row(b, d ? TL - 1 - t : t);
}
DEV int dir_chunk(int cc, int d) { if (!d) return cc; return cc < NCHC ? NCHC - 1 - cc : NCH - 1 - (cc - NCHC); }
DEV int chunk_row0(int b, int cc) { return cc < NCHC ? ctx_row(b, cc * CH) : lat_row(b, (cc - NCHC) * CH); }
DEV int row_vec(int row) { return row < MLAT ? row / TL : NB; }

#ifdef HOST_EMU
DEV int opaque_tid() { return threadIdx.x; }
#else
DEV int opaque_tid() { int t = threadIdx.x; asm volatile("" : "+v"(t)); return t; }
#endif
struct Ctx {
    int tid, lane, wave, gw, ngw, bid, nblk; unsigned char* lds;
};
DEV Ctx make_ctx(unsigned char* lds) {
    Ctx c; c.tid = opaque_tid(); c.lane = c.tid & 63; c.wave = c.tid >> 6; c.bid = blockIdx.x; c.nblk = gridDim.x; c.gw = c.bid * NWAVES + c.wave; c.ngw = c.nblk * NWAVES; c.lds = lds; return c;
}
#define WSP(T, off) ((T*)(P.ws + (off)))

struct Job { const float* src; int K, ld, c0, nc; bf16_t* dst; int r0, mode; };
constexpr int NJOBS = DEPTH * 6 + 3 + NE * 3;
DEV Job get_job(const Params& P, int j) {
    Job J; J.mode = 0; J.r0 = 0; J.c0 = 0;
    if (j < DEPTH * 6) {
        const int l = j / 6, k = j % 6;
        if (k == 0) { J.src = P.w_in + (size_t)l * D * N_IN; J.K = D; J.ld = N_IN; J.c0 = 0; J.nc = OMG; J.dst = WSP(bf16_t, WS_WIN) + (size_t)l * NP * D; J.r0 = 0; }
        else if (k == 1) { J.src = P.w_in + (size_t)l * D * N_IN; J.K = D; J.ld = N_IN; J.c0 = OMG + NG; J.nc = N_IN - OMG - NG; J.dst = WSP(bf16_t, WS_WIN) + (size_t)l * NP * D; J.r0 = OMG; }
        else if (k < 5) { const int n = k - 2; J.src = P.w_branch + (size_t)(l * 3 + n) * BW * D; J.K = BW; J.ld = D; J.nc = D; J.dst = WSP(bf16_t, WS_WBR) + (size_t)(l * 3 + n) * D * BW; }
        else { J.src = P.w_out + (size_t)l * D * D; J.K = D; J.ld = D; J.nc = D; J.dst = WSP(bf16_t, WS_WOUT) + (size_t)l * D * D; }
        return J;
    }
    j -= DEPTH * 6;
    if (j < 3) {
        if (j == 0) { J.src = P.ffn_wg; J.K = D; J.ld = DFF; J.nc = DFF; J.dst = WSP(bf16_t, WS_WGU); J.r0 = 0; J.mode = 1; }
        else if (j == 1) { J.src = P.ffn_wu; J.K = D; J.ld = DFF; J.nc = DFF; J.dst = WSP(bf16_t, WS_WGU); J.r0 = 128; J.mode = 1; }
        else { J.src = P.ffn_wd; J.K = DFF; J.ld = D; J.nc = D; J.dst = WSP(bf16_t, WS_WDN); }
        return J;
    }
    j -= 3; const int e = j / 3, k = j % 3;
    if (k == 0) { J.src = P.moe_wg + (size_t)e * D * DFF; J.K = D; J.ld = DFF; J.nc = DFF; J.dst = WSP(bf16_t, WS_WMGU) + (size_t)e * 2 * DFF * D; J.r0 = 0; J.mode = 1; }
    else if (k == 1) { J.src = P.moe_wu + (size_t)e * D * DFF; J.K = D; J.ld = DFF; J.nc = DFF; J.dst = WSP(bf16_t, WS_WMGU) + (size_t)e * 2 * DFF * D; J.r0 = 128; J.mode = 1; }
    else { J.src = P.moe_wd + (size_t)e * DFF * D; J.K = DFF; J.ld = D; J.nc = D; J.dst = WSP(bf16_t, WS_WMDN) + (size_t)e * D * DFF; }
    return J;
}
DEV int job_items(const Job& J) { return (J.K / 64) * (J.nc / 32); }
DEV void transpose_item(const Job& J, int item, float* scr, int lane) {
    const int nblk = J.nc / 32, kb = item / nblk, nb = item % nblk, k0 = 64 * kb, n0 = 32 * nb;
    {
        const float* sp = J.src + (size_t)(k0 + (lane >> 3)) * J.ld + J.c0 + n0 + 4 * (lane & 7);
        f32x4 v[8];
#pragma unroll
        for (int i = 0; i < 8; ++i) v[i] = *(const f32x4*)(sp + (size_t)(8 * i) * J.ld);
#pragma unroll
        for (int i = 0; i < 8; ++i) { float* d = scr + (8 * i + (lane >> 3)) * 33 + 4 * (lane & 7); d[0] = v[i][0]; d[1] = v[i][1]; d[2] = v[i][2]; d[3] = v[i][3]; }
    }
    WAVE_LDS_SYNC();
    const int c = lane & 7;
#pragma unroll
    for (int jj = 0; jj < 4; ++jj) { const int n = (lane >> 3) + 8 * jj; const float* s = scr + (8 * c) * 33 + n; const int nn = n0 + n;
        u32x4 o; o.x = pk2(s[0 * 33], s[1 * 33]); o.y = pk2(s[2 * 33], s[3 * 33]); o.z = pk2(s[4 * 33], s[5 * 33]); o.w = pk2(s[6 * 33], s[7 * 33]);
        const int row = J.mode ? J.r0 + 256 * (nn / 128) + (nn % 128) : J.r0 + nn;
        *(u32x4*)(J.dst + (size_t)row * J.K + k0 + 8 * c) = o; }
    WAVE_LDS_SYNC();
}
DEV void phase_weights(const Params& P, const Ctx& C) {
    float* scr = (float*)(C.lds + C.wave * 16384);
    int total = 0;
    for (int j = 0; j < NJOBS; ++j) total += job_items(get_job(P, j));
    for (int it = C.gw; it < total; it += C.ngw) {
        int r = it, j = 0; Job J = get_job(P, 0);
        for (;;) { const int n = job_items(J); if (r < n) break; r -= n; ++j; J = get_job(P, j); }
        transpose_item(J, r, scr, C.lane);
    }
    const int gt = C.bid * NTHREADS + C.tid, ngt = C.nblk * NTHREADS;
    for (int i = gt; i < DEPTH * 256 * (D / 8); i += ngt) {
        const int l = i / (256 * (D / 8)), r = (i / (D / 8)) % 256, k8 = (i % (D / 8)) * 8;
        float f[8];
#pragma unroll
        for (int q = 0; q < 8; ++q) f[q] = r < NG ? P.w_in[((size_t)l * D + k8 + q) * N_IN + OMG + r] : 0.f;
        *(u32x4*)(WSP(bf16_t, WS_WIN) + ((size_t)l * NP + NPB + r) * D + k8) = pack8(f);
    }
}
DEV const float* cvec_ptr(const Params& P, int v) { return v < NB ? P.c + (size_t)v * D : P.c_ctx; }
DEV void phase_mod_partial(const Params& P, const Ctx& C) {
    constexpr int NCG = 6 * D / 256, NKS = D / 64;
    for (int it = C.gw; it < DEPTH * NKS * NCG; it += C.ngw) {
        const int cg = it % NCG, ks = (it / NCG) % NKS, l = it / (NCG * NKS), col = cg * 256 + C.lane * 4;
        f32x4 acc[NV];
#pragma unroll
        for (int v = 0; v < NV; ++v) acc[v] = (f32x4){0.f, 0.f, 0.f, 0.f};
#pragma unroll 16
        for (int k = ks * 64; k < ks * 64 + 64; ++k) {
            const f32x4 w = *(const f32x4*)(P.w_mod + ((size_t)l * D + k) * 6 * D + col);
#pragma unroll
            for (int v = 0; v < NV; ++v) { const float s = siluf_(cvec_ptr(P, v)[k]); acc[v] += w * s; }
        }
#pragma unroll
        for (int v = 0; v < NV; ++v) *(f32x4*)(WSP(float, WS_MODP) + (((size_t)ks * DEPTH + l) * NV + v) * 6 * D + col) = acc[v];
    }
}
DEV void phase_mod_final(const Params& P, const Ctx& C) {
    constexpr int NKS = D / 64;
    const int gt = C.bid * NTHREADS + C.tid, ngt = C.nblk * NTHREADS;
    for (int i = gt; i < DEPTH * NV * 6 * D; i += ngt) {
        const int col = i % (6 * D), v = (i / (6 * D)) % NV, l = i / (6 * D * NV);
        float s = P.b_mod[(size_t)l * 6 * D + col];
        for (int ks = 0; ks < NKS; ++ks) s += WSP(float, WS_MODP)[(((size_t)ks * DEPTH + l) * NV + v) * 6 * D + col];
        WSP(float, WS_MOD)[((size_t)l * NV + v) * 6 * D + col] = s;
    }
    for (int i = gt; i < HG_W; i += ngt) {
        float mx = -1e30f; for (int l = 0; l < DEPTH; ++l) mx = fmaxf(mx, P.lb_logits[(size_t)l * HG_W + i]);
        float den = 0.f; for (int l = 0; l < DEPTH; ++l) den += expf(P.lb_logits[(size_t)l * HG_W + i] - mx);
        float cum = 0.f;
        for (int l = 0; l < DEPTH; ++l) { if (l > 0) cum += expf(P.lb_logits[(size_t)l * HG_W + i] - mx) / den; WSP(float, WS_LB)[(size_t)l * HG_W + i] = cum; }
    }
}
DEV const float* mod_vec(const Params& P, int l, int v, int idx) { return WSP(float, WS_MOD) + ((size_t)l * NV + v) * 6 * D + (size_t)idx * D; }

DEV void phase_hpass(const Params& P, const Ctx& C, int l, int which, bool router) {
    constexpr int NJ = D / 256;
    const int nrows = (which == 1 && l == DEPTH - 1) ? MLAT : MT;
    const float* g = (which ? P.norm2_g : P.norm1_g) + (size_t)l * D;
    for (int row = C.gw; row < nrows; row += C.ngw) {
        const float* src;
        if (which) src = WSP(float, WS_X1) + (size_t)row * D;
        else if (l == 0) src = row < MLAT ? P.x + (size_t)row * D : P.ctx + (size_t)(row - MLAT) * D;
        else src = WSP(float, WS_X2) + (size_t)row * D;
        const int v = row_vec(row);
        const float* sh = mod_vec(P, l, v, which ? 3 : 0); const float* sc = mod_vec(P, l, v, which ? 4 : 1);
        f32x4 x[NJ]; float ss = 0.f;
#pragma unroll
        for (int j = 0; j < NJ; ++j) { x[j] = *(const f32x4*)(src + 256 * j + 4 * C.lane); ss += (x[j].x * x[j].x + x[j].y * x[j].y) + (x[j].z * x[j].z + x[j].w * x[j].w); }
        const float rstd = 1.0f / sqrtf(wave_sum(ss) * (1.0f / D) + EPS);
        float lg[NE];
#pragma unroll
        for (int e = 0; e < NE; ++e) lg[e] = 0.f;
#pragma unroll
        for (int j = 0; j < NJ; ++j) {
            const int col = 256 * j + 4 * C.lane;
            const f32x4 gg = *(const f32x4*)(g + col), s1 = *(const f32x4*)(sc + col), s0 = *(const f32x4*)(sh + col);
            f32x4 y = x[j] * rstd * gg * (s1 + 1.0f) + s0;
            u32x2 o; o.x = pk2(y.x, y.y); o.y = pk2(y.z, y.w);
            *(u32x2*)(WSP(bf16_t, WS_H) + (size_t)row * D + col) = o;
            if (router) {
                const float* wr = P.moe_wr + (size_t)(l / 2) * D * NE + (size_t)col * NE;
#pragma unroll
                for (int q = 0; q < 4; ++q)
#pragma unroll
                    for (int e = 0; e < NE; ++e) lg[e] += y[q] * wr[q * NE + e];
            }
        }
        if (router) {
#pragma unroll
            for (int e = 0; e < NE; ++e) lg[e] = wave_sum(lg[e]);
            if (C.lane == 0) {
                int i0 = 0; float v0 = lg[0];
#pragma unroll
                for (int e = 1; e < NE; ++e) if (lg[e] > v0) { v0 = lg[e]; i0 = e; }
                int i1 = -1; float v1 = -3.0e38f;
#pragma unroll
                for (int e = 0; e < NE; ++e) if (e != i0 && lg[e] > v1) { v1 = lg[e]; i1 = e; }
                const float w1 = 1.0f / (1.0f + expf(v0 - v1)), w0 = 1.0f - w1;
                int* te = WSP(int, WS_SMALL + SM_TE) + row * 2; float* tw = WSP(float, WS_SMALL + SM_TW) + row * 2; int* tp = WSP(int, WS_SMALL + SM_TP) + row * 2;
                unsigned* cnt = WSP(unsigned, WS_CTL) + CW_CNT;
                te[0] = i0; te[1] = i1; tw[0] = w0; tw[1] = w1;
                tp[0] = (int)atomicAdd(cnt + i0, 1u); tp[1] = (int)atomicAdd(cnt + i1, 1u);
            }
        }
    }
    if (router) {
        const int gt = C.bid * NTHREADS + C.tid, ngt = C.nblk * NTHREADS;
        for (int i = gt; i < MOE_ROWS; i += ngt) WSP(int, WS_SMALL + SM_RTOK)[i] = -1;
    }
}

DEV void phase_fixup(const Params& P, const Ctx& C, int l, bool need_ctx) {
    const bf16_t* Pb = WSP(bf16_t, WS_P);
    const float* qg = P.qn_g + (size_t)l * HD; const float* kg = P.kn_g + (size_t)l * HD;
    const float* cw = P.conv_w + (size_t)l * 3 * 2 * ML_W;
    const int lane = C.lane, jf = lane & 31;
    const float invf = expf(-logf(10000.0f) * (float)(2 * jf) / 64.0f);
    for (int row = C.gw; row < MT; row += C.ngw) {
        const bool lat = row < MLAT;
        const int b = lat ? row / TL : (row - MLAT) / TC, t = lat ? row % TL : (row - MLAT) % TC, tseg = lat ? TL : TC;
        const bf16_t* pr = Pb + (size_t)row * NPB;
        float c0 = 1.f, s0 = 0.f, c1 = 1.f, s1 = 0.f;
        if (lat) { const float a0 = (float)(t / GRIDW) * invf, a1 = (float)(t % GRIDW) * invf; c0 = cosf(a0); s0 = sinf(a0); c1 = cosf(a1); s1 = sinf(a1); }
        const int pos = lat ? TC + t : t;
        for (int hh = 0; hh < AH + AKV; ++hh) {
            const bool isq = hh < AH;
            if (isq && !lat && !need_ctx) continue;
            const int col = isq ? PQ + hh * HD : PK + (hh - AH) * HD;
            float e0 = bf2f(pr[col + lane]), e1 = bf2f(pr[col + 64 + lane]);
            const float r = 1.0f / sqrtf(wave_sum(e0 * e0 + e1 * e1) * (1.0f / HD) + EPS);
            const float* gg = isq ? qg : kg;
            e0 *= r * gg[lane]; e1 *= r * gg[64 + lane];
            if (lat) {
                const float p0 = __shfl_xor(e0, 32), p1 = __shfl_xor(e1, 32);
                e0 = lane < 32 ? e0 * c0 - p0 * s0 : e0 * c0 + p0 * s0;
                e1 = lane < 32 ? e1 * c1 - p1 * s1 : e1 * c1 + p1 * s1;
            }
            bf16_t* dst = isq ? WSP(bf16_t, WS_QA) + (size_t)row * ATT_W + hh * HD : WSP(bf16_t, WS_KCAT) + ((size_t)b * TT + pos) * KV_W + (hh - AH) * HD;
            dst[lane] = (bf16_t)f2bf(e0); dst[64 + lane] = (bf16_t)f2bf(e1);
        }
        for (int cidx = lane * 4; cidx < KV_W; cidx += 256) *(u32x2*)(WSP(bf16_t, WS_VCAT) + ((size_t)b * TT + pos) * KV_W + cidx) = *(const u32x2*)(pr + PV + cidx);
        for (int cidx = lane * 8; cidx < 2 * ML_W; cidx += 512) {
            const bool isk = cidx >= ML_W; const int pc = isk ? PMK + (cidx - ML_W) : PMQ + cidx;
            float xm[8], x0[8], xp[8], o[8];
            unpack8(*(const u32x4*)(pr + pc), x0);
            if (t > 0) unpack8(*(const u32x4*)(pr - NPB + pc), xm); else { for (int q = 0; q < 8; ++q) xm[q] = 0.f; }
            if (t + 1 < tseg) unpack8(*(const u32x4*)(pr + NPB + pc), xp); else { for (int q = 0; q < 8; ++q) xp[q] = 0.f; }
            const float sc = isk ? 0.0625f : 1.0f;
#pragma unroll
            for (int q = 0; q < 8; ++q) o[q] = (xm[q] * cw[cidx + q] + x0[q] * cw[2 * ML_W + cidx + q] + xp[q] * cw[4 * ML_W + cidx + q]) * sc;
            bf16_t* dst = (isk ? WSP(bf16_t, WS_KM) + (size_t)row * ML_W + (cidx - ML_W) : WSP(bf16_t, WS_QM) + (size_t)row * ML_W + cidx);
            *(u32x4*)dst = pack8(o);
        }
    }
}

constexpr int MQP = MDK + 8, CP = CH + 8;
DEV const bf16_t* cptr(const bf16_t* p) { return p; }
DEV void mlstm_s1_unit(const Params& P, const Ctx& C0, int l, int u) {
    const Ctx C = make_ctx(C0.lds);
    const int c = u % NCH, sq = u / NCH, d = sq & 1, h = (sq >> 1) % MLH, b = sq / (2 * MLH);
    bf16_t* Ks = (bf16_t*)C.lds;
    bf16_t* Vs = Ks + CH * MQP;
    float* wsl = (float*)(Vs + CH * MQP);
    const float* G16 = WSP(float, WS_G16); const float* gb = P.gate_b + (size_t)l * NG;
    const int lane = C.lane, w = C.wave, r32 = lane & 31, hi = lane >> 5;
    const int rowL = seq_row(b, d, c * CH + lane);
    const float li = G16[(size_t)rowL * 16 + d * MLH + h] + gb[d * MLH + h];
    const float lf = logsigmoidf_(G16[(size_t)rowL * 16 + (2 + d) * MLH + h] + gb[(2 + d) * MLH + h]);
    const float fc = wave_scan_add(lf, lane), tot = __shfl(fc, 63);
    const float g = tot - fc + li, mx = wave_max(g), wsv = expf(g - mx);
    if (w == 0) { wsl[lane] = wsv; if (lane == 0) { WSP(float, WS_SMALL + SM_FL)[sq * NCH + c] = tot; WSP(float, WS_SMALL + SM_MLOC)[sq * NCH + c] = mx; } }
#pragma unroll
    for (int it = 0; it < CH * (MDK / 8) / NTHREADS; ++it) {
        const int i = C.tid + NTHREADS * it, s = i / (MDK / 8), cg = i % (MDK / 8), row = seq_row(b, d, c * CH + s);
        const float wv = __shfl(wsv, s);
        *(u32x4*)(Ks + s * MQP + cg * 8) = *(const u32x4*)(WSP(bf16_t, WS_KM) + (size_t)row * ML_W + h * MDK + cg * 8);
        float vv[8]; unpack8(*(const u32x4*)(WSP(bf16_t, WS_P) + (size_t)row * NPB + PMV + h * MDV + cg * 8), vv);
#pragma unroll
        for (int q = 0; q < 8; ++q) vv[q] *= wv;
        *(u32x4*)(Vs + s * MQP + cg * 8) = pack8(vv);
    }
    __syncthreads();
    if (C.tid < MDK) { float s = 0.f; for (int j = 0; j < CH; ++j) s += wsl[j] * bf2f(Ks[j * MQP + C.tid]); WSP(float, WS_SMALL + SM_NLOC)[((size_t)sq * NCH + c) * MDK + C.tid] = s; }
    f32x16 acc[8];
#pragma unroll
    for (int mb = 0; mb < 8; ++mb) acc[mb] = (f32x16){0};
#pragma unroll
    for (int ks = 0; ks < CH / 16; ++ks) {
        s16x4 bl, bh; tr_issue(bl, bh, cptr(Vs), MQP, 16 * ks, 32 * w, lane);
#pragma unroll
        for (int g4 = 0; g4 < 2; ++g4) {
            s16x4 al[4], ah[4];
#pragma unroll
            for (int q = 0; q < 4; ++q) tr_issue(al[q], ah[q], cptr(Ks), MQP, 16 * ks, 32 * (4 * g4 + q), lane);
            TR_WAIT8(al[0], ah[0], al[1], ah[1], al[2], ah[2], al[3], ah[3]); TR_WAIT2(bl, bh);
#pragma unroll
            for (int q = 0; q < 4; ++q) acc[4 * g4 + q] = MFMA32(TR_PK(al[q], ah[q]), TR_PK(bl, bh), acc[4 * g4 + q]);
        }
    }
    bf16_t* out = WSP(bf16_t, WS_CSTM) + ((size_t)sq * NCH + c) * MDV * MDK + (size_t)(32 * w + r32) * MDK + 4 * hi;
#pragma unroll
    for (int mb = 0; mb < 8; ++mb)
#pragma unroll
        for (int g4 = 0; g4 < 4; ++g4) { u32x2 o; o.x = pk2(acc[mb][4 * g4], acc[mb][4 * g4 + 1]); o.y = pk2(acc[mb][4 * g4 + 2], acc[mb][4 * g4 + 3]); *(u32x2*)(out + 32 * mb + 8 * g4) = o; }
    __syncthreads();
}
DEV void mlstm_s2(const Params& P, const Ctx& C) {
    const int gt = C.bid * NTHREADS + C.tid, ngt = C.nblk * NTHREADS;
    constexpr int NG8 = MDV * MDK / 8;
    static_assert(NCH % 4 == 0, "chunk pipeline depth");
    const float* FL = WSP(float, WS_SMALL + SM_FL); const float* MLOC = WSP(float, WS_SMALL + SM_MLOC);
    for (int i = gt; i < NSQM * NG8; i += ngt) {
        const int sq = i / NG8, g8 = i % NG8; float run[8];
#pragma unroll
        for (int q = 0; q < 8; ++q) run[q] = 0.f;
        float m_run = -1e30f;
        u32x4* p = (u32x4*)(WSP(bf16_t, WS_CSTM) + (size_t)sq * NCH * MDV * MDK + (size_t)g8 * 8);
        u32x4 buf[4];
#pragma unroll
        for (int q = 0; q < 4; ++q) buf[q] = p[(size_t)q * NG8];
        for (int c0 = 0; c0 < NCH; c0 += 4) {
#pragma unroll
            for (int q = 0; q < 4; ++q) { const int c = c0 + q;
                float kl[8]; unpack8(buf[q], kl);
                if (c + 4 < NCH) buf[q] = p[(size_t)(c + 4) * NG8];
                p[(size_t)c * NG8] = pack8(run);
                const float fl = FL[sq * NCH + c], ml = MLOC[sq * NCH + c], mn = fmaxf(fl + m_run, ml), dec = fexp(fl + m_run - mn), sl = fexp(ml - mn);
#pragma unroll
                for (int e = 0; e < 8; ++e) run[e] = dec * run[e] + sl * kl[e];
                m_run = mn; }
        }
    }
    for (int i = gt; i < NSQM * MDK; i += ngt) {
        const int sq = i / MDK, dk = i % MDK; float run = 0.f, m_run = -1e30f;
        float* p = WSP(float, WS_SMALL + SM_NLOC) + (size_t)sq * NCH * MDK + dk;
        for (int c = 0; c < NCH; ++c) {
            const float nl = p[(size_t)c * MDK]; p[(size_t)c * MDK] = run;
            const float fl = FL[sq * NCH + c], ml = MLOC[sq * NCH + c], mn = fmaxf(fl + m_run, ml), dec = fexp(fl + m_run - mn), sl = fexp(ml - mn);
            run = dec * run + sl * nl;
            if (dk == 0) WSP(float, WS_SMALL + SM_MST)[sq * NCH + c] = m_run;
            m_run = mn;
        }
    }
}
DEV void mlstm_s3_unit(const Params& P, const Ctx& C0, int l, int u) {
    const Ctx C = make_ctx(C0.lds);
    const int cc = u % NCH, h = (u / NCH) % MLH, b = u / (NCH * MLH);
    const int row0 = chunk_row0(b, cc);
    bf16_t* Qs = (bf16_t*)C.lds;
    bf16_t* Ks = Qs + CH * MQP;
    bf16_t* Vs = Ks + CH * MQP;
    bf16_t* SC = Vs + CH * MQP;
    float* vec = (float*)(SC + 2 * CH * CP);
    float* liv = vec;
    float* fcv = vec + 128;
    float* mtv = vec + 256;
    float* av = vec + 384;
    float* qnv = vec + 512;
    float* rinv = vec + 640;
    float* HS = (float*)C.lds;
    const float* G16 = WSP(float, WS_G16); const float* gb = P.gate_b + (size_t)l * NG;
    const int sq0 = (b * MLH + h) * 2, c0 = dir_chunk(cc, 0), c1 = dir_chunk(cc, 1);
    const int lane = C.lane, r32 = lane & 31, hi = lane >> 5, w = C.wave;
#pragma unroll
    for (int it = 0; it < CH * (MDK / 8) / NTHREADS; ++it) {
        const int i = C.tid + NTHREADS * it, s = i / (MDK / 8), cg = i % (MDK / 8), row = row0 + s;
        *(u32x4*)(Qs + s * MQP + cg * 8) = *(const u32x4*)(WSP(bf16_t, WS_QM) + (size_t)row * ML_W + h * MDK + cg * 8);
        *(u32x4*)(Ks + s * MQP + cg * 8) = *(const u32x4*)(WSP(bf16_t, WS_KM) + (size_t)row * ML_W + h * MDK + cg * 8);
        *(u32x4*)(Vs + s * MQP + cg * 8) = *(const u32x4*)(WSP(bf16_t, WS_P) + (size_t)row * NPB + PMV + h * MDV + cg * 8);
    }
    if (w == 4 || w == 5) {
        const int d = w - 4, j = d ? CH - 1 - lane : lane, row = row0 + j;
        const float li = G16[(size_t)row * 16 + d * MLH + h] + gb[d * MLH + h];
        const float lf = logsigmoidf_(G16[(size_t)row * 16 + (2 + d) * MLH + h] + gb[(2 + d) * MLH + h]);
        const float ms = WSP(float, WS_SMALL + SM_MST)[(sq0 + d) * NCH + (d ? c1 : c0)];
        const float fc = wave_scan_add(lf, lane), pm = wave_scan_max(li - fc, lane), mt = fc + fmaxf(ms, pm);
        liv[d * 64 + j] = li; fcv[d * 64 + j] = fc; mtv[d * 64 + j] = mt; av[d * 64 + j] = expf(fc + ms - mt);
    }
    __syncthreads();
    f32x16 sacc = (f32x16){0};
    if (w < 4) {
        const int tb = w >> 1, sb = w & 1;
#pragma unroll
        for (int ks = 0; ks < MDK / 16; ++ks) {
            const bf16x8 a = *(const bf16x8*)(Qs + (32 * tb + r32) * MQP + 16 * ks + 8 * hi);
            const bf16x8 bb = *(const bf16x8*)(Ks + (32 * sb + r32) * MQP + 16 * ks + 8 * hi);
            sacc = MFMA32(a, bb, sacc);
        }
    }
    {
        const int t = C.tid >> 3, part = C.tid & 7;
        const float* n0 = WSP(float, WS_SMALL + SM_NLOC) + ((size_t)(sq0 + 0) * NCH + c0) * MDK + part * 32;
        const float* n1 = WSP(float, WS_SMALL + SM_NLOC) + ((size_t)(sq0 + 1) * NCH + c1) * MDK + part * 32;
        float s0 = 0.f, s1 = 0.f;
#pragma unroll
        for (int q4 = 0; q4 < 4; ++q4) { float qq[8]; unpack8(*(const u32x4*)(Qs + t * MQP + part * 32 + q4 * 8), qq);
            const f32x4 a0 = *(const f32x4*)(n0 + q4 * 8), a1 = *(const f32x4*)(n0 + q4 * 8 + 4), b0 = *(const f32x4*)(n1 + q4 * 8), b1 = *(const f32x4*)(n1 + q4 * 8 + 4);
#pragma unroll
            for (int e = 0; e < 4; ++e) { s0 += qq[e] * a0[e] + qq[4 + e] * a1[e]; s1 += qq[e] * b0[e] + qq[4 + e] * b1[e]; } }
#pragma unroll
        for (int o = 1; o < 8; o <<= 1) { s0 += __shfl_xor(s0, o); s1 += __shfl_xor(s1, o); }
        if (part == 0) { qnv[t] = s0; qnv[64 + t] = s1; }
    }
    if (w < 4) {
        const int tb = w >> 1, sb = w & 1, s = 32 * sb + r32;
#pragma unroll
        for (int d = 0; d < 2; ++d) { const float fs = fcv[d * 64 + s], ls = liv[d * 64 + s];
#pragma unroll
            for (int r = 0; r < 16; ++r) { const int t = 32 * tb + crow(r, hi); const bool ok = d ? (s >= t) : (s <= t);
                const float wgt = ok ? fexp(fcv[d * 64 + t] - fs + ls - mtv[d * 64 + t]) : 0.f;
                SC[(d * CH + t) * CP + s] = (bf16_t)f2bf(ok ? sacc[r] * wgt : 0.f);
                if ((r & 3) == 3) asm volatile("" ::: "memory"); } }
    }
    __syncthreads();
    if (C.tid < 2 * CH) { const int d = C.tid >> 6, t = C.tid & 63; float s = 0.f;
#pragma unroll
        for (int k8 = 0; k8 < CH / 8; ++k8) { float x[8]; unpack8(*(const u32x4*)(SC + (d * CH + t) * CP + k8 * 8), x);
#pragma unroll
            for (int e = 0; e < 8; ++e) s += x[e]; }
        const float den = s + av[C.tid] * qnv[C.tid]; rinv[C.tid] = 1.0f / fmaxf(fabsf(den), expf(-mtv[C.tid])); }
    __syncthreads();
    f32x16 hs[2]; hs[0] = (f32x16){0}; hs[1] = (f32x16){0};
#pragma unroll 1
    for (int d = 0; d < 2; ++d) {
        { f32x16 a1[2]; a1[0] = (f32x16){0}; a1[1] = (f32x16){0};
#pragma unroll
        for (int ks = 0; ks < CH / 16; ++ks) {
            s16x4 bl, bh; tr_issue(bl, bh, cptr(Vs), MQP, 16 * ks, 32 * w, lane);
            const bf16x8 x0 = *(const bf16x8*)(SC + (d * CH + r32) * CP + 16 * ks + 8 * hi), x1 = *(const bf16x8*)(SC + (d * CH + 32 + r32) * CP + 16 * ks + 8 * hi);
            TR_WAIT2(bl, bh);
            a1[0] = MFMA32(x0, TR_PK(bl, bh), a1[0]); a1[1] = MFMA32(x1, TR_PK(bl, bh), a1[1]);
        }
#pragma unroll
        for (int r = 0; r < 16; ++r) { const int t = crow(r, hi); hs[0][r] += a1[0][r] * rinv[d * 64 + t]; hs[1][r] += a1[1][r] * rinv[d * 64 + 32 + t]; } }
        f32x16 a2[2]; a2[0] = (f32x16){0}; a2[1] = (f32x16){0};
        const bf16_t* cst = WSP(bf16_t, WS_CSTM) + ((size_t)(sq0 + d) * NCH + (d ? c1 : c0)) * MDV * MDK + (size_t)(32 * w + r32) * MDK + 8 * hi;
#pragma unroll 4
        for (int ks = 0; ks < MDK / 16; ++ks) {
            const bf16x8 bb = *(const bf16x8*)(cst + 16 * ks);
            const bf16x8 x0 = *(const bf16x8*)(Qs + r32 * MQP + 16 * ks + 8 * hi), x1 = *(const bf16x8*)(Qs + (32 + r32) * MQP + 16 * ks + 8 * hi);
            a2[0] = MFMA32(x0, bb, a2[0]); a2[1] = MFMA32(x1, bb, a2[1]);
        }
#pragma unroll
        for (int r = 0; r < 16; ++r) { const int t = crow(r, hi);
            hs[0][r] += av[d * 64 + t] * a2[0][r] * rinv[d * 64 + t];
            hs[1][r] += av[d * 64 + 32 + t] * a2[1][r] * rinv[d * 64 + 32 + t]; }
    }
    __syncthreads();
#pragma unroll
    for (int tb = 0; tb < 2; ++tb)
#pragma unroll
        for (int r = 0; r < 16; ++r) HS[(32 * tb + crow(r, hi)) * 257 + 32 * w + r32] = hs[tb][r];
    __syncthreads();
    const float* ng = P.ml_norm_g + (size_t)l * ML_W + h * MDV;
    for (int t = w; t < CH; t += NWAVES) {
        float v[4], ss = 0.f;
#pragma unroll
        for (int q = 0; q < 4; ++q) { v[q] = HS[t * 257 + C.lane * 4 + q]; ss += v[q] * v[q]; }
        const float rstd = 1.0f / sqrtf(wave_sum(ss) * (1.0f / MDV) + EPS);
        const int row = row0 + t; const u32x2 ov = *(const u32x2*)(WSP(bf16_t, WS_P) + (size_t)row * NPB + PMO + h * MDV + C.lane * 4);
        const float o0 = bitsf(ov.x << 16), o1 = bitsf(ov.x & 0xffff0000u), o2 = bitsf(ov.y << 16), o3 = bitsf(ov.y & 0xffff0000u);
        u32x2 y; y.x = pk2(v[0] * rstd * ng[C.lane * 4 + 0] * sigmoidf_(o0), v[1] * rstd * ng[C.lane * 4 + 1] * sigmoidf_(o1));
        y.y = pk2(v[2] * rstd * ng[C.lane * 4 + 2] * sigmoidf_(o2), v[3] * rstd * ng[C.lane * 4 + 3] * sigmoidf_(o3));
        *(u32x2*)(WSP(bf16_t, WS_Y) + ((size_t)1 * MT + row) * BW + h * MDV + C.lane * 4) = y;
    }
    __syncthreads();
}

constexpr int HQP = HDK + 8;
DEV float hg_f(float z, float lb) { return lb + (1.0f - lb) * sigmoidf_(z); }
DEV void hgrn_s1_unit(const Params& P, const Ctx& C0, int l, int u) {
    const Ctx C = make_ctx(C0.lds);
    const int cc = u % NCH, h = (u / NCH) % HGH, b = u / (NCH * HGH), row0 = chunk_row0(b, cc);
    float* LF = (float*)C.lds;
    bf16_t* KP = (bf16_t*)(C.lds + 2 * CH * HDK * 4);
    bf16_t* Vs = KP + 2 * CH * HQP;
    const bf16_t* Pb = WSP(bf16_t, WS_P); const float* LB = WSP(float, WS_LB) + (size_t)l * HG_W + h * HDK;
    const int sq0 = (b * HGH + h) * 2;
    const int lane = C.lane, r32 = lane & 31, hi = lane >> 5, w = C.wave;
#pragma unroll
    for (int it = 0; it < 2 * CH * (HDK / 8) / NTHREADS; ++it) {
        const int i = C.tid + NTHREADS * it, dk8 = i % (HDK / 8), j = (i / (HDK / 8)) % CH, d = i / (CH * (HDK / 8));
        float z[8]; unpack8(*(const u32x4*)(Pb + (size_t)(row0 + j) * NPB + (d ? PHB : PHF) + h * HDK + dk8 * 8), z);
        const f32x4 l0 = *(const f32x4*)(LB + dk8 * 8), l1 = *(const f32x4*)(LB + dk8 * 8 + 4);
        f32x4 o0, o1;
#pragma unroll
        for (int e = 0; e < 4; ++e) { o0[e] = logf(hg_f(z[e], l0[e])); o1[e] = logf(hg_f(z[4 + e], l1[e])); }
        *(f32x4*)(LF + (d * CH + j) * HDK + dk8 * 8) = o0; *(f32x4*)(LF + (d * CH + j) * HDK + dk8 * 8 + 4) = o1;
    }
#pragma unroll
    for (int it = 0; it < CH * (HDV / 8) / NTHREADS; ++it) {
        const int i = C.tid + NTHREADS * it, s = i / (HDV / 8), cg = i % (HDV / 8);
        *(u32x4*)(Vs + s * HQP + cg * 8) = *(const u32x4*)(Pb + (size_t)(row0 + s) * NPB + PHI + h * HDV + cg * 8);
    }
    __syncthreads();
    if (C.tid < 2 * HDK) {
        const int d = C.tid >> 7, dk = C.tid & 127; float R = 0.f;
        for (int st = 0; st < CH; ++st) { const int j = d ? st : CH - 1 - st;
            const float x = LF[(d * CH + j) * HDK + dk];
            KP[(d * CH + j) * HQP + dk] = (bf16_t)f2bf((1.0f - fexp(x)) * fexp(R)); R += x; }
        WSP(float, WS_SMALL + SM_LAM)[((size_t)(sq0 + d) * NCH + dir_chunk(cc, d)) * HDK + dk] = expf(R);
    }
    __syncthreads();
    const int d = w >> 2, nb = w & 3;
    f32x16 acc[4];
#pragma unroll
    for (int mb = 0; mb < 4; ++mb) acc[mb] = (f32x16){0};
#pragma unroll
    for (int ks = 0; ks < CH / 16; ++ks) {
        s16x4 bl, bh, al[4], ah[4]; tr_issue(bl, bh, cptr(Vs), HQP, 16 * ks, 32 * nb, lane);
#pragma unroll
        for (int q = 0; q < 4; ++q) tr_issue(al[q], ah[q], cptr(KP + d * CH * HQP), HQP, 16 * ks, 32 * q, lane);
        TR_WAIT8(al[0], ah[0], al[1], ah[1], al[2], ah[2], al[3], ah[3]); TR_WAIT2(bl, bh);
#pragma unroll
        for (int q = 0; q < 4; ++q) acc[q] = MFMA32(TR_PK(al[q], ah[q]), TR_PK(bl, bh), acc[q]);
    }
    bf16_t* out = WSP(bf16_t, WS_CSTH) + ((size_t)(sq0 + d) * NCH + dir_chunk(cc, d)) * HDV * HDK + (size_t)(32 * nb + r32) * HDK + 4 * hi;
#pragma unroll
    for (int mb = 0; mb < 4; ++mb)
#pragma unroll
        for (int g4 = 0; g4 < 4; ++g4) { u32x2 o; o.x = pk2(acc[mb][4 * g4], acc[mb][4 * g4 + 1]); o.y = pk2(acc[mb][4 * g4 + 2], acc[mb][4 * g4 + 3]); *(u32x2*)(out + 32 * mb + 8 * g4) = o; }
    __syncthreads();
}
DEV void hgrn_s2(const Params& P, const Ctx& C) {
    const int gt = C.bid * NTHREADS + C.tid, ngt = C.nblk * NTHREADS;
    constexpr int NG8 = HDV * HDK / 8;
    for (int i = gt; i < NSQH * NG8; i += ngt) {
        const int sq = i / NG8, g8 = i % NG8, dk0 = (g8 * 8) % HDK; float run[8];
#pragma unroll
        for (int q = 0; q < 8; ++q) run[q] = 0.f;
        u32x4* p = (u32x4*)(WSP(bf16_t, WS_CSTH) + (size_t)sq * NCH * HDV * HDK + (size_t)g8 * 8);
        const float* lam = WSP(float, WS_SMALL + SM_LAM) + (size_t)sq * NCH * HDK + dk0;
        u32x4 buf[4];
#pragma unroll
        for (int q = 0; q < 4; ++q) buf[q] = p[(size_t)q * NG8];
        for (int c0 = 0; c0 < NCH; c0 += 4) {
#pragma unroll
            for (int q = 0; q < 4; ++q) { const int c = c0 + q;
                float kl[8]; unpack8(buf[q], kl);
                if (c + 4 < NCH) buf[q] = p[(size_t)(c + 4) * NG8];
                p[(size_t)c * NG8] = pack8(run);
                const f32x4 la = *(const f32x4*)(lam + (size_t)c * HDK), lb4 = *(const f32x4*)(lam + (size_t)c * HDK + 4);
#pragma unroll
                for (int e = 0; e < 4; ++e) { run[e] = la[e] * run[e] + kl[e]; run[4 + e] = lb4[e] * run[4 + e] + kl[4 + e]; } }
        }
    }
}
DEV void hgrn_s3_unit(const Params& P, const Ctx& C0, int l, int u) {
    const Ctx C = make_ctx(C0.lds);
    const int cc = u % NCH, h = (u / NCH) % HGH, b = u / (NCH * HGH), row0 = chunk_row0(b, cc);
    float* GL = (float*)C.lds;
    bf16_t* QH = (bf16_t*)(C.lds + CH * HDK * 4);
    bf16_t* KH = QH + CH * HQP;
    bf16_t* KTL = KH + CH * HQP;
    bf16_t* QP = KTL + 32 * HQP;
    bf16_t* Vs = QP + CH * HQP;
    bf16_t* AT = Vs + CH * HQP;
    float* HS = GL;
    const bf16_t* Pb = WSP(bf16_t, WS_P); const float* LB = WSP(float, WS_LB) + (size_t)l * HG_W + h * HDK;
    const int sq0 = (b * HGH + h) * 2;
    const int lane = C.lane, r32 = lane & 31, hi = lane >> 5, w = C.wave, tbo = w >> 2, eb = w & 3;
#pragma unroll
    for (int it = 0; it < CH * (HDV / 8) / NTHREADS; ++it) {
        const int i = C.tid + NTHREADS * it, s = i / (HDV / 8), cg = i % (HDV / 8);
        *(u32x4*)(Vs + s * HQP + cg * 8) = *(const u32x4*)(Pb + (size_t)(row0 + s) * NPB + PHI + h * HDV + cg * 8);
    }
    f32x16 oacc = (f32x16){0};
#pragma unroll 1
    for (int d = 0; d < 2; ++d) {
        const int zc = (d ? PHB : PHF) + h * HDK;
#pragma unroll
        for (int it = 0; it < CH * (HDK / 8) / NTHREADS; ++it) {
            const int i = C.tid + NTHREADS * it, dk8 = i % (HDK / 8), j = i / (HDK / 8);
            float z[8]; unpack8(*(const u32x4*)(Pb + (size_t)(row0 + j) * NPB + zc + dk8 * 8), z);
            const f32x4 l0 = *(const f32x4*)(LB + dk8 * 8), l1 = *(const f32x4*)(LB + dk8 * 8 + 4);
            f32x4 o0, o1;
#pragma unroll
            for (int e = 0; e < 4; ++e) { o0[e] = logf(hg_f(z[e], l0[e])); o1[e] = logf(hg_f(z[4 + e], l1[e])); }
            *(f32x4*)(GL + j * HDK + dk8 * 8) = o0; *(f32x4*)(GL + j * HDK + dk8 * 8 + 4) = o1;
        }
        __syncthreads();
        if (C.tid < HDK) { float G = 0.f; for (int st = 0; st < CH; ++st) { const int j = d ? CH - 1 - st : st; G += GL[j * HDK + C.tid]; GL[j * HDK + C.tid] = G; } }
        __syncthreads();
#pragma unroll
        for (int it = 0; it < CH * (HDK / 8) / NTHREADS; ++it) {
            const int i = C.tid + NTHREADS * it, dk8 = i % (HDK / 8), j = i / (HDK / 8), blk = j >> 5, jp = d ? j + 1 : j - 1;
            float qq[8]; unpack8(*(const u32x4*)(Pb + (size_t)(row0 + j) * NPB + PHQ + h * HDK + dk8 * 8), qq);
            const bool first = d ? (j == CH - 1) : (j == 0), ref0 = d ? (blk == 1) : (blk == 0);
            float qh[8], kh[8], qp[8], kt[8];
#pragma unroll
            for (int e = 0; e < 8; ++e) { const int dk = dk8 * 8 + e;
                const float G = GL[j * HDK + dk], Gp = first ? 0.f : GL[jp * HDK + dk], Gmid = GL[(d ? 32 : 31) * HDK + dk], Gref = ref0 ? 0.f : Gmid;
                const float q = siluf_(qq[e]), kk = 1.0f - fexp(G - Gp);
                qh[e] = q * fexp(G - Gref); kh[e] = kk * fexp(Gref - G); qp[e] = q * fexp(G); kt[e] = kk * fexp(Gmid - G); }
            *(u32x4*)(QH + j * HQP + dk8 * 8) = pack8(qh); *(u32x4*)(KH + j * HQP + dk8 * 8) = pack8(kh); *(u32x4*)(QP + j * HQP + dk8 * 8) = pack8(qp);
            if (ref0) *(u32x4*)(KTL + (j & 31) * HQP + dk8 * 8) = pack8(kt);
        }
        __syncthreads();
        if (w < 4) {
            const int tb = w >> 1, sb = w & 1; const bool diag = tb == sb, off = d ? (tb == 0 && sb == 1) : (tb == 1 && sb == 0);
            f32x16 sa = (f32x16){0};
            if (diag || off) {
                const bf16_t* kb = diag ? KH + (32 * sb) * HQP : KTL;
#pragma unroll
                for (int ks = 0; ks < HDK / 16; ++ks) {
                    const bf16x8 a = *(const bf16x8*)(QH + (32 * tb + r32) * HQP + 16 * ks + 8 * hi);
                    const bf16x8 bb = *(const bf16x8*)(kb + r32 * HQP + 16 * ks + 8 * hi);
                    sa = MFMA32(a, bb, sa);
                }
            }
#pragma unroll
            for (int r = 0; r < 16; ++r) { const int t = 32 * tb + crow(r, hi), s = 32 * sb + r32; const bool ok = d ? (s >= t) : (s <= t);
                AT[t * CP + s] = (bf16_t)f2bf((ok && (diag || off)) ? sa[r] : 0.f); }
        }
        __syncthreads();
#pragma unroll
        for (int ks = 0; ks < CH / 16; ++ks) {
            s16x4 bl, bh; tr_issue(bl, bh, cptr(Vs), HQP, 16 * ks, 32 * eb, lane);
            const bf16x8 a = *(const bf16x8*)(AT + (32 * tbo + r32) * CP + 16 * ks + 8 * hi);
            TR_WAIT2(bl, bh);
            oacc = MFMA32(a, TR_PK(bl, bh), oacc);
        }
        const bf16_t* sst = WSP(bf16_t, WS_CSTH) + ((size_t)(sq0 + d) * NCH + dir_chunk(cc, d)) * HDV * HDK + (size_t)(32 * eb + r32) * HDK + 8 * hi;
#pragma unroll
        for (int ks = 0; ks < HDK / 16; ++ks) {
            const bf16x8 a = *(const bf16x8*)(QP + (32 * tbo + r32) * HQP + 16 * ks + 8 * hi);
            const bf16x8 bb = *(const bf16x8*)(sst + 16 * ks);
            oacc = MFMA32(a, bb, oacc);
        }
        __syncthreads();
    }
#pragma unroll
    for (int r = 0; r < 16; ++r) HS[(32 * tbo + crow(r, hi)) * HDV + 32 * eb + r32] = oacc[r];
    __syncthreads();
    const float* ng = P.hg_norm_g + (size_t)l * HG_W + h * HDV;
    for (int t = w; t < CH; t += NWAVES) {
        const float v0 = HS[t * HDV + C.lane * 2], v1 = HS[t * HDV + C.lane * 2 + 1];
        const float rstd = 1.0f / sqrtf(wave_sum(v0 * v0 + v1 * v1) * (1.0f / HDV) + EPS);
        const int row = row0 + t; const unsigned gv = *(const unsigned*)(Pb + (size_t)row * NPB + PHG + h * HDV + C.lane * 2);
        const float g0 = bitsf(gv << 16), g1 = bitsf(gv & 0xffff0000u);
        *(unsigned*)(WSP(bf16_t, WS_Y) + ((size_t)2 * MT + row) * BW + h * HDV + C.lane * 2) = pk2(v0 * rstd * ng[C.lane * 2] * siluf_(g0), v1 * rstd * ng[C.lane * 2 + 1] * siluf_(g1));
    }
    __syncthreads();
}
DEV void phase_s1(const Params& P, const Ctx& C, int l) {
    for (int u = C.bid; u < NSQM * NCH; u += C.nblk) mlstm_s1_unit(P, C, l, u);
    for (int u = C.bid; u < NB * HGH * NCH; u += C.nblk) hgrn_s1_unit(P, C, l, u);
}
DEV void phase_s2(const Params& P, const Ctx& C) { mlstm_s2(P, C); hgrn_s2(P, C); }
DEV void phase_s3(const Params& P, const Ctx& C, int l, bool need_ctx) {
    const int c_lo = need_ctx ? 0 : NCHC, ncu = NCH - c_lo;
    for (int u = C.bid; u < NB * MLH * ncu; u += C.nblk) mlstm_s3_unit(P, C, l, (u / ncu) * NCH + c_lo + (u % ncu));
    for (int u = C.bid; u < NB * HGH * ncu; u += C.nblk) hgrn_s3_unit(P, C, l, (u / ncu) * NCH + c_lo + (u % ncu));
}

namespace pg8 {
constexpr int BM = 256, BK = 64, HALF = 128, HTB = HALF * BK * 2, STAGE_BYTES = 8 * HTB, NXCD = 8, WGM = 8;
struct Unit { int pm, pn, po; };
struct Gemm { const bf16_t* A; const bf16_t* Bt; int K; };
DEV int lds_byte(int r, int c) { const int st = (r >> 4) * 2 + (c >> 5), rr = r & 15, cc = c & 31, ob = rr * 64 + cc * 2; return st * 1024 + (ob ^ (((ob >> 9) & 1) << 5)); }
DEV void stage_rc(int b, int& R, int& C) { const int st = b / 1024, sb = b % 1024, swz = sb ^ (((sb >> 9) & 1) << 5); R = (st >> 1) * 16 + swz / 64; C = (st & 1) * 32 + (swz % 64) / 2; }
DEV int perm32(int rho) { const int n = rho >> 4, i = rho & 15; return 8 * (i >> 2) + 4 * n + (i & 3); }
struct PanelOrder {
    int nM, nN, nwg, G, c; const int* pe;
    DEV void init(int nM_, int nN_, int G_, int c_, const int* pe_) { nM = nM_; nN = nN_; nwg = nM * nN; G = G_; c = c_; pe = pe_; }
    DEV bool next(int i, Unit& u) const {
        const long L = (long)i * G + c; if (L >= nwg) return false;
        int wgid = (int)L; { const int q = nwg / NXCD, r = nwg % NXCD, xcd = wgid % NXCD, off = wgid / NXCD; wgid = (xcd < r ? xcd * (q + 1) : r * (q + 1) + (xcd - r) * q) + off; }
        const int nig = WGM * nN, gid = wgid / nig, fm = gid * WGM, gsz = (nM - fm) < WGM ? (nM - fm) : WGM;
        u.pm = fm + ((wgid % nig) % gsz); u.po = (wgid % nig) / gsz; u.pn = pe ? pe[u.pm] * nN + u.po : u.po; return true;
    }
    DEV void a_ready(const Unit&) const {}
    DEV void done(const Unit&) const {}
};
#ifndef HOST_EMU
#define PG8_LAS __attribute__((address_space(3)))
template <class Epi, class Sched, bool ALIGN_EPI = false, bool SP2 = false>
__device__ __forceinline__ void gemm_phase(PG8_LAS unsigned char* lds, const Gemm g, const Sched& S, const Epi& E) {
    const int tid = opaque_tid(), wid = __builtin_amdgcn_readfirstlane(tid >> 6), lane = tid & 63, wr = wid >> 2, wc = wid & 3, fr = lane & 15, fq = lane >> 4;
    const int K = g.K, nt = K / BK;
    unsigned voffA[2], voffB[2];
#pragma unroll
    for (int i = 0; i < 2; ++i) { int R, C; stage_rc(tid * 16 + i * 8192, R, C); const int Rb = Epi::PERM ? ((R & ~31) + perm32(R & 31)) : R;
        voffA[i] = (unsigned)(R * K + C) * 2u; voffB[i] = (unsigned)(Rb * K + C) * 2u; }
    const size_t kstep = (size_t)(BK * 2);
    const size_t hstep = (size_t)HALF * K * 2;
    const size_t tstep = 2 * hstep;
    const unsigned ldsw = (unsigned)wid * 1024u;
    const int aoff = lds_byte(wr * 64 + fr, fq * 8), boff = lds_byte(wc * 32 + fr, fq * 8);
#define PG8_SA(b, h) (((b) * 2 + (h)) * HTB)
#define PG8_SB(b, h) ((4 + (b) * 2 + (h)) * HTB)
#define PG8_STAGE(bufoff, gbase, voff) do { _Pragma("unroll") for (int _i = 0; _i < 2; ++_i) \
        __builtin_amdgcn_global_load_lds((const unsigned*)((const char*)(gbase) + (voff)[_i]), (PG8_LAS unsigned*)(lds + (bufoff) + ldsw + _i * 8192), 16, 0, 0); } while (0)
#define PG8_LDA(dst, b, h) do { _Pragma("unroll") for (int m = 0; m < 4; ++m) _Pragma("unroll") for (int k = 0; k < 2; ++k) dst[m][k] = *(const PG8_LAS bf16x8*)(lds + PG8_SA(b, h) + aoff + m * 2048 + k * 1024); } while (0)
#define PG8_LDB(dst, b, h) do { _Pragma("unroll") for (int n = 0; n < 2; ++n) _Pragma("unroll") for (int k = 0; k < 2; ++k) dst[n][k] = *(const PG8_LAS bf16x8*)(lds + PG8_SB(b, h) + boff + n * 2048 + k * 1024); } while (0)
#define PG8_MMA(ai, bj, At, Bt) do { __builtin_amdgcn_s_setprio(1); _Pragma("unroll") for (int m = 0; m < 4; ++m) _Pragma("unroll") for (int n = 0; n < 2; ++n) _Pragma("unroll") for (int k = 0; k < 2; ++k) \
        acc[ai][bj][m][n] = __builtin_amdgcn_mfma_f32_16x16x32_bf16(Bt[n][k], At[m][k], acc[ai][bj][m][n], 0, 0, 0); __builtin_amdgcn_s_setprio(0); } while (0)
#define PG8_WAIT_V(n) asm volatile("s_waitcnt vmcnt(" #n ")" ::: "memory")
#define PG8_WAIT_L(n) asm volatile("s_waitcnt lgkmcnt(" #n ")" ::: "memory")
#define PG8_BAR __builtin_amdgcn_s_barrier()
#define PG8_SCHED __builtin_amdgcn_sched_barrier(0)
    Unit cur, nxt; int ui = 0;
    if (!S.next(0, cur)) return;
    f32x4 acc[2][2][4][2];
#pragma unroll
    for (int a = 0; a < 2; ++a)
#pragma unroll
        for (int b = 0; b < 2; ++b)
#pragma unroll
            for (int m = 0; m < 4; ++m)
#pragma unroll
                for (int n = 0; n < 2; ++n) acc[a][b][m][n] = (f32x4){0.f, 0.f, 0.f, 0.f};
    bf16x8 At[4][2], B0[2][2], B1[2][2];
    const char* cA = (const char*)g.A + (size_t)cur.pm * tstep; const char* cB = (const char*)g.Bt + (size_t)cur.pn * tstep;
    S.a_ready(cur);
    if constexpr (SP2) {
        PG8_STAGE(PG8_SB(0, 0), cB, voffB); PG8_STAGE(PG8_SB(0, 1), cB + hstep, voffB); PG8_STAGE(PG8_SA(0, 0), cA, voffA); PG8_STAGE(PG8_SA(0, 1), cA + hstep, voffA);
        if (wr == 1) PG8_BAR;
        PG8_WAIT_V(2); PG8_BAR;
        PG8_STAGE(PG8_SB(1, 0), cB + kstep, voffB); PG8_STAGE(PG8_SA(1, 0), cA + kstep, voffA); PG8_STAGE(PG8_SB(1, 1), cB + hstep + kstep, voffB);
        PG8_WAIT_V(6); PG8_BAR;
    } else {
        PG8_STAGE(PG8_SB(0, 0), cB, voffB); PG8_STAGE(PG8_SA(0, 0), cA, voffA); PG8_STAGE(PG8_SB(0, 1), cB + hstep, voffB); PG8_STAGE(PG8_SA(0, 1), cA + hstep, voffA);
        if (wr == 1) PG8_BAR;
        PG8_WAIT_V(4); PG8_BAR;
        PG8_STAGE(PG8_SB(1, 0), cB + kstep, voffB); PG8_STAGE(PG8_SA(1, 0), cA + kstep, voffA); PG8_STAGE(PG8_SB(1, 1), cB + hstep + kstep, voffB);
        PG8_WAIT_V(6); PG8_BAR;
    }
    for (;;) {
        const bool has_next = S.next(ui + 1, nxt);
        const char* nA = has_next ? (const char*)g.A + (size_t)nxt.pm * tstep : cA; const char* nB = has_next ? (const char*)g.Bt + (size_t)nxt.pn * tstep : cB;
        for (int t = 0; t < nt; t += 2) {
            const bool last = (t == nt - 2);
            const char* a1 = cA + (size_t)(t + 1) * kstep;
            const char* a2 = last ? nA : cA + (size_t)(t + 2) * kstep; const char* b2 = last ? nB : cB + (size_t)(t + 2) * kstep;
            const char* a3 = a2 + kstep; const char* b3 = b2 + kstep;
            if (last && has_next) S.a_ready(nxt);
            if constexpr (SP2) {
            PG8_LDB(B0, 0, 0); PG8_LDB(B1, 0, 1); PG8_SCHED; PG8_LDA(At, 0, 0); PG8_STAGE(PG8_SA(1, 1), a1 + hstep, voffA);
            PG8_WAIT_V(8); PG8_WAIT_L(0); PG8_BAR; PG8_MMA(0, 0, At, B0); PG8_MMA(0, 1, At, B1); PG8_BAR; PG8_SCHED;
            PG8_LDA(At, 0, 1); PG8_STAGE(PG8_SB(0, 0), b2, voffB); PG8_STAGE(PG8_SB(0, 1), b2 + hstep, voffB); PG8_STAGE(PG8_SA(0, 0), a2, voffA);
            PG8_WAIT_V(8); PG8_WAIT_L(0); PG8_BAR; PG8_MMA(1, 0, At, B0); PG8_MMA(1, 1, At, B1); PG8_BAR; PG8_SCHED;
            PG8_LDB(B0, 1, 0); PG8_LDB(B1, 1, 1); PG8_SCHED; PG8_LDA(At, 1, 0); PG8_STAGE(PG8_SA(0, 1), a2 + hstep, voffA);
            PG8_WAIT_V(8); PG8_WAIT_L(0); PG8_BAR; PG8_MMA(0, 0, At, B0); PG8_MMA(0, 1, At, B1); PG8_BAR; PG8_SCHED;
            PG8_LDA(At, 1, 1); PG8_STAGE(PG8_SB(1, 0), b3, voffB); PG8_STAGE(PG8_SB(1, 1), b3 + hstep, voffB); PG8_STAGE(PG8_SA(1, 0), a3, voffA);
            PG8_WAIT_V(8); PG8_WAIT_L(0); PG8_BAR; PG8_MMA(1, 0, At, B0); PG8_MMA(1, 1, At, B1); PG8_BAR; PG8_SCHED;
            } else {
            PG8_LDB(B0, 0, 0); PG8_SCHED; PG8_LDA(At, 0, 0); PG8_STAGE(PG8_SA(1, 1), a1 + hstep, voffA);
            PG8_WAIT_L(8); PG8_BAR; PG8_WAIT_L(0); PG8_MMA(0, 0, At, B0); PG8_BAR; PG8_SCHED;
            PG8_LDB(B1, 0, 1); PG8_STAGE(PG8_SB(0, 0), b2, voffB);
            PG8_BAR; PG8_WAIT_L(0); PG8_MMA(0, 1, At, B1); PG8_BAR;
            PG8_LDA(At, 0, 1); PG8_STAGE(PG8_SA(0, 0), a2, voffA);
            PG8_BAR; PG8_WAIT_L(0); PG8_MMA(1, 0, At, B0); PG8_BAR; PG8_SCHED;
            PG8_STAGE(PG8_SB(0, 1), b2 + hstep, voffB);
            PG8_WAIT_V(6); PG8_BAR; PG8_MMA(1, 1, At, B1); PG8_BAR;
            PG8_LDB(B0, 1, 0); PG8_SCHED; PG8_LDA(At, 1, 0); PG8_STAGE(PG8_SA(0, 1), a2 + hstep, voffA);
            PG8_WAIT_L(8); PG8_BAR; PG8_WAIT_L(0); PG8_MMA(0, 0, At, B0); PG8_BAR; PG8_SCHED;
            PG8_LDB(B1, 1, 1); PG8_STAGE(PG8_SB(1, 0), b3, voffB);
            PG8_BAR; PG8_WAIT_L(0); PG8_MMA(0, 1, At, B1); PG8_BAR;
            PG8_LDA(At, 1, 1); PG8_STAGE(PG8_SA(1, 0), a3, voffA);
            PG8_BAR; PG8_WAIT_L(0); PG8_MMA(1, 0, At, B0); PG8_BAR; PG8_SCHED;
            PG8_STAGE(PG8_SB(1, 1), b3 + hstep, voffB);
            PG8_WAIT_V(6); PG8_BAR; PG8_MMA(1, 1, At, B1); PG8_BAR;
            }
        }
        if constexpr (ALIGN_EPI) { if (wr == 0) PG8_BAR; }
        E(acc, cur, wr, wc, fr, fq); S.done(cur);
        if (!has_next) break;
#pragma unroll
        for (int a = 0; a < 2; ++a)
#pragma unroll
            for (int b = 0; b < 2; ++b)
#pragma unroll
                for (int m = 0; m < 4; ++m)
#pragma unroll
                    for (int n = 0; n < 2; ++n) acc[a][b][m][n] = (f32x4){0.f, 0.f, 0.f, 0.f};
        cur = nxt; cA = nA; cB = nB; ++ui;
        if constexpr (ALIGN_EPI) { if (wr == 1) PG8_BAR; }
    }
    PG8_WAIT_V(0);
    if constexpr (!ALIGN_EPI) { if (wr == 0) PG8_BAR; }
    PG8_BAR;
#undef PG8_SA
#undef PG8_SB
#undef PG8_STAGE
#undef PG8_LDA
#undef PG8_LDB
#undef PG8_MMA
#undef PG8_WAIT_V
#undef PG8_WAIT_L
#undef PG8_BAR
#undef PG8_SCHED
}
#else
template <class Epi, class Sched, bool ALIGN_EPI = false, bool SP2 = false>
inline void gemm_phase(unsigned char*, const Gemm g, const Sched& S, const Epi& E) {
    const int tid = threadIdx.x, wid = tid >> 6, lane = tid & 63, wr = wid >> 2, wc = wid & 3, fr = lane & 15, fq = lane >> 4;
    Unit u;
    for (int i = 0; S.next(i, u); ++i) {
        f32x4 acc[2][2][4][2];
        for (int ai = 0; ai < 2; ++ai) for (int bj = 0; bj < 2; ++bj) for (int m = 0; m < 4; ++m) for (int n = 0; n < 2; ++n) for (int j = 0; j < 4; ++j) {
            const int row = 256 * u.pm + 128 * ai + 64 * wr + 16 * m + fr;
            const int cit = Epi::PERM ? 128 * bj + 32 * wc + 8 * fq + 4 * n + j : 128 * bj + 32 * wc + 16 * n + 4 * fq + j;
            const bf16_t* a = g.A + (size_t)row * g.K; const bf16_t* b = g.Bt + (size_t)(256 * u.pn + cit) * g.K; float s = 0.f;
            for (int k = 0; k < g.K; ++k) s += bf2f(a[k]) * bf2f(b[k]);
            acc[ai][bj][m][n][j] = s; }
        E(acc, u, wr, wc, fr, fq);
    }
}
#endif
}

typedef const f32x4 (&AccRef)[2][2][4][2];
struct EpiInProj {
    static constexpr bool PERM = true;
    bf16_t* Pb; float* G16;
    DEV void operator()(AccRef acc, const pg8::Unit& u, int wr, int wc, int fr, int fq) const {
        const int row0 = u.pm * 256 + wr * 64 + fr;
        if (u.po < NPB / 256) {
            const int col0 = u.po * 256 + wc * 32 + 8 * fq;
#pragma unroll
            for (int ai = 0; ai < 2; ++ai)
#pragma unroll
                for (int m = 0; m < 4; ++m) { bf16_t* rowp = Pb + (size_t)(row0 + ai * 128 + m * 16) * NPB + col0;
#pragma unroll
                    for (int bj = 0; bj < 2; ++bj) { const f32x4 v0 = acc[ai][bj][m][0], v1 = acc[ai][bj][m][1];
                        u32x4 w; w.x = pk2(v0[0], v0[1]); w.y = pk2(v0[2], v0[3]); w.z = pk2(v1[0], v1[1]); w.w = pk2(v1[2], v1[3]);
                        *(u32x4*)(rowp + bj * 128) = w; } }
        } else if (wc == 0 && fq < 2) {
#pragma unroll
            for (int ai = 0; ai < 2; ++ai)
#pragma unroll
                for (int m = 0; m < 4; ++m) { float* rowp = G16 + (size_t)(row0 + ai * 128 + m * 16) * 16 + 8 * fq;
                    *(f32x4*)rowp = acc[ai][0][m][0]; *(f32x4*)(rowp + 4) = acc[ai][0][m][1]; }
        }
    }
};
struct EpiBranch {
    static constexpr bool PERM = true;
    const bf16_t* Pb; float* MGF; bf16_t* MG; int n;
    DEV void operator()(AccRef acc, const pg8::Unit& u, int wr, int wc, int fr, int fq) const {
        const int row0 = u.pm * 256 + wr * 64 + fr, col0 = u.po * 256 + wc * 32 + 8 * fq;
#pragma unroll
        for (int ai = 0; ai < 2; ++ai)
#pragma unroll
            for (int m = 0; m < 4; ++m) { const int row = row0 + ai * 128 + m * 16;
#pragma unroll
                for (int bj = 0; bj < 2; ++bj) { const int col = col0 + bj * 128;
                    float gt[8]; unpack8(*(const u32x4*)(Pb + (size_t)row * NPB + PGATE + n * D + col), gt);
                    float v[8];
#pragma unroll
                    for (int q = 0; q < 8; ++q) v[q] = sigmoidf_(gt[q]) * acc[ai][bj][m][q >> 2][q & 3];
                    float* mp = MGF + (size_t)row * D + col;
                    if (n > 0) { const f32x4 p0 = *(const f32x4*)mp, p1 = *(const f32x4*)(mp + 4);
#pragma unroll
                        for (int q = 0; q < 4; ++q) { v[q] += p0[q]; v[4 + q] += p1[q]; } }
                    if (n < 2) { *(f32x4*)mp = (f32x4){v[0], v[1], v[2], v[3]}; *(f32x4*)(mp + 4) = (f32x4){v[4], v[5], v[6], v[7]}; }
                    else *(u32x4*)(MG + (size_t)row * D + col) = pack8(v); } }
    }
};
struct EpiResid {
    static constexpr bool PERM = false;
    const float* baseL; const float* baseC; float* outL; float* outC; const float* gate;
    bool moe; const int* rtok; const float* rw; const int* rslot; float* ys;
    DEV void operator()(AccRef acc, const pg8::Unit& u, int wr, int wc, int fr, int fq) const {
        const int row0 = u.pm * 256 + wr * 64 + fr, col0 = u.po * 256 + wc * 32 + 4 * fq;
#pragma unroll
        for (int ai = 0; ai < 2; ++ai)
#pragma unroll
            for (int m = 0; m < 4; ++m) { const int row = row0 + ai * 128 + m * 16;
                if (moe) {
                    const int tok = rtok[row]; if (tok < 0) continue;
                    const float w = rw[row]; float* o = ys + ((size_t)rslot[row] * MLAT + tok) * D + col0;
#pragma unroll
                    for (int bj = 0; bj < 2; ++bj)
#pragma unroll
                        for (int n = 0; n < 2; ++n) *(f32x4*)(o + bj * 128 + n * 16) = acc[ai][bj][m][n] * w;
                } else {
                    const bool lat = row < MLAT; const float* b = lat ? baseL + (size_t)row * D : baseC + (size_t)(row - MLAT) * D;
                    float* o = lat ? outL + (size_t)row * D : outC + (size_t)(row - MLAT) * D; const float* gv = gate + (size_t)row_vec(row) * 6 * D;
#pragma unroll
                    for (int bj = 0; bj < 2; ++bj)
#pragma unroll
                        for (int n = 0; n < 2; ++n) { const int c = col0 + bj * 128 + n * 16; *(f32x4*)(o + c) = *(const f32x4*)(b + c) + *(const f32x4*)(gv + c) * acc[ai][bj][m][n]; }
                } }
    }
};
struct EpiGU {
    static constexpr bool PERM = true;
    bf16_t* ACT;
    DEV void operator()(AccRef acc, const pg8::Unit& u, int wr, int wc, int fr, int fq) const {
        const int row0 = u.pm * 256 + wr * 64 + fr, col0 = u.po * 128 + wc * 32 + 8 * fq;
#pragma unroll
        for (int ai = 0; ai < 2; ++ai)
#pragma unroll
            for (int m = 0; m < 4; ++m) { float v[8];
#pragma unroll
                for (int q = 0; q < 8; ++q) v[q] = siluf_(acc[ai][0][m][q >> 2][q & 3]) * acc[ai][1][m][q >> 2][q & 3];
                *(u32x4*)(ACT + (size_t)(row0 + ai * 128 + m * 16) * DFF + col0) = pack8(v); }
    }
};

namespace att {
constexpr int NW = 8, QBLK = 32, KVBLK = 64, LDQ = ATT_W, LDK = KV_W, LDO = BW;
constexpr float SCALE = 0.088388347648318440f, THR = 8.f;
constexpr size_t SHM_V = KVBLK * HD * 2, SHM_K = KVBLK * HD * 2, SHM_ATTN = 2 * SHM_V + 2 * SHM_K + NW * 64 * 4;
#ifndef HOST_EMU
using s16x4 = __attribute__((ext_vector_type(4))) short;
#define KSWZ(row, colB) ((row) * 256 + ((colB) ^ (((row) & 7) << 4)))
#define SBAR() __builtin_amdgcn_sched_barrier(0)
__device__ __forceinline__ unsigned cvtpk(float lo, float hi) { unsigned r; asm volatile("v_cvt_pk_bf16_f32 %0, %1, %2" : "=v"(r) : "v"(lo), "v"(hi)); return r; }
__device__ __forceinline__ void partialSM(f32x16& p0, f32x16& p1, float& m_reg, float& mn, float& alpha) {
  constexpr float C = SCALE * 1.4426950408889634f;
  float pmax = p0[0]; for (int r = 1; r < 16; ++r) pmax = fmaxf(pmax, p0[r]); for (int r = 0; r < 16; ++r) pmax = fmaxf(pmax, p1[r]);
  { auto rr = __builtin_amdgcn_permlane32_swap(__float_as_uint(pmax), __float_as_uint(pmax), false, false);
    pmax = fmaxf(__uint_as_float(rr[0]), __uint_as_float(rr[1])); }
  if (__builtin_expect(__all(pmax - m_reg <= THR / SCALE), 1)) { mn = m_reg; alpha = 1.f; }
  else { mn = fmaxf(m_reg, pmax); alpha = __builtin_amdgcn_exp2f((m_reg - mn) * C); m_reg = mn; }
  float mnC = -mn * C;
  for (int r = 0; r < 16; ++r) p0[r] = fmaf(p0[r], C, mnC); for (int r = 0; r < 16; ++r) p1[r] = fmaf(p1[r], C, mnC);
  for (int r = 0; r < 16; ++r) p0[r] = __builtin_amdgcn_exp2f(p0[r]);
}
__device__ __forceinline__ void finishSM(f32x16& p0, f32x16& p1, float alpha, float& l_reg, bf16x8& pa0, bf16x8& pa1, bf16x8& pa2, bf16x8& pa3) {
  for (int r = 0; r < 16; ++r) p1[r] = __builtin_amdgcn_exp2f(p1[r]);
  float ps = 0; for (int r = 0; r < 16; ++r) ps += p0[r]; for (int r = 0; r < 16; ++r) ps += p1[r];
  { auto rr = __builtin_amdgcn_permlane32_swap(__float_as_uint(ps), __float_as_uint(ps), false, false);
    ps = __uint_as_float(rr[0]) + __uint_as_float(rr[1]); }
  l_reg = l_reg * alpha + ps;
#define PK4(P, BASE, OUT) do { unsigned a0 = cvtpk(P[BASE + 0], P[BASE + 1]), a1 = cvtpk(P[BASE + 2], P[BASE + 3]);   \
    unsigned b0 = cvtpk(P[BASE + 4], P[BASE + 5]), b1 = cvtpk(P[BASE + 6], P[BASE + 7]);                              \
    auto r0 = __builtin_amdgcn_permlane32_swap(a0, b0, false, false); auto r1 = __builtin_amdgcn_permlane32_swap(a1, b1, false, false); \
    u32x4 w = {r0[0], r1[0], r0[1], r1[1]}; OUT = *reinterpret_cast<bf16x8*>(&w); } while (0)
  PK4(p0, 0, pa0); PK4(p0, 8, pa1); PK4(p1, 0, pa2); PK4(p1, 8, pa3);
#undef PK4
}
__device__ __forceinline__ void qkt(f32x16& p0, f32x16& p1, const bf16_t* Ks, const bf16x8* qr, int r32, int hi) {
  p0 = f32x16{}; p1 = f32x16{};
  for (int d0 = 0; d0 < 8; ++d0) { int cb = (d0 * 16 + hi * 8) * 2;
    bf16x8 b0 = *reinterpret_cast<const bf16x8*>((const char*)Ks + KSWZ(r32, cb));
    bf16x8 b1 = *reinterpret_cast<const bf16x8*>((const char*)Ks + KSWZ(32 + r32, cb));
    p0 = __builtin_amdgcn_mfma_f32_32x32x16_bf16(b0, qr[d0], p0, 0, 0, 0);
    p1 = __builtin_amdgcn_mfma_f32_32x32x16_bf16(b1, qr[d0], p1, 0, 0, 0); }
}
__device__ __forceinline__ int v_st(int k, int c) { const int kk = (k & ~0xC) | ((k & 4) << 1) | ((k & 8) >> 1); return ((kk >> 3) * 4 + (c >> 5)) * 512 + ((kk & 7) * 32 + (c & 31)) * 2; }
__device__ __forceinline__ int v_rd_base(int lane) { return ((lane & 3) << 3) | (((lane >> 2) & 3) << 6) | (((lane >> 4) & 1) << 5) | (((lane >> 5) & 1) << 8); }
constexpr int v_rd_off(int d0, int ks, int half) { return d0 * 512 + ks * 4096 + half * 2048; }
template <int OFF> __device__ __forceinline__ s16x4 tr_read(int vb) {
  s16x4 r; asm volatile("ds_read_b64_tr_b16 %0, %1 offset:%2" : "=&v"(r) : "v"(vb), "i"(OFF) : "memory"); return r;
}
template <int D0> __device__ __forceinline__ void pv_one(f32x16& od, int vb, bf16x8 pa0, bf16x8 pa1, bf16x8 pa2, bf16x8 pa3) {
  const s16x4 l0 = tr_read<v_rd_off(D0, 0, 0)>(vb), h0 = tr_read<v_rd_off(D0, 0, 1)>(vb), l1 = tr_read<v_rd_off(D0, 1, 0)>(vb), h1 = tr_read<v_rd_off(D0, 1, 1)>(vb);
  const s16x4 l2 = tr_read<v_rd_off(D0, 2, 0)>(vb), h2 = tr_read<v_rd_off(D0, 2, 1)>(vb), l3 = tr_read<v_rd_off(D0, 3, 0)>(vb), h3 = tr_read<v_rd_off(D0, 3, 1)>(vb);
  asm volatile("s_waitcnt lgkmcnt(0)" ::: "memory"); SBAR();
#define PK(L, H) (bf16x8){L[0], L[1], L[2], L[3], H[0], H[1], H[2], H[3]}
  od = __builtin_amdgcn_mfma_f32_32x32x16_bf16(pa0, PK(l0, h0), od, 0, 0, 0);
  od = __builtin_amdgcn_mfma_f32_32x32x16_bf16(pa1, PK(l1, h1), od, 0, 0, 0);
  od = __builtin_amdgcn_mfma_f32_32x32x16_bf16(pa2, PK(l2, h2), od, 0, 0, 0);
  od = __builtin_amdgcn_mfma_f32_32x32x16_bf16(pa3, PK(l3, h3), od, 0, 0, 0);
#undef PK
}
__device__ __forceinline__ void pv_d0(f32x16* o, int vb, bf16x8 pa0, bf16x8 pa1, bf16x8 pa2, bf16x8 pa3) {
  pv_one<0>(o[0], vb, pa0, pa1, pa2, pa3); pv_one<1>(o[1], vb, pa0, pa1, pa2, pa3); pv_one<2>(o[2], vb, pa0, pa1, pa2, pa3); pv_one<3>(o[3], vb, pa0, pa1, pa2, pa3);
}
__device__ __forceinline__ void attn_dense_body(const bf16_t* __restrict__ Qb, const bf16_t* __restrict__ Kh, const bf16_t* __restrict__ Vh, bf16_t* __restrict__ Ob, int seq, char* lds) {
  const int tid = opaque_tid(), wid = tid >> 6, lane = tid & 63, r32 = lane & 31, hi = lane >> 5;
  bf16_t* V_lds = (bf16_t*)lds; bf16_t* K_lds = (bf16_t*)(lds + 2 * SHM_V);
  float* ws = (float*)(lds + 2 * SHM_V + 2 * SHM_K) + wid * 64; float* li_l = ws; float* al_l = ws + 32;
  float m_reg = -1e30f, l_reg = 0; f32x16 o[4] = {}; bf16x8 qr[8];
  const bf16_t* Qw = Qb + (long)(wid * QBLK + r32) * LDQ + hi * 8;
#pragma unroll
  for (int d0 = 0; d0 < 8; ++d0) qr[d0] = *reinterpret_cast<const bf16x8*>(Qw + d0 * 16);
  const int sr = tid >> 4, sc = (tid & 15) * 8, vst0 = v_st(sr, sc), vst1 = v_st(32 + sr, sc);
  const int vb0 = (int)(uintptr_t)V_lds + v_rd_base(lane);
  struct { bf16x8 vs0, vs1, ks0, ks1; } sr_[2];
#define SLOAD(i, k0) do { sr_[i].vs0 = *reinterpret_cast<const bf16x8*>(&Vh[(long)((k0) + sr) * LDK + sc]); sr_[i].vs1 = *reinterpret_cast<const bf16x8*>(&Vh[(long)((k0) + 32 + sr) * LDK + sc]); \
    sr_[i].ks0 = *reinterpret_cast<const bf16x8*>(&Kh[(long)((k0) + sr) * LDK + sc]); sr_[i].ks1 = *reinterpret_cast<const bf16x8*>(&Kh[(long)((k0) + 32 + sr) * LDK + sc]); } while (0)
#define SWRITE(b, i) do { *(bf16x8*)((char*)V_lds + (b) * SHM_V + vst0) = sr_[i].vs0;          \
    *(bf16x8*)((char*)V_lds + (b) * SHM_V + vst1) = sr_[i].vs1; int kc = sc * 2;               \
    *(bf16x8*)((char*)K_lds + (b) * SHM_K + KSWZ(sr, kc)) = sr_[i].ks0;                       \
    *(bf16x8*)((char*)K_lds + (b) * SHM_K + KSWZ(32 + sr, kc)) = sr_[i].ks1; } while (0)
#define SWAIT() asm volatile("s_waitcnt vmcnt(4)" ::: "memory")
#define RESC(a) do { if (__any((a) < 1.f)) { if (hi == 0) al_l[r32] = (a); asm volatile("s_waitcnt lgkmcnt(0)" ::: "memory"); \
    for (int d = 0; d < 4; ++d) for (int r = 0; r < 16; ++r) o[d][r] *= al_l[crow(r, hi)]; } } while (0)
  f32x16 pA0, pA1, pB0, pB1; float mnA, mnB, alA, alB; bf16x8 pa0, pa1, pa2, pa3; const int NT = seq / KVBLK;
  constexpr int SE = 0, SO = 1;
  SLOAD(SE, 0); asm volatile("s_waitcnt vmcnt(0)" ::: "memory"); SWRITE(0, SE); __syncthreads();
  qkt(pA0, pA1, K_lds, qr, r32, hi); partialSM(pA0, pA1, m_reg, mnA, alA);
  SLOAD(SO, KVBLK); if (2 < NT) SLOAD(SE, 2 * KVBLK);
  SWAIT(); SWRITE(1, SO); __syncthreads();
  for (int j = 1; j + 1 < NT; j += 2) {
    SBAR(); qkt(pB0, pB1, (bf16_t*)((char*)K_lds + SHM_K), qr, r32, hi);
    finishSM(pA0, pA1, alA, l_reg, pa0, pa1, pa2, pa3); SBAR();
    SLOAD(SO, (j + 2) * KVBLK); SBAR();
    pv_d0(o, vb0, pa0, pa1, pa2, pa3); partialSM(pB0, pB1, m_reg, mnB, alB);
    __syncthreads(); SWAIT(); SWRITE(0, SE);
    RESC(alB); __syncthreads();
    SBAR(); qkt(pA0, pA1, K_lds, qr, r32, hi);
    finishSM(pB0, pB1, alB, l_reg, pa0, pa1, pa2, pa3); SBAR();
    if (j + 3 < NT) SLOAD(SE, (j + 3) * KVBLK); SBAR();
    pv_d0(o, vb0 + (int)SHM_V, pa0, pa1, pa2, pa3); partialSM(pA0, pA1, m_reg, mnA, alA);
    __syncthreads(); SWAIT(); SWRITE(1, SO);
    RESC(alA); __syncthreads();
  }
  SBAR(); qkt(pB0, pB1, (bf16_t*)((char*)K_lds + SHM_K), qr, r32, hi);
  finishSM(pA0, pA1, alA, l_reg, pa0, pa1, pa2, pa3); SBAR();
  pv_d0(o, vb0, pa0, pa1, pa2, pa3); partialSM(pB0, pB1, m_reg, mnB, alB);
  __syncthreads(); RESC(alB);
  finishSM(pB0, pB1, alB, l_reg, pa0, pa1, pa2, pa3); SBAR();
  pv_d0(o, vb0 + (int)SHM_V, pa0, pa1, pa2, pa3);
  if (hi == 0) li_l[r32] = l_reg; asm volatile("s_waitcnt lgkmcnt(0)" ::: "memory");
  float rli[16];
#pragma unroll
  for (int r = 0; r < 16; ++r) rli[r] = __builtin_amdgcn_rcpf(li_l[crow(r, hi)]);
  bf16_t* Ow = Ob + (long)(wid * QBLK) * LDO;
#pragma unroll
  for (int r = 0; r < 16; ++r) { int orow = crow(r, hi);
    for (int d0 = 0; d0 < 4; ++d0) Ow[(long)orow * LDO + d0 * 32 + r32] = (bf16_t)f2bf(o[d0][r] * rli[r]); }
  __syncthreads();
#undef SLOAD
#undef SWRITE
#undef SWAIT
#undef RESC
}
#else
inline void attn_dense_body(const bf16_t* Qb, const bf16_t* Kh, const bf16_t* Vh, bf16_t* Ob, int seq, char*) {
  const int tid = threadIdx.x; if (tid >= 256) return;
  const bf16_t* q = Qb + (long)tid * LDQ; std::vector<float> sc(seq); float mx = -1e30f;
  for (int k = 0; k < seq; ++k) { float s = 0; for (int d = 0; d < HD; ++d) s += bf2f(q[d]) * bf2f(Kh[(long)k * LDK + d]); sc[k] = s * SCALE; mx = fmaxf(mx, sc[k]); }
  float l = 0; for (int k = 0; k < seq; ++k) { sc[k] = expf(sc[k] - mx); l += sc[k]; }
  for (int d = 0; d < HD; ++d) { float o = 0; for (int k = 0; k < seq; ++k) o += sc[k] * bf2f(Vh[(long)k * LDK + d]); Ob[(long)tid * LDO + d] = (bf16_t)f2bf(o / l); }
}
#endif
}
DEV void phase_attn(const Params& P, const Ctx& C, bool need_ctx) {
    constexpr int QBL = TL / 256, QBC = TC / 256, NUL = NB * AH * QBL;
    const int nu = NUL + (need_ctx ? NB * AH * QBC : 0);
    for (int u = C.bid; u < nu; u += C.nblk) {
        const bool lat = u < NUL; const int v = lat ? u : u - NUL, nqb = lat ? QBL : QBC;
        const int qb = v % nqb, h = (v / nqb) % AH, b = v / (nqb * AH), kvh = h / (AH / AKV);
        const int row0 = lat ? lat_row(b, qb * 256) : ctx_row(b, qb * 256);
        const bf16_t* Kh = WSP(bf16_t, WS_KCAT) + (size_t)b * TT * KV_W + kvh * HD; const bf16_t* Vh = WSP(bf16_t, WS_VCAT) + (size_t)b * TT * KV_W + kvh * HD;
        att::attn_dense_body(WSP(bf16_t, WS_QA) + (size_t)row0 * ATT_W + h * HD, Kh, Vh, WSP(bf16_t, WS_Y) + (size_t)row0 * BW + h * HD, lat ? TT : TC, (char*)C.lds);
    }
}

constexpr size_t SM2_PE = 0;
constexpr int CW_PE = 2048, CW_NPAN = 2047;
static_assert(CW_PE + MOE_PANELS <= CW_BAR, "panel table fits below the barrier words");
DEV void phase_moe_gather(const Params& P, const Ctx& C) {
    const unsigned* cnt = WSP(unsigned, WS_CTL) + CW_CNT;
    int poff[NE + 1]; poff[0] = 0;
#pragma unroll
    for (int e = 0; e < NE; ++e) poff[e + 1] = poff[e] + (int)((cnt[e] + 255u) / 256u) * 256;
    if (C.bid == 0 && C.tid < MOE_PANELS) { int e = -1;
#pragma unroll
        for (int q = 0; q < NE; ++q) if (C.tid * 256 >= poff[q] && C.tid * 256 < poff[q + 1]) e = q;
        WSP(int, WS_CTL)[CW_PE + C.tid] = e < 0 ? 0 : e; if (C.tid == 0) WSP(int, WS_CTL)[CW_NPAN] = poff[NE] / 256; }
    const int* te = WSP(int, WS_SMALL + SM_TE); const float* tw = WSP(float, WS_SMALL + SM_TW); const int* tp = WSP(int, WS_SMALL + SM_TP);
    for (int i = C.gw; i < MLAT * 2; i += C.ngw) {
        const int tok = i >> 1, k = i & 1, e = te[i]; int base = 0;
#pragma unroll
        for (int q = 0; q < NE; ++q) if (q == e) base = poff[q];
        const int r = base + tp[i];
        const u32x4* src = (const u32x4*)(WSP(bf16_t, WS_H) + (size_t)tok * D); u32x4* dst = (u32x4*)(WSP(bf16_t, WS_APERM) + (size_t)r * D);
        for (int q = C.lane; q < D / 8; q += 64) dst[q] = src[q];
        if (C.lane == 0) { WSP(int, WS_SMALL + SM_RTOK)[r] = tok; WSP(float, WS_SMALL + SM_RW)[r] = tw[i]; WSP(int, WS_SMALL + SM_RSLOT)[r] = k; }
    }
}
DEV void phase_moe_combine(const Params& P, const Ctx& C, int l) {
    const int gt = C.bid * NTHREADS + C.tid, ngt = C.nblk * NTHREADS;
    const float* ys = WSP(float, WS_YS);
    for (int i = gt; i < MLAT * (D / 4); i += ngt) {
        const int row = i / (D / 4), col = (i % (D / 4)) * 4;
        const f32x4 g = *(const f32x4*)(mod_vec(P, l, row_vec(row), 5) + col);
        *(f32x4*)(P.out + (size_t)row * D + col) = *(const f32x4*)(WSP(float, WS_X1) + (size_t)row * D + col) + g * (*(const f32x4*)(ys + (size_t)row * D + col) + *(const f32x4*)(ys + ((size_t)MLAT + row) * D + col));
    }
}

#ifndef HOST_EMU
#define LAS __attribute__((address_space(3)))
#define XB_TMO      128
#define XB_XCNT(j)  (256  + 64 * (j))
#define XB_XSUB(j)  (1280 + 64 * (j))
#define XB_XGEN(j)  (2304 + 64 * (j))
#define XB_TOP      3328
#define XB_TOPGEN   3392
#define XCD_BAR_WORDS 3456
#define XB_SPIN_CAP (1u << 18)
__device__ __forceinline__ unsigned xb_ld(unsigned* p)              { return __hip_atomic_load(p, __ATOMIC_RELAXED, __HIP_MEMORY_SCOPE_AGENT); }
__device__ __forceinline__ unsigned xb_add(unsigned* p, unsigned v) { return __hip_atomic_fetch_add(p, v, __ATOMIC_RELAXED, __HIP_MEMORY_SCOPE_AGENT); }
__device__ __forceinline__ unsigned xb_xcc_id() { return (unsigned)__builtin_amdgcn_s_getreg((3 << 11) | 20) & 0xFu; }
#define XB_SPIN(cond, bar) do { unsigned _sp = 0; while (cond) { __builtin_amdgcn_s_sleep(1); \
    if ((++_sp & 255u) == 0u) { if (xb_ld(&(bar)[XB_TMO])) break; if (_sp > XB_SPIN_CAP) { atomicAdd(&(bar)[XB_TMO], 1u); break; } } } } while (0)
struct XcdBarrier { unsigned* bar; unsigned x; volatile LAS unsigned* st; };
__device__ __forceinline__ XcdBarrier xcd_barrier_post(unsigned* bar, volatile LAS unsigned* st) {
    XcdBarrier b; b.bar = bar; b.x = xb_xcc_id(); b.st = st;
    if (threadIdx.x == 0) (void)xb_add(&bar[XB_XCNT(b.x)], 1u);
    return b;
}
__device__ __forceinline__ void xcd_barrier_complete(unsigned* bar, unsigned x, unsigned& nloc, unsigned& nx) {
    const unsigned G = gridDim.x * gridDim.y * gridDim.z;
    unsigned sum, cnt, mine, sp = 0u;
    for (;;) {
        sum = 0u; cnt = 0u; mine = 0u;
#pragma unroll
        for (unsigned j = 0; j < 16; ++j) { const unsigned c = xb_ld(&bar[XB_XCNT(j)]); sum += c; cnt += (c > 0u) ? 1u : 0u; mine = (j == x) ? c : mine; }
        if (sum == G) break;
        __builtin_amdgcn_s_sleep(1);
        if ((++sp & 255u) == 0u) { if (xb_ld(&bar[XB_TMO])) break; if (sp > XB_SPIN_CAP) { atomicAdd(&bar[XB_TMO], 1u); break; } }
    }
    nloc = mine > 0u ? mine : 1u; nx = cnt > 0u ? cnt : 1u;
}
__device__ __forceinline__ void xcd_barrier(const XcdBarrier& b) {
    asm volatile("s_waitcnt vmcnt(0)" ::: "memory");
    __syncthreads();
    if (threadIdx.x == 0) {
        unsigned* bar = b.bar;
        __builtin_amdgcn_s_waitcnt(0);
        unsigned nloc = b.st[0], nx = b.st[1];
        if (nloc == 0u) { xcd_barrier_complete(bar, b.x, nloc, nx); b.st[0] = nloc; b.st[1] = nx; }
        const unsigned old = xb_add(&bar[XB_XSUB(b.x)], 1u);
        const unsigned gen = old / nloc;
        if (old + 1u == (gen + 1u) * nloc) {
            __builtin_amdgcn_fence(__ATOMIC_RELEASE, "agent");
            asm volatile("s_waitcnt vmcnt(0)" ::: "memory");
            const unsigned og = xb_add(&bar[XB_TOP], 1u);
            const unsigned tg = og / nx;
            if (og + 1u == (tg + 1u) * nx) xb_add(&bar[XB_TOPGEN], 1u);
            else XB_SPIN(xb_ld(&bar[XB_TOPGEN]) == tg, bar);
            __builtin_amdgcn_fence(__ATOMIC_ACQUIRE, "agent");
            xb_add(&bar[XB_XGEN(b.x)], 1u);
            asm volatile("s_waitcnt vmcnt(0)" ::: "memory");
        } else {
            XB_SPIN(xb_ld(&bar[XB_XGEN(b.x)]) == gen, bar);
            __builtin_amdgcn_fence(__ATOMIC_ACQUIRE, "agent");
            asm volatile("s_waitcnt vmcnt(0)" ::: "memory");
        }
    }
    __syncthreads();
}
#define GEMM_LDS(C) ((PG8_LAS unsigned char*)(C).lds)
#else
struct XcdBarrier { int dummy; };
inline void xcd_barrier(const XcdBarrier&) {}
#define GEMM_LDS(C) ((C).lds)
#endif

constexpr int NPL = 13, NPHASES = 2 + DEPTH * NPL;
#ifndef PROBE_MASK
#define PROBE_MASK 0
#endif
#define REPS(g) (1 + ((PROBE_MASK >> (g)) & 1))
#define REP_BEGIN(g) _Pragma("unroll 1") for (int rep_ = 0; rep_ < REPS(g); ++rep_) {
#define REP_END(g) if (rep_ + 1 < REPS(g)) xcd_barrier(bar); }
DEV void run_phases(const Params& P, unsigned char* ldsp, const int lo, const int hi, const XcdBarrier& bar) {
#define C make_ctx(ldsp)
#define IN(k) (lo <= (k) && (k) < hi)
#define SEAM(k) do { if (IN(k) && IN((k) + 1)) xcd_barrier(bar); } while (0)
    if (IN(0)) { REP_BEGIN(0) phase_weights(P, C); phase_mod_partial(P, C); REP_END(0) }
    SEAM(0);
    if (IN(1)) phase_mod_final(P, C);
    SEAM(1);
    for (int l = 0; l < DEPTH; ++l) {
        const int pb = 2 + l * NPL; const bool need_ctx = l < DEPTH - 1, moe = (l & 1) != 0;
        const int rows = need_ctx ? MT : MLAT;
        if (IN(pb + 0)) { REP_BEGIN(1) phase_hpass(P, C, l, 0, false); REP_END(1) }
        SEAM(pb + 0);
        if (IN(pb + 1)) { REP_BEGIN(2)
            pg8::Gemm g{WSP(bf16_t, WS_H), WSP(bf16_t, WS_WIN) + (size_t)l * NP * D, D};
            pg8::PanelOrder S; S.init(MT / 256, NP / 256, C.nblk, C.bid, nullptr);
            EpiInProj E{WSP(bf16_t, WS_P), WSP(float, WS_G16)};
            pg8::gemm_phase<EpiInProj, pg8::PanelOrder, true, true>(GEMM_LDS(C), g, S, E);
        REP_END(2) }
        SEAM(pb + 1);
        if (IN(pb + 2)) { REP_BEGIN(3) phase_fixup(P, C, l, need_ctx); REP_END(3) }
        SEAM(pb + 2);
        REP_BEGIN(4)
        if (IN(pb + 3)) phase_s1(P, C, l);
        SEAM(pb + 3);
        if (IN(pb + 4)) phase_s2(P, C);
        REP_END(4)
        SEAM(pb + 4);
        if (IN(pb + 5)) { REP_BEGIN(5) phase_attn(P, C, need_ctx); REP_END(5) REP_BEGIN(6) phase_s3(P, C, l, need_ctx); REP_END(6) }
        SEAM(pb + 5);
        if (IN(pb + 6)) { REP_BEGIN(7)
            for (int n = 0; n < 3; ++n) {
                pg8::Gemm g{WSP(bf16_t, WS_Y) + (size_t)n * MT * BW, WSP(bf16_t, WS_WBR) + (size_t)(l * 3 + n) * D * BW, BW};
                pg8::PanelOrder S; S.init(rows / 256, D / 256, C.nblk, C.bid, nullptr);
                EpiBranch E{WSP(bf16_t, WS_P), WSP(float, WS_MGF), WSP(bf16_t, WS_MG), n};
                pg8::gemm_phase<EpiBranch, pg8::PanelOrder, true, true>(GEMM_LDS(C), g, S, E);
            }
        REP_END(7) }
        SEAM(pb + 6);
        if (IN(pb + 7)) { REP_BEGIN(8)
            pg8::Gemm g{WSP(bf16_t, WS_MG), WSP(bf16_t, WS_WOUT) + (size_t)l * D * D, D};
            pg8::PanelOrder S; S.init(rows / 256, D / 256, C.nblk, C.bid, nullptr);
            const float* bL = l == 0 ? P.x : WSP(float, WS_X2); const float* bC = l == 0 ? P.ctx : WSP(float, WS_X2) + (size_t)MLAT * D;
            EpiResid E{bL, bC, WSP(float, WS_X1), WSP(float, WS_X1) + (size_t)MLAT * D, mod_vec(P, l, 0, 2), false, nullptr, nullptr, nullptr, nullptr};
            pg8::gemm_phase<EpiResid, pg8::PanelOrder, true, true>(GEMM_LDS(C), g, S, E);
        REP_END(8) }
        SEAM(pb + 7);
        if (IN(pb + 8)) phase_hpass(P, C, l, 1, moe);
        SEAM(pb + 8);
        if (IN(pb + 9)) { if (moe) phase_moe_gather(P, C); }
        SEAM(pb + 9);
        if (IN(pb + 10)) { REP_BEGIN(9)
            pg8::Gemm g{moe ? WSP(bf16_t, WS_APERM) : WSP(bf16_t, WS_H), moe ? WSP(bf16_t, WS_WMGU) + (size_t)(l / 2) * NE * 2 * DFF * D : WSP(bf16_t, WS_WGU) + (size_t)(l / 2) * 2 * DFF * D, D};
            pg8::PanelOrder S; S.init(moe ? WSP(int, WS_CTL)[CW_NPAN] : rows / 256, 2 * DFF / 256, C.nblk, C.bid, moe ? WSP(int, WS_CTL) + CW_PE : nullptr);
            EpiGU E{WSP(bf16_t, WS_ACT)};
            pg8::gemm_phase<EpiGU, pg8::PanelOrder, true, true>(GEMM_LDS(C), g, S, E);
        REP_END(9) }
        SEAM(pb + 10);
        if (IN(pb + 11)) { REP_BEGIN(10)
            pg8::Gemm g{WSP(bf16_t, WS_ACT), moe ? WSP(bf16_t, WS_WMDN) + (size_t)(l / 2) * NE * D * DFF : WSP(bf16_t, WS_WDN) + (size_t)(l / 2) * D * DFF, DFF};
            pg8::PanelOrder S; S.init(moe ? WSP(int, WS_CTL)[CW_NPAN] : rows / 256, D / 256, C.nblk, C.bid, moe ? WSP(int, WS_CTL) + CW_PE : nullptr);
            float* oL = (l == DEPTH - 1) ? P.out : WSP(float, WS_X2);
            EpiResid E{WSP(float, WS_X1), WSP(float, WS_X1) + (size_t)MLAT * D, oL, WSP(float, WS_X2) + (size_t)MLAT * D, mod_vec(P, l, 0, 5), moe,
                       WSP(int, WS_SMALL + SM_RTOK), WSP(float, WS_SMALL + SM_RW), WSP(int, WS_SMALL + SM_RSLOT), WSP(float, WS_YS)};
            pg8::gemm_phase<EpiResid, pg8::PanelOrder, true, true>(GEMM_LDS(C), g, S, E);
        REP_END(10) }
        SEAM(pb + 11);
        if (IN(pb + 12)) { if (moe) phase_moe_combine(P, C, l); }
        if (l + 1 < DEPTH) SEAM(pb + 12);
    }
#undef IN
#undef SEAM
#undef C
}

struct Args { Params P; int ph_lo, ph_hi; };
#if !defined(HOST_EMU) && !defined(NO_MAIN_KERNEL)
constexpr int MISC_OFF = 131072 + 320;
__global__ void __launch_bounds__(NTHREADS, 2) hybrid_fwd(Args a) {
    extern __shared__ __attribute__((aligned(16))) unsigned char lds[];
    volatile LAS unsigned* MISC = (volatile LAS unsigned*)((LAS unsigned char*)lds + MISC_OFF);
    if (threadIdx.x < 32) MISC[threadIdx.x] = 0u;
    __syncthreads();
    XcdBarrier bar = xcd_barrier_post((unsigned*)(a.P.ws + WS_CTL) + CW_BAR, MISC + 8);
    run_phases(a.P, lds, a.ph_lo, a.ph_hi, bar);
}

#ifndef N_LAUNCH_MODE
#define N_LAUNCH_MODE 1
#endif
extern "C" void kernel_launch(void* const* d_in, const int* in_sizes, int n_in, void* d_out, int out_size, void* d_ws, size_t ws_size, hipStream_t stream) {
    static int grid = 0;
    if (grid == 0) {
        if (n_in != 25 || in_sizes[0] != MLAT * D || out_size != MLAT * D || ws_size < WS_END) {
            fprintf(stderr, "kernel_launch: unexpected shapes: n_in %d in0 %d out %d ws %zu (need %zu)\n", n_in, n_in > 0 ? in_sizes[0] : -1, out_size, ws_size, (size_t)WS_END); grid = -1; return; }
        int dev = 0, cus = 0, per_cu = 0;
        if (hipGetDevice(&dev) != hipSuccess || hipDeviceGetAttribute(&cus, hipDeviceAttributeMultiprocessorCount, dev) != hipSuccess) { grid = -1; return; }
        if (hipFuncSetAttribute((const void*)hybrid_fwd, hipFuncAttributeMaxDynamicSharedMemorySize, LDS_BYTES) != hipSuccess) { fprintf(stderr, "kernel_launch: hipFuncSetAttribute failed\n"); grid = -1; return; }
        if (hipOccupancyMaxActiveBlocksPerMultiprocessor(&per_cu, (const void*)hybrid_fwd, NTHREADS, LDS_BYTES) != hipSuccess || per_cu < 1) fprintf(stderr, "kernel_launch: occupancy query says %d\n", per_cu);
        (void)hipGetLastError();
        grid = cus;
    }
    if (grid < 0) return;
    (void)hipMemsetAsync((char*)d_ws + WS_CTL, 0, CTL_BYTES, stream);
    Args a{};
    const float** pp = (const float**)&a.P;
    for (int i = 0; i < 25; ++i) pp[i] = (const float*)d_in[i];
    a.P.out = (float*)d_out; a.P.ws = (unsigned char*)d_ws;
    if (N_LAUNCH_MODE == 1) { a.ph_lo = 0; a.ph_hi = NPHASES; hipLaunchKernelGGL(hybrid_fwd, dim3(grid), dim3(NTHREADS), LDS_BYTES, stream, a); }
    else for (int ph = 0; ph < NPHASES; ++ph) { a.ph_lo = ph; a.ph_hi = ph + 1; hipLaunchKernelGGL(hybrid_fwd, dim3(grid), dim3(NTHREADS), LDS_BYTES, stream, a); }
    const hipError_t le = hipPeekAtLastError();
    if (le != hipSuccess) fprintf(stderr, "kernel_launch: launch failed: %s\n", hipGetErrorName(le));
}
#endif
```

```cpp
#ifdef HOST_EMU
#include "emu.h"
#define DEV inline
#define WAVE_LDS_SYNC() emu::wave_barrier()
#define MFMA32(a, b, c) emu_mfma_32x32x16_bf16((a), (b), (c))
#define LDS_BASE() EMU_LDS_BASE()
#else
#include <hip/hip_runtime.h>
#include <cstdio>
#define DEV __device__ __forceinline__
#define WAVE_LDS_SYNC() asm volatile("s_waitcnt lgkmcnt(0)" ::: "memory")
#define MFMA32(a, b, c) __builtin_amdgcn_mfma_f32_32x32x16_bf16((a), (b), (c), 0, 0, 0)
typedef short bf16x8 __attribute__((ext_vector_type(8)));
typedef float f32x16 __attribute__((ext_vector_type(16)));
typedef float f32x4 __attribute__((ext_vector_type(4)));
#endif
typedef unsigned short bf16_t;
typedef unsigned u32x4 __attribute__((ext_vector_type(4)));
typedef unsigned u32x2 __attribute__((ext_vector_type(2)));
typedef float f32x2 __attribute__((ext_vector_type(2)));

#ifdef SMALL_CFG
constexpr int D = 512, NB = 2, TL = 256, TC = 256, AH = 4, AKV = 2, MLH = 2, HGH = 4, DFF = 768;
#else
constexpr int D = 2048, NB = 2, TL = 4096, TC = 256, AH = 8, AKV = 2, MLH = 4, HGH = 8, DFF = 5632;
#endif
constexpr int DEPTH = 2, GRIDW = 64, HD = 128, ATT_W = AH * HD, KV_W = AKV * HD, MDK = 256, MDV = 256, ML_W = MLH * MDV, HDK = 128, HDV = 128, HG_W = HGH * HDV;
constexpr int BW = ATT_W, NE = 8, CH = 64, NV = NB + 1;
constexpr float EPS = 1e-6f;
constexpr int MLAT = NB * TL, MCTX = NB * TC, MT = MLAT + MCTX, TT = TC + TL, NCH = TT / CH, NCHC = TC / CH;
constexpr int NG = 4 * MLH;
static_assert(ML_W == BW && HG_W == BW && NG <= 16 && TC % 256 == 0 && TL % 256 == 0 && D % 256 == 0 && DFF % 128 == 0, "config");
constexpr int OQ = 0, OK_ = OQ + ATT_W, OV = OK_ + KV_W, OMQ = OV + KV_W, OMK = OMQ + ML_W, OMV = OMK + ML_W, OMO = OMV + ML_W, OMG = OMO + ML_W;
constexpr int OHQ = OMG + NG, OHF = OHQ + HG_W, OHB = OHF + HG_W, OHI = OHB + HG_W, OHG = OHI + HG_W, OGATE = OHG + HG_W, N_IN = OGATE + 3 * D;
constexpr int PQ = OQ, PK = OK_, PV = OV, PMQ = OMQ, PMK = OMK, PMV = OMV, PMO = OMO, PHQ = OMG, PHF = PHQ + HG_W, PHB = PHF + HG_W, PHI = PHB + HG_W, PHG = PHI + HG_W, PGATE = PHG + HG_W;
constexpr int NPB = N_IN - NG, NP = NPB + 256;
static_assert(NPB % 256 == 0 && PGATE + 3 * D == NPB, "projection layout");
constexpr int MOE_ROWS = MLAT * 2 + NE * 256, MOE_PANELS = MOE_ROWS / 256;
constexpr int NSQM = NB * MLH * 2, NSQH = NB * HGH * 2;

constexpr size_t al256(size_t x) { return (x + 255) / 256 * 256; }
constexpr size_t WS_CTL = 0, CTL_BYTES = 1u << 20;
constexpr size_t WS_MODP = WS_CTL + CTL_BYTES;
constexpr size_t WS_MOD = WS_MODP + al256((size_t)(D / 64) * DEPTH * NV * 6 * D * 4);
constexpr size_t WS_LB = WS_MOD + al256((size_t)DEPTH * NV * 6 * D * 4);
constexpr size_t WS_WIN = WS_LB + al256((size_t)DEPTH * HG_W * 4);
constexpr size_t WS_WBR = WS_WIN + al256((size_t)DEPTH * NP * D * 2);
constexpr size_t WS_WOUT = WS_WBR + al256((size_t)DEPTH * 3 * D * BW * 2);
constexpr size_t WS_WGU = WS_WOUT + al256((size_t)DEPTH * D * D * 2);
constexpr size_t WS_WDN = WS_WGU + al256((size_t)2 * DFF * D * 2);
constexpr size_t WS_WMGU = WS_WDN + al256((size_t)D * DFF * 2);
constexpr size_t WS_WMDN = WS_WMGU + al256((size_t)NE * 2 * DFF * D * 2);
constexpr size_t WS_H = WS_WMDN + al256((size_t)NE * D * DFF * 2);
constexpr size_t WS_G16 = WS_H + al256((size_t)MT * D * 2);
constexpr size_t WS_QA = WS_G16 + al256((size_t)MT * 16 * 4);
constexpr size_t WS_KCAT = WS_QA + al256((size_t)MT * ATT_W * 2);
constexpr size_t WS_VCAT = WS_KCAT + al256((size_t)NB * TT * KV_W * 2);
constexpr size_t WS_QM = WS_VCAT + al256((size_t)NB * TT * KV_W * 2);
constexpr size_t WS_KM = WS_QM + al256((size_t)MT * ML_W * 2);
constexpr size_t WS_Y = WS_KM + al256((size_t)MT * ML_W * 2);
constexpr size_t WS_MGF = WS_Y + al256((size_t)3 * MT * BW * 2);
constexpr size_t WS_MG = WS_MGF + al256((size_t)MT * D * 4);
constexpr size_t WS_X1 = WS_MG + al256((size_t)MT * D * 2);
constexpr size_t WS_X2 = WS_X1 + al256((size_t)MT * D * 4);
constexpr size_t WS_SMALL = WS_X2 + al256((size_t)MT * D * 4);
constexpr size_t SM_FL = 0;
constexpr size_t SM_MLOC = SM_FL + al256((size_t)NSQM * NCH * 4);
constexpr size_t SM_MST = SM_MLOC + al256((size_t)NSQM * NCH * 4);
constexpr size_t SM_NLOC = SM_MST + al256((size_t)NSQM * NCH * 4);
constexpr size_t SM_LAM = SM_NLOC + al256((size_t)NSQM * NCH * MDK * 4);
constexpr size_t SM_TE = SM_LAM + al256((size_t)NSQH * NCH * HDK * 4);
constexpr size_t SM_TW = SM_TE + al256((size_t)MLAT * 2 * 4);
constexpr size_t SM_TP = SM_TW + al256((size_t)MLAT * 2 * 4);
constexpr size_t SM_RTOK = SM_TP + al256((size_t)MLAT * 2 * 4);
constexpr size_t SM_RW = SM_RTOK + al256((size_t)MOE_ROWS * 4);
constexpr size_t SM_RSLOT = SM_RW + al256((size_t)MOE_ROWS * 4);
constexpr size_t SM_END = SM_RSLOT + al256((size_t)MOE_ROWS * 4);
constexpr size_t WS_BIG = WS_SMALL + SM_END;
constexpr size_t WS_P = WS_BIG;
constexpr size_t WS_ACT = WS_BIG;
constexpr size_t WS_APERM = WS_ACT + al256((size_t)MOE_ROWS * DFF * 2);
constexpr size_t BIG_BYTES = al256((size_t)MT * NPB * 2) > al256((size_t)MOE_ROWS * DFF * 2) + al256((size_t)MOE_ROWS * D * 2) ? al256((size_t)MT * NPB * 2) : al256((size_t)MOE_ROWS * DFF * 2) + al256((size_t)MOE_ROWS * D * 2);
constexpr size_t WS_ST = WS_BIG + BIG_BYTES;
constexpr size_t WS_CSTM = WS_ST;
constexpr size_t WS_CSTH = WS_CSTM + al256((size_t)NSQM * NCH * MDV * MDK * 2);
constexpr size_t WS_YS = WS_ST;
constexpr size_t ST_BYTES = al256((size_t)NSQM * NCH * MDV * MDK * 2) + al256((size_t)NSQH * NCH * HDV * HDK * 2) > al256((size_t)2 * MLAT * D * 4) ? al256((size_t)NSQM * NCH * MDV * MDK * 2) + al256((size_t)NSQH * NCH * HDV * HDK * 2) : al256((size_t)2 * MLAT * D * 4);
constexpr size_t WS_END = WS_ST + ST_BYTES;
constexpr int CW_BAR = 4096;
constexpr int CW_CNT = 1024;

constexpr int NTHREADS = 512, NWAVES = 8;
constexpr int LDS_BYTES = 147456;

struct Params {
    const float *x, *c, *ctx, *c_ctx, *w_mod, *b_mod, *norm1_g, *norm2_g, *w_in, *qn_g, *kn_g, *conv_w, *gate_b, *ml_norm_g, *lb_logits, *hg_norm_g,
        *w_branch, *w_out, *ffn_wg, *ffn_wu, *ffn_wd, *moe_wr, *moe_wg, *moe_wu, *moe_wd;
    float* out; unsigned char* ws;
};

DEV unsigned fbits(float f) { return __builtin_bit_cast(unsigned, f); }
DEV float bitsf(unsigned u) { return __builtin_bit_cast(float, u); }
DEV float bf2f(bf16_t h) { return bitsf(((unsigned)h) << 16); }
DEV unsigned f2bf(float f) { const unsigned u = fbits(f); return (u + 0x7fffu + ((u >> 16) & 1u)) >> 16; }
DEV unsigned pk2(float lo, float hi) { return f2bf(lo) | (f2bf(hi) << 16); }
#ifdef HOST_EMU
DEV float fexp(float x) { return expf(x); }
#else
DEV float fexp(float x) { return __builtin_amdgcn_exp2f(x * 1.4426950408889634f); }
#endif
#ifdef HOST_EMU
DEV float sigmoidf_(float x) { return 1.0f / (1.0f + expf(-x)); }
DEV float flog(float x) { return logf(x); }
#else
DEV float sigmoidf_(float x) { return __builtin_amdgcn_rcpf(1.0f + __builtin_amdgcn_exp2f(x * -1.4426950408889634f)); }
DEV float flog(float x) { return __builtin_amdgcn_logf(x) * 0.6931471805599453f; }
#endif
DEV float siluf_(float x) { return x * sigmoidf_(x); }
DEV float logsigmoidf_(float x) { return fminf(x, 0.f) - log1pf(expf(-fabsf(x))); }
DEV float wave_sum(float v) {
#pragma unroll
    for (int o = 1; o < 64; o <<= 1) v += __shfl_xor(v, o);
    return v;
}
DEV int crow(int r, int hi) { return (r & 3) + 8 * (r >> 2) + 4 * hi; }
#ifdef HOST_EMU
typedef s16x4_emu s16x4;
DEV void tr_issue(s16x4& lo, s16x4& hi4, const bf16_t* X, int px, int k0, int n0, int lane) {
    const bf16_t* a = X + (size_t)(k0 + 8 * (lane >> 5) + ((lane & 15) >> 2)) * px + n0 + 16 * ((lane >> 4) & 1) + 4 * (lane & 3);
    lo = emu_tr_read(a); hi4 = emu_tr_read(a + 4 * px);
}
#define TR_WAIT2(a, b) do {} while (0)
#define TR_WAIT4(a, b, c, d) do {} while (0)
#define TR_WAIT8(a, b, c, d, e, f, g, h) do {} while (0)
#else
typedef short s16x4 __attribute__((ext_vector_type(4)));
DEV void tr_issue(s16x4& lo, s16x4& hi4, const bf16_t* X, int px, int k0, int n0, int lane) {
    const bf16_t* a = X + (size_t)(k0 + 8 * (lane >> 5) + ((lane & 15) >> 2)) * px + n0 + 16 * ((lane >> 4) & 1) + 4 * (lane & 3);
    const unsigned a0 = (unsigned)(uintptr_t)a, a1 = (unsigned)(uintptr_t)(a + 4 * px);
    asm volatile("ds_read_b64_tr_b16 %0, %1" : "=&v"(lo) : "v"(a0) : "memory");
    asm volatile("ds_read_b64_tr_b16 %0, %1" : "=&v"(hi4) : "v"(a1) : "memory");
}
#define TR_WAIT2(a, b) asm volatile("s_waitcnt lgkmcnt(0)" : "+v"(a), "+v"(b) :: "memory")
#define TR_WAIT4(a, b, c, d) asm volatile("s_waitcnt lgkmcnt(0)" : "+v"(a), "+v"(b), "+v"(c), "+v"(d) :: "memory")
#define TR_WAIT8(a, b, c, d, e, f, g, h) asm volatile("s_waitcnt lgkmcnt(0)" : "+v"(a), "+v"(b), "+v"(c), "+v"(d), "+v"(e), "+v"(f), "+v"(g), "+v"(h) :: "memory")
#endif
#define TR_PK(L, H) ((bf16x8){(L)[0], (L)[1], (L)[2], (L)[3], (H)[0], (H)[1], (H)[2], (H)[3]})
DEV float wave_max(float v) {
#pragma unroll
    for (int o = 1; o < 64; o <<= 1) v = fmaxf(v, __shfl_xor(v, o));
    return v;
}
DEV float wave_scan_add(float v, int lane) {
#pragma unroll
    for (int o = 1; o < 64; o <<= 1) { const float t = __shfl(v, (lane - o) & 63); if (lane >= o) v += t; }
    return v;
}
DEV float wave_scan_max(float v, int lane) {
#pragma unroll
    for (int o = 1; o < 64; o <<= 1) { const float t = __shfl(v, (lane - o) & 63); if (lane >= o) v = fmaxf(v, t); }
    return v;
}
DEV void unpack8(const u32x4 w, float (&f)[8]) {
    f[0] = bitsf(w.x << 16); f[1] = bitsf(w.x & 0xffff0000u); f[2] = bitsf(w.y << 16); f[3] = bitsf(w.y & 0xffff0000u);
    f[4] = bitsf(w.z << 16); f[5] = bitsf(w.z & 0xffff0000u); f[6] = bitsf(w.w << 16); f[7] = bitsf(w.w & 0xffff0000u);
}
DEV u32x4 pack8(const float (&f)[8]) { u32x4 w; w.x = pk2(f[0], f[1]); w.y = pk2(f[2], f[3]); w.z = pk2(f[4], f[5]); w.w = pk2(f[6], f[7]); return w; }
DEV int lat_row(int b, int t) { return b * TL + t; }
DEV int ctx_row(int b, int t) { return MLAT + b * TC + t; }
DEV int seq_row(int b, int d, int p) {
    if (p < TC) return ctx_row(b, d ? TC - 1 - p : p);
    const int t = p - TC; return lat_row(b, d ? TL - 1 - t : t);
}
DEV int dir_chunk(int cc, int d) { if (!d) return cc; return cc < NCHC ? NCHC - 1 - cc : NCH - 1 - (cc - NCHC); }
DEV int chunk_row0(int b, int cc) { return cc < NCHC ? ctx_row(b, cc * CH) : lat_row(b, (cc - NCHC) * CH); }
DEV int row_vec(int row) { return row < MLAT ? row / TL : NB; }

#ifdef HOST_EMU
DEV int opaque_tid() { return threadIdx.x; }
#else
DEV int opaque_tid() { int t = threadIdx.x; asm volatile("" : "+v"(t)); return t; }
#endif
struct Ctx {
    int tid, lane, wave, gw, ngw, bid, nblk; unsigned char* lds;
};
DEV Ctx make_ctx(unsigned char* lds) {
    Ctx c; c.tid = opaque_tid(); c.lane = c.tid & 63; c.wave = c.tid >> 6; c.bid = blockIdx.x; c.nblk = gridDim.x; c.gw = c.bid * NWAVES + c.wave; c.ngw = c.nblk * NWAVES; c.lds = lds; return c;
}
#define WSP(T, off) ((T*)(P.ws + (off)))

struct Job { const float* src; int K, ld, c0, nc; bf16_t* dst; int r0, mode; };
constexpr int NJOBS = DEPTH * 6 + 3 + NE * 3;
DEV Job get_job(const Params& P, int j) {
    Job J; J.mode = 0; J.r0 = 0; J.c0 = 0;
    if (j < DEPTH * 6) {
        const int l = j / 6, k = j % 6;
        if (k == 0) { J.src = P.w_in + (size_t)l * D * N_IN; J.K = D; J.ld = N_IN; J.c0 = 0; J.nc = OMG; J.dst = WSP(bf16_t, WS_WIN) + (size_t)l * NP * D; J.r0 = 0; }
        else if (k == 1) { J.src = P.w_in + (size_t)l * D * N_IN; J.K = D; J.ld = N_IN; J.c0 = OMG + NG; J.nc = N_IN - OMG - NG; J.dst = WSP(bf16_t, WS_WIN) + (size_t)l * NP * D; J.r0 = OMG; }
        else if (k < 5) { const int n = k - 2; J.src = P.w_branch + (size_t)(l * 3 + n) * BW * D; J.K = BW; J.ld = D; J.nc = D; J.dst = WSP(bf16_t, WS_WBR) + (size_t)(l * 3 + n) * D * BW; }
        else { J.src = P.w_out + (size_t)l * D * D; J.K = D; J.ld = D; J.nc = D; J.dst = WSP(bf16_t, WS_WOUT) + (size_t)l * D * D; }
        return J;
    }
    j -= DEPTH * 6;
    if (j < 3) {
        if (j == 0) { J.src = P.ffn_wg; J.K = D; J.ld = DFF; J.nc = DFF; J.dst = WSP(bf16_t, WS_WGU); J.r0 = 0; J.mode = 1; }
        else if (j == 1) { J.src = P.ffn_wu; J.K = D; J.ld = DFF; J.nc = DFF; J.dst = WSP(bf16_t, WS_WGU); J.r0 = 128; J.mode = 1; }
        else { J.src = P.ffn_wd; J.K = DFF; J.ld = D; J.nc = D; J.dst = WSP(bf16_t, WS_WDN); }
        return J;
    }
    j -= 3; const int e = j / 3, k = j % 3;
    if (k == 0) { J.src = P.moe_wg + (size_t)e * D * DFF; J.K = D; J.ld = DFF; J.nc = DFF; J.dst = WSP(bf16_t, WS_WMGU) + (size_t)e * 2 * DFF * D; J.r0 = 0; J.mode = 1; }
    else if (k == 1) { J.src = P.moe_wu + (size_t)e * D * DFF; J.K = D; J.ld = DFF; J.nc = DFF; J.dst = WSP(bf16_t, WS_WMGU) + (size_t)e * 2 * DFF * D; J.r0 = 128; J.mode = 1; }
    else { J.src = P.moe_wd + (size_t)e * DFF * D; J.K = DFF; J.ld = D; J.nc = D; J.dst = WSP(bf16_t, WS_WMDN) + (size_t)e * D * DFF; }
    return J;
}
DEV int job_items(const Job& J) { return (J.K / 64) * (J.nc / 32); }
DEV void transpose_item(const Job& J, int item, float* scr, int lane) {
    const int nblk = J.nc / 32, kb = item / nblk, nb = item % nblk, k0 = 64 * kb, n0 = 32 * nb;
    {
        const float* sp = J.src + (size_t)(k0 + (lane >> 3)) * J.ld + J.c0 + n0 + 4 * (lane & 7);
        f32x4 v[8];
#pragma unroll
        for (int i = 0; i < 8; ++i) v[i] = *(const f32x4*)(sp + (size_t)(8 * i) * J.ld);
#pragma unroll
        for (int i = 0; i < 8; ++i) { float* d = scr + (8 * i + (lane >> 3)) * 33 + 4 * (lane & 7); d[0] = v[i][0]; d[1] = v[i][1]; d[2] = v[i][2]; d[3] = v[i][3]; }
    }
    WAVE_LDS_SYNC();
    const int c = lane & 7;
#pragma unroll
    for (int jj = 0; jj < 4; ++jj) { const int n = (lane >> 3) + 8 * jj; const float* s = scr + (8 * c) * 33 + n; const int nn = n0 + n;
        u32x4 o; o.x = pk2(s[0 * 33], s[1 * 33]); o.y = pk2(s[2 * 33], s[3 * 33]); o.z = pk2(s[4 * 33], s[5 * 33]); o.w = pk2(s[6 * 33], s[7 * 33]);
        const int row = J.mode ? J.r0 + 256 * (nn / 128) + (nn % 128) : J.r0 + nn;
        *(u32x4*)(J.dst + (size_t)row * J.K + k0 + 8 * c) = o; }
    WAVE_LDS_SYNC();
}
DEV void phase_weights(const Params& P, const Ctx& C) {
    float* scr = (float*)(C.lds + C.wave * 16384);
    int total = 0;
    for (int j = 0; j < NJOBS; ++j) total += job_items(get_job(P, j));
    for (int it = C.gw; it < total; it += C.ngw) {
        int r = it, j = 0; Job J = get_job(P, 0);
        for (;;) { const int n = job_items(J); if (r < n) break; r -= n; ++j; J = get_job(P, j); }
        transpose_item(J, r, scr, C.lane);
    }
    const int gt = C.bid * NTHREADS + C.tid, ngt = C.nblk * NTHREADS;
    for (int i = gt; i < DEPTH * 256 * (D / 8); i += ngt) {
        const int l = i / (256 * (D / 8)), r = (i / (D / 8)) % 256, k8 = (i % (D / 8)) * 8;
        float f[8];
#pragma unroll
        for (int q = 0; q < 8; ++q) f[q] = r < NG ? P.w_in[((size_t)l * D + k8 + q) * N_IN + OMG + r] : 0.f;
        *(u32x4*)(WSP(bf16_t, WS_WIN) + ((size_t)l * NP + NPB + r) * D + k8) = pack8(f);
    }
}
DEV const float* cvec_ptr(const Params& P, int v) { return v < NB ? P.c + (size_t)v * D : P.c_ctx; }
DEV void phase_mod_partial(const Params& P, const Ctx& C) {
    constexpr int NCG = 6 * D / 256, NKS = D / 64;
    for (int it = C.gw; it < DEPTH * NKS * NCG; it += C.ngw) {
        const int cg = it % NCG, ks = (it / NCG) % NKS, l = it / (NCG * NKS), col = cg * 256 + C.lane * 4;
        f32x4 acc[NV];
#pragma unroll
        for (int v = 0; v < NV; ++v) acc[v] = (f32x4){0.f, 0.f, 0.f, 0.f};
#pragma unroll 16
        for (int k = ks * 64; k < ks * 64 + 64; ++k) {
            const f32x4 w = *(const f32x4*)(P.w_mod + ((size_t)l * D + k) * 6 * D + col);
#pragma unroll
            for (int v = 0; v < NV; ++v) { const float s = siluf_(cvec_ptr(P, v)[k]); acc[v] += w * s; }
        }
#pragma unroll
        for (int v = 0; v < NV; ++v) *(f32x4*)(WSP(float, WS_MODP) + (((size_t)ks * DEPTH + l) * NV + v) * 6 * D + col) = acc[v];
    }
}
DEV void phase_mod_final(const Params& P, const Ctx& C) {
    constexpr int NKS = D / 64;
    const int gt = C.bid * NTHREADS + C.tid, ngt = C.nblk * NTHREADS;
    for (int i = gt; i < DEPTH * NV * 6 * D; i += ngt) {
        const int col = i % (6 * D), v = (i / (6 * D)) % NV, l = i / (6 * D * NV);
        float s = P.b_mod[(size_t)l * 6 * D + col];
        for (int ks = 0; ks < NKS; ++ks) s += WSP(float, WS_MODP)[(((size_t)ks * DEPTH + l) * NV + v) * 6 * D + col];
        WSP(float, WS_MOD)[((size_t)l * NV + v) * 6 * D + col] = s;
    }
    for (int i = gt; i < HG_W; i += ngt) {
        float mx = -1e30f; for (int l = 0; l < DEPTH; ++l) mx = fmaxf(mx, P.lb_logits[(size_t)l * HG_W + i]);
        float den = 0.f; for (int l = 0; l < DEPTH; ++l) den += expf(P.lb_logits[(size_t)l * HG_W + i] - mx);
        float cum = 0.f;
        for (int l = 0; l < DEPTH; ++l) { if (l > 0) cum += expf(P.lb_logits[(size_t)l * HG_W + i] - mx) / den; WSP(float, WS_LB)[(size_t)l * HG_W + i] = cum; }
    }
}
DEV const float* mod_vec(const Params& P, int l, int v, int idx) { return WSP(float, WS_MOD) + ((size_t)l * NV + v) * 6 * D + (size_t)idx * D; }

DEV void phase_hpass(const Params& P, const Ctx& C, int l, int which, bool router) {
    constexpr int NJ = D / 256;
    const int nrows = (which == 1 && l == DEPTH - 1) ? MLAT : MT;
    const float* g = (which ? P.norm2_g : P.norm1_g) + (size_t)l * D;
    for (int row = C.gw; row < nrows; row += C.ngw) {
        const float* src;
        if (which) src = WSP(float, WS_X1) + (size_t)row * D;
        else if (l == 0) src = row < MLAT ? P.x + (size_t)row * D : P.ctx + (size_t)(row - MLAT) * D;
        else src = WSP(float, WS_X2) + (size_t)row * D;
        const int v = row_vec(row);
        const float* sh = mod_vec(P, l, v, which ? 3 : 0); const float* sc = mod_vec(P, l, v, which ? 4 : 1);
        f32x4 x[NJ]; float ss = 0.f;
#pragma unroll
        for (int j = 0; j < NJ; ++j) { x[j] = *(const f32x4*)(src + 256 * j + 4 * C.lane); ss += (x[j].x * x[j].x + x[j].y * x[j].y) + (x[j].z * x[j].z + x[j].w * x[j].w); }
        const float rstd = 1.0f / sqrtf(wave_sum(ss) * (1.0f / D) + EPS);
        float lg[NE];
#pragma unroll
        for (int e = 0; e < NE; ++e) lg[e] = 0.f;
#pragma unroll
        for (int j = 0; j < NJ; ++j) {
            const int col = 256 * j + 4 * C.lane;
            const f32x4 gg = *(const f32x4*)(g + col), s1 = *(const f32x4*)(sc + col), s0 = *(const f32x4*)(sh + col);
            f32x4 y = x[j] * rstd * gg * (s1 + 1.0f) + s0;
            u32x2 o; o.x = pk2(y.x, y.y); o.y = pk2(y.z, y.w);
            *(u32x2*)(WSP(bf16_t, WS_H) + (size_t)row * D + col) = o;
            if (router) {
                const float* wr = P.moe_wr + (size_t)(l / 2) * D * NE + (size_t)col * NE;
#pragma unroll
                for (int q = 0; q < 4; ++q)
#pragma unroll
                    for (int e = 0; e < NE; ++e) lg[e] += y[q] * wr[q * NE + e];
            }
        }
        if (router) {
#pragma unroll
            for (int e = 0; e < NE; ++e) lg[e] = wave_sum(lg[e]);
            if (C.lane == 0) {
                int i0 = 0; float v0 = lg[0];
#pragma unroll
                for (int e = 1; e < NE; ++e) if (lg[e] > v0) { v0 = lg[e]; i0 = e; }
                int i1 = -1; float v1 = -3.0e38f;
#pragma unroll
                for (int e = 0; e < NE; ++e) if (e != i0 && lg[e] > v1) { v1 = lg[e]; i1 = e; }
                const float w1 = 1.0f / (1.0f + expf(v0 - v1)), w0 = 1.0f - w1;
                int* te = WSP(int, WS_SMALL + SM_TE) + row * 2; float* tw = WSP(float, WS_SMALL + SM_TW) + row * 2; int* tp = WSP(int, WS_SMALL + SM_TP) + row * 2;
                unsigned* cnt = WSP(unsigned, WS_CTL) + CW_CNT;
                te[0] = i0; te[1] = i1; tw[0] = w0; tw[1] = w1;
                tp[0] = (int)atomicAdd(cnt + i0, 1u); tp[1] = (int)atomicAdd(cnt + i1, 1u);
            }
        }
    }
    if (router) {
        const int gt = C.bid * NTHREADS + C.tid, ngt = C.nblk * NTHREADS;
        for (int i = gt; i < MOE_ROWS; i += ngt) WSP(int, WS_SMALL + SM_RTOK)[i] = -1;
    }
}

DEV void phase_fixup(const Params& P, const Ctx& C, int l, bool need_ctx) {
    const bf16_t* Pb = WSP(bf16_t, WS_P);
    const float* qg = P.qn_g + (size_t)l * HD; const float* kg = P.kn_g + (size_t)l * HD;
    const float* cw = P.conv_w + (size_t)l * 3 * 2 * ML_W;
    const int lane = C.lane, jf = lane & 31;
    const float invf = expf(-logf(10000.0f) * (float)(2 * jf) / 64.0f);
    for (int row = C.gw; row < MT; row += C.ngw) {
        const bool lat = row < MLAT;
        const int b = lat ? row / TL : (row - MLAT) / TC, t = lat ? row % TL : (row - MLAT) % TC, tseg = lat ? TL : TC;
        const bf16_t* pr = Pb + (size_t)row * NPB;
        float c0 = 1.f, s0 = 0.f, c1 = 1.f, s1 = 0.f;
        if (lat) { const float a0 = (float)(t / GRIDW) * invf, a1 = (float)(t % GRIDW) * invf; c0 = cosf(a0); s0 = sinf(a0); c1 = cosf(a1); s1 = sinf(a1); }
        const int pos = lat ? TC + t : t;
        for (int hh = 0; hh < AH + AKV; ++hh) {
            const bool isq = hh < AH;
            if (isq && !lat && !need_ctx) continue;
            const int col = isq ? PQ + hh * HD : PK + (hh - AH) * HD;
            float e0 = bf2f(pr[col + lane]), e1 = bf2f(pr[col + 64 + lane]);
            const float r = 1.0f / sqrtf(wave_sum(e0 * e0 + e1 * e1) * (1.0f / HD) + EPS);
            const float* gg = isq ? qg : kg;
            e0 *= r * gg[lane]; e1 *= r * gg[64 + lane];
            if (lat) {
                const float p0 = __shfl_xor(e0, 32), p1 = __shfl_xor(e1, 32);
                e0 = lane < 32 ? e0 * c0 - p0 * s0 : e0 * c0 + p0 * s0;
                e1 = lane < 32 ? e1 * c1 - p1 * s1 : e1 * c1 + p1 * s1;
            }
            bf16_t* dst = isq ? WSP(bf16_t, WS_QA) + (size_t)row * ATT_W + hh * HD : WSP(bf16_t, WS_KCAT) + ((size_t)b * TT + pos) * KV_W + (hh - AH) * HD;
            dst[lane] = (bf16_t)f2bf(e0); dst[64 + lane] = (bf16_t)f2bf(e1);
        }
        for (int cidx = lane * 4; cidx < KV_W; cidx += 256) *(u32x2*)(WSP(bf16_t, WS_VCAT) + ((size_t)b * TT + pos) * KV_W + cidx) = *(const u32x2*)(pr + PV + cidx);
        for (int cidx = lane * 8; cidx < 2 * ML_W; cidx += 512) {
            const bool isk = cidx >= ML_W; const int pc = isk ? PMK + (cidx - ML_W) : PMQ + cidx;
            float xm[8], x0[8], xp[8], o[8];
            unpack8(*(const u32x4*)(pr + pc), x0);
            if (t > 0) unpack8(*(const u32x4*)(pr - NPB + pc), xm); else { for (int q = 0; q < 8; ++q) xm[q] = 0.f; }
            if (t + 1 < tseg) unpack8(*(const u32x4*)(pr + NPB + pc), xp); else { for (int q = 0; q < 8; ++q) xp[q] = 0.f; }
            const float sc = isk ? 0.0625f : 1.0f;
#pragma unroll
            for (int q = 0; q < 8; ++q) o[q] = (xm[q] * cw[cidx + q] + x0[q] * cw[2 * ML_W + cidx + q] + xp[q] * cw[4 * ML_W + cidx + q]) * sc;
            bf16_t* dst = (isk ? WSP(bf16_t, WS_KM) + (size_t)row * ML_W + (cidx - ML_W) : WSP(bf16_t, WS_QM) + (size_t)row * ML_W + cidx);
            *(u32x4*)dst = pack8(o);
        }
    }
}

constexpr int MQP = MDK + 8, CP = CH + 8;
DEV const bf16_t* cptr(const bf16_t* p) { return p; }
DEV void mlstm_s1_unit(const Params& P, const Ctx& C0, int l, int u) {
    const Ctx C = make_ctx(C0.lds);
    const int c = u % NCH, sq = u / NCH, d = sq & 1, h = (sq >> 1) % MLH, b = sq / (2 * MLH);
    bf16_t* Ks = (bf16_t*)C.lds;
    bf16_t* Vs = Ks + CH * MQP;
    float* wsl = (float*)(Vs + CH * MQP);
    const float* G16 = WSP(float, WS_G16); const float* gb = P.gate_b + (size_t)l * NG;
    const int lane = C.lane, w = C.wave, r32 = lane & 31, hi = lane >> 5;
    const int rowL = seq_row(b, d, c * CH + lane);
    const float li = G16[(size_t)rowL * 16 + d * MLH + h] + gb[d * MLH + h];
    const float lf = logsigmoidf_(G16[(size_t)rowL * 16 + (2 + d) * MLH + h] + gb[(2 + d) * MLH + h]);
    const float fc = wave_scan_add(lf, lane), tot = __shfl(fc, 63);
    const float g = tot - fc + li, mx = wave_max(g), wsv = expf(g - mx);
    if (w == 0) { wsl[lane] = wsv; if (lane == 0) { WSP(float, WS_SMALL + SM_FL)[sq * NCH + c] = tot; WSP(float, WS_SMALL + SM_MLOC)[sq * NCH + c] = mx; } }
#pragma unroll
    for (int it = 0; it < CH * (MDK / 8) / NTHREADS; ++it) {
        const int i = C.tid + NTHREADS * it, s = i / (MDK / 8), cg = i % (MDK / 8), row = seq_row(b, d, c * CH + s);
        const float wv = __shfl(wsv, s);
        *(u32x4*)(Ks + s * MQP + cg * 8) = *(const u32x4*)(WSP(bf16_t, WS_KM) + (size_t)row * ML_W + h * MDK + cg * 8);
        float vv[8]; unpack8(*(const u32x4*)(WSP(bf16_t, WS_P) + (size_t)row * NPB + PMV + h * MDV + cg * 8), vv);
#pragma unroll
        for (int q = 0; q < 8; ++q) vv[q] *= wv;
        *(u32x4*)(Vs + s * MQP + cg * 8) = pack8(vv);
    }
    __syncthreads();
    if (C.tid < MDK) { float s = 0.f; for (int j = 0; j < CH; ++j) s += wsl[j] * bf2f(Ks[j * MQP + C.tid]); WSP(float, WS_SMALL + SM_NLOC)[((size_t)sq * NCH + c) * MDK + C.tid] = s; }
    f32x16 acc[8];
#pragma unroll
    for (int mb = 0; mb < 8; ++mb) acc[mb] = (f32x16){0};
#pragma unroll
    for (int ks = 0; ks < CH / 16; ++ks) {
        s16x4 bl, bh; tr_issue(bl, bh, cptr(Vs), MQP, 16 * ks, 32 * w, lane);
#pragma unroll
        for (int g4 = 0; g4 < 2; ++g4) {
            s16x4 al[4], ah[4];
#pragma unroll
            for (int q = 0; q < 4; ++q) tr_issue(al[q], ah[q], cptr(Ks), MQP, 16 * ks, 32 * (4 * g4 + q), lane);
            TR_WAIT8(al[0], ah[0], al[1], ah[1], al[2], ah[2], al[3], ah[3]); TR_WAIT2(bl, bh);
#pragma unroll
            for (int q = 0; q < 4; ++q) acc[4 * g4 + q] = MFMA32(TR_PK(al[q], ah[q]), TR_PK(bl, bh), acc[4 * g4 + q]);
        }
    }
    bf16_t* out = WSP(bf16_t, WS_CSTM) + ((size_t)sq * NCH + c) * MDV * MDK + (size_t)(32 * w + r32) * MDK + 4 * hi;
#pragma unroll
    for (int mb = 0; mb < 8; ++mb)
#pragma unroll
        for (int g4 = 0; g4 < 4; ++g4) { u32x2 o; o.x = pk2(acc[mb][4 * g4], acc[mb][4 * g4 + 1]); o.y = pk2(acc[mb][4 * g4 + 2], acc[mb][4 * g4 + 3]); *(u32x2*)(out + 32 * mb + 8 * g4) = o; }
    __syncthreads();
}
DEV void mlstm_s2(const Params& P, const Ctx& C) {
    const int gt = C.bid * NTHREADS + C.tid, ngt = C.nblk * NTHREADS;
    constexpr int NG8 = MDV * MDK / 8;
    static_assert(NCH % 4 == 0, "chunk pipeline depth");
    const float* FL = WSP(float, WS_SMALL + SM_FL); const float* MLOC = WSP(float, WS_SMALL + SM_MLOC);
    for (int i = gt; i < NSQM * NG8; i += ngt) {
        const int sq = i / NG8, g8 = i % NG8; float run[8];
#pragma unroll
        for (int q = 0; q < 8; ++q) run[q] = 0.f;
        float m_run = -1e30f;
        u32x4* p = (u32x4*)(WSP(bf16_t, WS_CSTM) + (size_t)sq * NCH * MDV * MDK + (size_t)g8 * 8);
        u32x4 buf[4];
#pragma unroll
        for (int q = 0; q < 4; ++q) buf[q] = p[(size_t)q * NG8];
        for (int c0 = 0; c0 < NCH; c0 += 4) {
#pragma unroll
            for (int q = 0; q < 4; ++q) { const int c = c0 + q;
                float kl[8]; unpack8(buf[q], kl);
                if (c + 4 < NCH) buf[q] = p[(size_t)(c + 4) * NG8];
                p[(size_t)c * NG8] = pack8(run);
                const float fl = FL[sq * NCH + c], ml = MLOC[sq * NCH + c], mn = fmaxf(fl + m_run, ml), dec = fexp(fl + m_run - mn), sl = fexp(ml - mn);
#pragma unroll
                for (int e = 0; e < 8; ++e) run[e] = dec * run[e] + sl * kl[e];
                m_run = mn; }
        }
    }
    for (int i = gt; i < NSQM * MDK; i += ngt) {
        const int sq = i / MDK, dk = i % MDK; float run = 0.f, m_run = -1e30f;
        float* p = WSP(float, WS_SMALL + SM_NLOC) + (size_t)sq * NCH * MDK + dk;
        for (int c = 0; c < NCH; ++c) {
            const float nl = p[(size_t)c * MDK]; p[(size_t)c * MDK] = run;
            const float fl = FL[sq * NCH + c], ml = MLOC[sq * NCH + c], mn = fmaxf(fl + m_run, ml), dec = fexp(fl + m_run - mn), sl = fexp(ml - mn);
            run = dec * run + sl * nl;
            if (dk == 0) WSP(float, WS_SMALL + SM_MST)[sq * NCH + c] = m_run;
            m_run = mn;
        }
    }
}
DEV void mlstm_s3_unit(const Params& P, const Ctx& C0, int l, int u) {
    const Ctx C = make_ctx(C0.lds);
    const int cc = u % NCH, h = (u / NCH) % MLH, b = u / (NCH * MLH);
    const int row0 = chunk_row0(b, cc);
    bf16_t* Qs = (bf16_t*)C.lds;
    bf16_t* Ks = Qs + CH * MQP;
    bf16_t* Vs = Ks + CH * MQP;
    bf16_t* SC = Vs + CH * MQP;
    float* vec = (float*)(SC + 2 * CH * CP);
    float* liv = vec;
    float* fcv = vec + 128;
    float* mtv = vec + 256;
    float* av = vec + 384;
    float* qnv = vec + 512;
    float* rinv = vec + 640;
    float* HS = (float*)C.lds;
    const float* G16 = WSP(float, WS_G16); const float* gb = P.gate_b + (size_t)l * NG;
    const int sq0 = (b * MLH + h) * 2, c0 = dir_chunk(cc, 0), c1 = dir_chunk(cc, 1);
    const int lane = C.lane, r32 = lane & 31, hi = lane >> 5, w = C.wave;
#pragma unroll
    for (int it = 0; it < CH * (MDK / 8) / NTHREADS; ++it) {
        const int i = C.tid + NTHREADS * it, s = i / (MDK / 8), cg = i % (MDK / 8), row = row0 + s;
        *(u32x4*)(Qs + s * MQP + cg * 8) = *(const u32x4*)(WSP(bf16_t, WS_QM) + (size_t)row * ML_W + h * MDK + cg * 8);
        *(u32x4*)(Ks + s * MQP + cg * 8) = *(const u32x4*)(WSP(bf16_t, WS_KM) + (size_t)row * ML_W + h * MDK + cg * 8);
        *(u32x4*)(Vs + s * MQP + cg * 8) = *(const u32x4*)(WSP(bf16_t, WS_P) + (size_t)row * NPB + PMV + h * MDV + cg * 8);
    }
    if (w == 4 || w == 5) {
        const int d = w - 4, j = d ? CH - 1 - lane : lane, row = row0 + j;
        const float li = G16[(size_t)row * 16 + d * MLH + h] + gb[d * MLH + h];
        const float lf = logsigmoidf_(G16[(size_t)row * 16 + (2 + d) * MLH + h] + gb[(2 + d) * MLH + h]);
        const float ms = WSP(float, WS_SMALL + SM_MST)[(sq0 + d) * NCH + (d ? c1 : c0)];
        const float fc = wave_scan_add(lf, lane), pm = wave_scan_max(li - fc, lane), mt = fc + fmaxf(ms, pm);
        liv[d * 64 + j] = li; fcv[d * 64 + j] = fc; mtv[d * 64 + j] = mt; av[d * 64 + j] = expf(fc + ms - mt);
    }
    __syncthreads();
    f32x16 sacc = (f32x16){0};
    if (w < 4) {
        const int tb = w >> 1, sb = w & 1;
#pragma unroll
        for (int ks = 0; ks < MDK / 16; ++ks) {
            const bf16x8 a = *(const bf16x8*)(Qs + (32 * tb + r32) * MQP + 16 * ks + 8 * hi);
            const bf16x8 bb = *(const bf16x8*)(Ks + (32 * sb + r32) * MQP + 16 * ks + 8 * hi);
            sacc = MFMA32(a, bb, sacc);
        }
    }
    {
        const int t = C.tid >> 3, part = C.tid & 7;
        const float* n0 = WSP(float, WS_SMALL + SM_NLOC) + ((size_t)(sq0 + 0) * NCH + c0) * MDK + part * 32;
        const float* n1 = WSP(float, WS_SMALL + SM_NLOC) + ((size_t)(sq0 + 1) * NCH + c1) * MDK + part * 32;
        float s0 = 0.f, s1 = 0.f;
#pragma unroll
        for (int q4 = 0; q4 < 4; ++q4) { float qq[8]; unpack8(*(const u32x4*)(Qs + t * MQP + part * 32 + q4 * 8), qq);
            const f32x4 a0 = *(const f32x4*)(n0 + q4 * 8), a1 = *(const f32x4*)(n0 + q4 * 8 + 4), b0 = *(const f32x4*)(n1 + q4 * 8), b1 = *(const f32x4*)(n1 + q4 * 8 + 4);
#pragma unroll
            for (int e = 0; e < 4; ++e) { s0 += qq[e] * a0[e] + qq[4 + e] * a1[e]; s1 += qq[e] * b0[e] + qq[4 + e] * b1[e]; } }
#pragma unroll
        for (int o = 1; o < 8; o <<= 1) { s0 += __shfl_xor(s0, o); s1 += __shfl_xor(s1, o); }
        if (part == 0) { qnv[t] = s0; qnv[64 + t] = s1; }
    }
    if (w < 4) {
        const int tb = w >> 1, sb = w & 1, s = 32 * sb + r32;
#pragma unroll
        for (int d = 0; d < 2; ++d) { const float fs = fcv[d * 64 + s], ls = liv[d * 64 + s];
#pragma unroll
            for (int r = 0; r < 16; ++r) { const int t = 32 * tb + crow(r, hi); const bool ok = d ? (s >= t) : (s <= t);
                const float wgt = ok ? fexp(fcv[d * 64 + t] - fs + ls - mtv[d * 64 + t]) : 0.f;
                SC[(d * CH + t) * CP + s] = (bf16_t)f2bf(ok ? sacc[r] * wgt : 0.f);
                if ((r & 3) == 3) asm volatile("" ::: "memory"); } }
    }
    __syncthreads();
    if (C.tid < 2 * CH) { const int d = C.tid >> 6, t = C.tid & 63; float s = 0.f;
#pragma unroll
        for (int k8 = 0; k8 < CH / 8; ++k8) { float x[8]; unpack8(*(const u32x4*)(SC + (d * CH + t) * CP + k8 * 8), x);
#pragma unroll
            for (int e = 0; e < 8; ++e) s += x[e]; }
        const float den = s + av[C.tid] * qnv[C.tid]; rinv[C.tid] = 1.0f / fmaxf(fabsf(den), expf(-mtv[C.tid])); }
    __syncthreads();
    f32x16 hs[2]; hs[0] = (f32x16){0}; hs[1] = (f32x16){0};
#pragma unroll 1
    for (int d = 0; d < 2; ++d) {
        { f32x16 a1[2]; a1[0] = (f32x16){0}; a1[1] = (f32x16){0};
#pragma unroll
        for (int ks = 0; ks < CH / 16; ++ks) {
            s16x4 bl, bh; tr_issue(bl, bh, cptr(Vs), MQP, 16 * ks, 32 * w, lane);
            const bf16x8 x0 = *(const bf16x8*)(SC + (d * CH + r32) * CP + 16 * ks + 8 * hi), x1 = *(const bf16x8*)(SC + (d * CH + 32 + r32) * CP + 16 * ks + 8 * hi);
            TR_WAIT2(bl, bh);
            a1[0] = MFMA32(x0, TR_PK(bl, bh), a1[0]); a1[1] = MFMA32(x1, TR_PK(bl, bh), a1[1]);
        }
#pragma unroll
        for (int r = 0; r < 16; ++r) { const int t = crow(r, hi); hs[0][r] += a1[0][r] * rinv[d * 64 + t]; hs[1][r] += a1[1][r] * rinv[d * 64 + 32 + t]; } }
        f32x16 a2[2]; a2[0] = (f32x16){0}; a2[1] = (f32x16){0};
        const bf16_t* cst = WSP(bf16_t, WS_CSTM) + ((size_t)(sq0 + d) * NCH + (d ? c1 : c0)) * MDV * MDK + (size_t)(32 * w + r32) * MDK + 8 * hi;
#pragma unroll 4
        for (int ks = 0; ks < MDK / 16; ++ks) {
            const bf16x8 bb = *(const bf16x8*)(cst + 16 * ks);
            const bf16x8 x0 = *(const bf16x8*)(Qs + r32 * MQP + 16 * ks + 8 * hi), x1 = *(const bf16x8*)(Qs + (32 + r32) * MQP + 16 * ks + 8 * hi);
            a2[0] = MFMA32(x0, bb, a2[0]); a2[1] = MFMA32(x1, bb, a2[1]);
        }
#pragma unroll
        for (int r = 0; r < 16; ++r) { const int t = crow(r, hi);
            hs[0][r] += av[d * 64 + t] * a2[0][r] * rinv[d * 64 + t];
            hs[1][r] += av[d * 64 + 32 + t] * a2[1][r] * rinv[d * 64 + 32 + t]; }
    }
    __syncthreads();
#pragma unroll
    for (int tb = 0; tb < 2; ++tb)
#pragma unroll
        for (int r = 0; r < 16; ++r) HS[(32 * tb + crow(r, hi)) * 257 + 32 * w + r32] = hs[tb][r];
    __syncthreads();
    const float* ng = P.ml_norm_g + (size_t)l * ML_W + h * MDV;
    for (int t = w; t < CH; t += NWAVES) {
        float v[4], ss = 0.f;
#pragma unroll
        for (int q = 0; q < 4; ++q) { v[q] = HS[t * 257 + C.lane * 4 + q]; ss += v[q] * v[q]; }
        const float rstd = 1.0f / sqrtf(wave_sum(ss) * (1.0f / MDV) + EPS);
        const int row = row0 + t; const u32x2 ov = *(const u32x2*)(WSP(bf16_t, WS_P) + (size_t)row * NPB + PMO + h * MDV + C.lane * 4);
        const float o0 = bitsf(ov.x << 16), o1 = bitsf(ov.x & 0xffff0000u), o2 = bitsf(ov.y << 16), o3 = bitsf(ov.y & 0xffff0000u);
        u32x2 y; y.x = pk2(v[0] * rstd * ng[C.lane * 4 + 0] * sigmoidf_(o0), v[1] * rstd * ng[C.lane * 4 + 1] * sigmoidf_(o1));
        y.y = pk2(v[2] * rstd * ng[C.lane * 4 + 2] * sigmoidf_(o2), v[3] * rstd * ng[C.lane * 4 + 3] * sigmoidf_(o3));
        *(u32x2*)(WSP(bf16_t, WS_Y) + ((size_t)1 * MT + row) * BW + h * MDV + C.lane * 4) = y;
    }
    __syncthreads();
}

constexpr int HQP = HDK + 8;
DEV float hg_f(float z, float lb) { return lb + (1.0f - lb) * sigmoidf_(z); }
DEV void hgrn_s1_unit(const Params& P, const Ctx& C0, int l, int u) {
    const Ctx C = make_ctx(C0.lds);
    const int cc = u % NCH, h = (u / NCH) % HGH, b = u / (NCH * HGH), row0 = chunk_row0(b, cc);
    bf16_t* KP = (bf16_t*)C.lds;
    bf16_t* Vs = KP + 2 * CH * HQP;
    float* T = (float*)(Vs + CH * HQP);
    const bf16_t* Pb = WSP(bf16_t, WS_P); const float* LB = WSP(float, WS_LB) + (size_t)l * HG_W + h * HDK;
    const int sq0 = (b * HGH + h) * 2;
    const int lane = C.lane, r32 = lane & 31, hi = lane >> 5, w = C.wave;
#pragma unroll
    for (int it = 0; it < CH * (HDV / 8) / NTHREADS; ++it) {
        const int i = C.tid + NTHREADS * it, s = i / (HDV / 8), cg = i % (HDV / 8);
        *(u32x4*)(Vs + s * HQP + cg * 8) = *(const u32x4*)(Pb + (size_t)(row0 + s) * NPB + PHI + h * HDV + cg * 8);
    }
    const float lb0 = LB[2 * lane], lb1 = LB[2 * lane + 1];
    float kk[2][8][2], gg[2][8][2];
#pragma unroll
    for (int d = 0; d < 2; ++d) {
        float c0 = 0.f, c1 = 0.f;
#pragma unroll
        for (int i = 0; i < 8; ++i) { const int p = 8 * w + i, j = d ? CH - 1 - p : p;
            const unsigned zz = *(const unsigned*)(Pb + (size_t)(row0 + j) * NPB + (d ? PHB : PHF) + h * HDK + 2 * lane);
            const float f0 = hg_f(bitsf(zz << 16), lb0), f1 = hg_f(bitsf(zz & 0xffff0000u), lb1);
            c0 += flog(f0); c1 += flog(f1); kk[d][i][0] = 1.0f - f0; kk[d][i][1] = 1.0f - f1; gg[d][i][0] = c0; gg[d][i][1] = c1; }
        *(f32x2*)(T + (d * 8 + w) * HDK + 2 * lane) = (f32x2){c0, c1};
    }
    __syncthreads();
#pragma unroll
    for (int d = 0; d < 2; ++d) {
        float off0 = 0.f, off1 = 0.f, tot0 = 0.f, tot1 = 0.f;
#pragma unroll
        for (int sg = 0; sg < 8; ++sg) { const f32x2 t = *(const f32x2*)(T + (d * 8 + sg) * HDK + 2 * lane); tot0 += t.x; tot1 += t.y; if (sg < w) { off0 += t.x; off1 += t.y; } }
#pragma unroll
        for (int i = 0; i < 8; ++i) { const int p = 8 * w + i, j = d ? CH - 1 - p : p;
            *(unsigned*)(KP + (d * CH + j) * HQP + 2 * lane) = pk2(kk[d][i][0] * fexp(tot0 - off0 - gg[d][i][0]), kk[d][i][1] * fexp(tot1 - off1 - gg[d][i][1])); }
        if (w == 0) *(f32x2*)(WSP(float, WS_SMALL + SM_LAM) + ((size_t)(sq0 + d) * NCH + dir_chunk(cc, d)) * HDK + 2 * lane) = (f32x2){fexp(tot0), fexp(tot1)};
    }
    __syncthreads();
    const int d = w >> 2, nb = w & 3;
    f32x16 acc[4];
#pragma unroll
    for (int mb = 0; mb < 4; ++mb) acc[mb] = (f32x16){0};
#pragma unroll
    for (int ks = 0; ks < CH / 16; ++ks) {
        s16x4 bl, bh, al[4], ah[4]; tr_issue(bl, bh, cptr(Vs), HQP, 16 * ks, 32 * nb, lane);
#pragma unroll
        for (int q = 0; q < 4; ++q) tr_issue(al[q], ah[q], cptr(KP + d * CH * HQP), HQP, 16 * ks, 32 * q, lane);
        TR_WAIT8(al[0], ah[0], al[1], ah[1], al[2], ah[2], al[3], ah[3]); TR_WAIT2(bl, bh);
#pragma unroll
        for (int q = 0; q < 4; ++q) acc[q] = MFMA32(TR_PK(al[q], ah[q]), TR_PK(bl, bh), acc[q]);
    }
    bf16_t* out = WSP(bf16_t, WS_CSTH) + ((size_t)(sq0 + d) * NCH + dir_chunk(cc, d)) * HDV * HDK + (size_t)(32 * nb + r32) * HDK + 4 * hi;
#pragma unroll
    for (int mb = 0; mb < 4; ++mb)
#pragma unroll
        for (int g4 = 0; g4 < 4; ++g4) { u32x2 o; o.x = pk2(acc[mb][4 * g4], acc[mb][4 * g4 + 1]); o.y = pk2(acc[mb][4 * g4 + 2], acc[mb][4 * g4 + 3]); *(u32x2*)(out + 32 * mb + 8 * g4) = o; }
    __syncthreads();
}
DEV void hgrn_s2(const Params& P, const Ctx& C) {
    const int gt = C.bid * NTHREADS + C.tid, ngt = C.nblk * NTHREADS;
    constexpr int NG8 = HDV * HDK / 8;
    for (int i = gt; i < NSQH * NG8; i += ngt) {
        const int sq = i / NG8, g8 = i % NG8, dk0 = (g8 * 8) % HDK; float run[8];
#pragma unroll
        for (int q = 0; q < 8; ++q) run[q] = 0.f;
        u32x4* p = (u32x4*)(WSP(bf16_t, WS_CSTH) + (size_t)sq * NCH * HDV * HDK + (size_t)g8 * 8);
        const float* lam = WSP(float, WS_SMALL + SM_LAM) + (size_t)sq * NCH * HDK + dk0;
        u32x4 buf[4];
#pragma unroll
        for (int q = 0; q < 4; ++q) buf[q] = p[(size_t)q * NG8];
        for (int c0 = 0; c0 < NCH; c0 += 4) {
#pragma unroll
            for (int q = 0; q < 4; ++q) { const int c = c0 + q;
                float kl[8]; unpack8(buf[q], kl);
                if (c + 4 < NCH) buf[q] = p[(size_t)(c + 4) * NG8];
                p[(size_t)c * NG8] = pack8(run);
                const f32x4 la = *(const f32x4*)(lam + (size_t)c * HDK), lb4 = *(const f32x4*)(lam + (size_t)c * HDK + 4);
#pragma unroll
                for (int e = 0; e < 4; ++e) { run[e] = la[e] * run[e] + kl[e]; run[4 + e] = lb4[e] * run[4 + e] + kl[4 + e]; } }
        }
    }
}
DEV void hgrn_s3_unit(const Params& P, const Ctx& C0, int l, int u) {
    const Ctx C = make_ctx(C0.lds);
    const int cc = u % NCH, h = (u / NCH) % HGH, b = u / (NCH * HGH), row0 = chunk_row0(b, cc);
    bf16_t* QH = (bf16_t*)C.lds;
    bf16_t* KH = QH + CH * HQP;
    bf16_t* KTL = KH + CH * HQP;
    bf16_t* QP = KTL + 32 * HQP;
    bf16_t* Vs = QP + CH * HQP;
    bf16_t* AT = Vs + CH * HQP;
    float* T = (float*)(AT + CH * CP);
    float* HS = (float*)C.lds;
    const bf16_t* Pb = WSP(bf16_t, WS_P); const float* LB = WSP(float, WS_LB) + (size_t)l * HG_W + h * HDK;
    const int sq0 = (b * HGH + h) * 2;
    const int lane = C.lane, r32 = lane & 31, hi = lane >> 5, w = C.wave, tbo = w >> 2, eb = w & 3;
#pragma unroll
    for (int it = 0; it < CH * (HDV / 8) / NTHREADS; ++it) {
        const int i = C.tid + NTHREADS * it, s = i / (HDV / 8), cg = i % (HDV / 8);
        *(u32x4*)(Vs + s * HQP + cg * 8) = *(const u32x4*)(Pb + (size_t)(row0 + s) * NPB + PHI + h * HDV + cg * 8);
    }
    const float lb0 = LB[2 * lane], lb1 = LB[2 * lane + 1];
    f32x16 oacc = (f32x16){0};
#pragma unroll 1
    for (int d = 0; d < 2; ++d) {
        const int zc = (d ? PHB : PHF) + h * HDK;
        float kk[8][2], gg[8][2], qq[8][2]; float c0 = 0.f, c1 = 0.f;
#pragma unroll
        for (int i = 0; i < 8; ++i) { const int p = 8 * w + i, j = d ? CH - 1 - p : p;
            const unsigned zz = *(const unsigned*)(Pb + (size_t)(row0 + j) * NPB + zc + 2 * lane), qv = *(const unsigned*)(Pb + (size_t)(row0 + j) * NPB + PHQ + h * HDK + 2 * lane);
            const float f0 = hg_f(bitsf(zz << 16), lb0), f1 = hg_f(bitsf(zz & 0xffff0000u), lb1);
            c0 += flog(f0); c1 += flog(f1); kk[i][0] = 1.0f - f0; kk[i][1] = 1.0f - f1; gg[i][0] = c0; gg[i][1] = c1;
            qq[i][0] = siluf_(bitsf(qv << 16)); qq[i][1] = siluf_(bitsf(qv & 0xffff0000u)); }
        *(f32x2*)(T + w * HDK + 2 * lane) = (f32x2){c0, c1};
        __syncthreads();
        float off0 = 0.f, off1 = 0.f, mid0 = 0.f, mid1 = 0.f;
#pragma unroll
        for (int sg = 0; sg < 8; ++sg) { const f32x2 t = *(const f32x2*)(T + sg * HDK + 2 * lane); if (sg < 4) { mid0 += t.x; mid1 += t.y; } if (sg < w) { off0 += t.x; off1 += t.y; } }
        const bool ref0 = w < 4;
        const float rf0 = ref0 ? 0.f : mid0, rf1 = ref0 ? 0.f : mid1;
#pragma unroll
        for (int i = 0; i < 8; ++i) { const int p = 8 * w + i, j = d ? CH - 1 - p : p; const float G0 = off0 + gg[i][0], G1 = off1 + gg[i][1];
            *(unsigned*)(QH + j * HQP + 2 * lane) = pk2(qq[i][0] * fexp(G0 - rf0), qq[i][1] * fexp(G1 - rf1));
            *(unsigned*)(KH + j * HQP + 2 * lane) = pk2(kk[i][0] * fexp(rf0 - G0), kk[i][1] * fexp(rf1 - G1));
            *(unsigned*)(QP + j * HQP + 2 * lane) = pk2(qq[i][0] * fexp(G0), qq[i][1] * fexp(G1));
            if (ref0) *(unsigned*)(KTL + (j & 31) * HQP + 2 * lane) = pk2(kk[i][0] * fexp(mid0 - G0), kk[i][1] * fexp(mid1 - G1)); }
        __syncthreads();
        if (w < 4) {
            const int tb = w >> 1, sb = w & 1; const bool diag = tb == sb, off = d ? (tb == 0 && sb == 1) : (tb == 1 && sb == 0);
            f32x16 sa = (f32x16){0};
            if (diag || off) {
                const bf16_t* kb = diag ? KH + (32 * sb) * HQP : KTL;
#pragma unroll
                for (int ks = 0; ks < HDK / 16; ++ks) {
                    const bf16x8 a = *(const bf16x8*)(QH + (32 * tb + r32) * HQP + 16 * ks + 8 * hi);
                    const bf16x8 bb = *(const bf16x8*)(kb + r32 * HQP + 16 * ks + 8 * hi);
                    sa = MFMA32(a, bb, sa);
                }
            }
#pragma unroll
            for (int r = 0; r < 16; ++r) { const int t = 32 * tb + crow(r, hi), s = 32 * sb + r32; const bool ok = d ? (s >= t) : (s <= t);
                AT[t * CP + s] = (bf16_t)f2bf((ok && (diag || off)) ? sa[r] : 0.f); }
        }
        __syncthreads();
#pragma unroll
        for (int ks = 0; ks < CH / 16; ++ks) {
            s16x4 bl, bh; tr_issue(bl, bh, cptr(Vs), HQP, 16 * ks, 32 * eb, lane);
            const bf16x8 a = *(const bf16x8*)(AT + (32 * tbo + r32) * CP + 16 * ks + 8 * hi);
            TR_WAIT2(bl, bh);
            oacc = MFMA32(a, TR_PK(bl, bh), oacc);
        }
        const bf16_t* sst = WSP(bf16_t, WS_CSTH) + ((size_t)(sq0 + d) * NCH + dir_chunk(cc, d)) * HDV * HDK + (size_t)(32 * eb + r32) * HDK + 8 * hi;
#pragma unroll
        for (int ks = 0; ks < HDK / 16; ++ks) {
            const bf16x8 a = *(const bf16x8*)(QP + (32 * tbo + r32) * HQP + 16 * ks + 8 * hi);
            const bf16x8 bb = *(const bf16x8*)(sst + 16 * ks);
            oacc = MFMA32(a, bb, oacc);
        }
        __syncthreads();
    }
#pragma unroll
    for (int r = 0; r < 16; ++r) HS[(32 * tbo + crow(r, hi)) * HDV + 32 * eb + r32] = oacc[r];
    __syncthreads();
    const float* ng = P.hg_norm_g + (size_t)l * HG_W + h * HDV;
    for (int t = w; t < CH; t += NWAVES) {
        const float v0 = HS[t * HDV + C.lane * 2], v1 = HS[t * HDV + C.lane * 2 + 1];
        const float rstd = 1.0f / sqrtf(wave_sum(v0 * v0 + v1 * v1) * (1.0f / HDV) + EPS);
        const int row = row0 + t; const unsigned gv = *(const unsigned*)(Pb + (size_t)row * NPB + PHG + h * HDV + C.lane * 2);
        const float g0 = bitsf(gv << 16), g1 = bitsf(gv & 0xffff0000u);
        *(unsigned*)(WSP(bf16_t, WS_Y) + ((size_t)2 * MT + row) * BW + h * HDV + C.lane * 2) = pk2(v0 * rstd * ng[C.lane * 2] * siluf_(g0), v1 * rstd * ng[C.lane * 2 + 1] * siluf_(g1));
    }
    __syncthreads();
}
DEV void phase_s1(const Params& P, const Ctx& C, int l) {
    for (int u = C.bid; u < NSQM * NCH; u += C.nblk) mlstm_s1_unit(P, C, l, u);
    for (int u = C.bid; u < NB * HGH * NCH; u += C.nblk) hgrn_s1_unit(P, C, l, u);
}
DEV void phase_s2(const Params& P, const Ctx& C) { mlstm_s2(P, C); hgrn_s2(P, C); }
DEV void phase_s3(const Params& P, const Ctx& C, int l, bool need_ctx) {
    const int c_lo = need_ctx ? 0 : NCHC, ncu = NCH - c_lo;
    for (int u = C.bid; u < NB * MLH * ncu; u += C.nblk) mlstm_s3_unit(P, C, l, (u / ncu) * NCH + c_lo + (u % ncu));
    for (int u = C.bid; u < NB * HGH * ncu; u += C.nblk) hgrn_s3_unit(P, C, l, (u / ncu) * NCH + c_lo + (u % ncu));
}

namespace pg8 {
constexpr int BM = 256, BK = 64, HALF = 128, HTB = HALF * BK * 2, STAGE_BYTES = 8 * HTB, NXCD = 8, WGM = 8;
struct Unit { int pm, pn, po; };
struct Gemm { const bf16_t* A; const bf16_t* Bt; int K; };
DEV int lds_byte(int r, int c) { const int st = (r >> 4) * 2 + (c >> 5), rr = r & 15, cc = c & 31, ob = rr * 64 + cc * 2; return st * 1024 + (ob ^ (((ob >> 9) & 1) << 5)); }
DEV void stage_rc(int b, int& R, int& C) { const int st = b / 1024, sb = b % 1024, swz = sb ^ (((sb >> 9) & 1) << 5); R = (st >> 1) * 16 + swz / 64; C = (st & 1) * 32 + (swz % 64) / 2; }
DEV int perm32(int rho) { const int n = rho >> 4, i = rho & 15; return 8 * (i >> 2) + 4 * n + (i & 3); }
struct PanelOrder {
    int nM, nN, nwg, G, c; const int* pe;
    DEV void init(int nM_, int nN_, int G_, int c_, const int* pe_) { nM = nM_; nN = nN_; nwg = nM * nN; G = G_; c = c_; pe = pe_; }
    DEV bool next(int i, Unit& u) const {
        const long L = (long)i * G + c; if (L >= nwg) return false;
        int wgid = (int)L; { const int q = nwg / NXCD, r = nwg % NXCD, xcd = wgid % NXCD, off = wgid / NXCD; wgid = (xcd < r ? xcd * (q + 1) : r * (q + 1) + (xcd - r) * q) + off; }
        const int nig = WGM * nN, gid = wgid / nig, fm = gid * WGM, gsz = (nM - fm) < WGM ? (nM - fm) : WGM;
        u.pm = fm + ((wgid % nig) % gsz); u.po = (wgid % nig) / gsz; u.pn = pe ? pe[u.pm] * nN + u.po : u.po; return true;
    }
    DEV void a_ready(const Unit&) const {}
    DEV void done(const Unit&) const {}
};
#ifndef HOST_EMU
#define PG8_LAS __attribute__((address_space(3)))
template <class Epi, class Sched, bool ALIGN_EPI = false, bool SP2 = false>
__device__ __forceinline__ void gemm_phase(PG8_LAS unsigned char* lds, const Gemm g, const Sched& S, const Epi& E) {
    const int tid = opaque_tid(), wid = __builtin_amdgcn_readfirstlane(tid >> 6), lane = tid & 63, wr = wid >> 2, wc = wid & 3, fr = lane & 15, fq = lane >> 4;
    const int K = g.K, nt = K / BK;
    unsigned voffA[2], voffB[2];
#pragma unroll
    for (int i = 0; i < 2; ++i) { int R, C; stage_rc(tid * 16 + i * 8192, R, C); const int Rb = Epi::PERM ? ((R & ~31) + perm32(R & 31)) : R;
        voffA[i] = (unsigned)(R * K + C) * 2u; voffB[i] = (unsigned)(Rb * K + C) * 2u; }
    const size_t kstep = (size_t)(BK * 2);
    const size_t hstep = (size_t)HALF * K * 2;
    const size_t tstep = 2 * hstep;
    const unsigned ldsw = (unsigned)wid * 1024u;
    const int aoff = lds_byte(wr * 64 + fr, fq * 8), boff = lds_byte(wc * 32 + fr, fq * 8);
#define PG8_SA(b, h) (((b) * 2 + (h)) * HTB)
#define PG8_SB(b, h) ((4 + (b) * 2 + (h)) * HTB)
#define PG8_STAGE(bufoff, gbase, voff) do { _Pragma("unroll") for (int _i = 0; _i < 2; ++_i) \
        __builtin_amdgcn_global_load_lds((const unsigned*)((const char*)(gbase) + (voff)[_i]), (PG8_LAS unsigned*)(lds + (bufoff) + ldsw + _i * 8192), 16, 0, 0); } while (0)
#define PG8_LDA(dst, b, h) do { _Pragma("unroll") for (int m = 0; m < 4; ++m) _Pragma("unroll") for (int k = 0; k < 2; ++k) dst[m][k] = *(const PG8_LAS bf16x8*)(lds + PG8_SA(b, h) + aoff + m * 2048 + k * 1024); } while (0)
#define PG8_LDB(dst, b, h) do { _Pragma("unroll") for (int n = 0; n < 2; ++n) _Pragma("unroll") for (int k = 0; k < 2; ++k) dst[n][k] = *(const PG8_LAS bf16x8*)(lds + PG8_SB(b, h) + boff + n * 2048 + k * 1024); } while (0)
#define PG8_MMA(ai, bj, At, Bt) do { __builtin_amdgcn_s_setprio(1); _Pragma("unroll") for (int m = 0; m < 4; ++m) _Pragma("unroll") for (int n = 0; n < 2; ++n) _Pragma("unroll") for (int k = 0; k < 2; ++k) \
        acc[ai][bj][m][n] = __builtin_amdgcn_mfma_f32_16x16x32_bf16(Bt[n][k], At[m][k], acc[ai][bj][m][n], 0, 0, 0); __builtin_amdgcn_s_setprio(0); } while (0)
#define PG8_WAIT_V(n) asm volatile("s_waitcnt vmcnt(" #n ")" ::: "memory")
#define PG8_WAIT_L(n) asm volatile("s_waitcnt lgkmcnt(" #n ")" ::: "memory")
#define PG8_BAR __builtin_amdgcn_s_barrier()
#define PG8_SCHED __builtin_amdgcn_sched_barrier(0)
    Unit cur, nxt; int ui = 0;
    if (!S.next(0, cur)) return;
    f32x4 acc[2][2][4][2];
#pragma unroll
    for (int a = 0; a < 2; ++a)
#pragma unroll
        for (int b = 0; b < 2; ++b)
#pragma unroll
            for (int m = 0; m < 4; ++m)
#pragma unroll
                for (int n = 0; n < 2; ++n) acc[a][b][m][n] = (f32x4){0.f, 0.f, 0.f, 0.f};
    bf16x8 At[4][2], B0[2][2], B1[2][2];
    const char* cA = (const char*)g.A + (size_t)cur.pm * tstep; const char* cB = (const char*)g.Bt + (size_t)cur.pn * tstep;
    S.a_ready(cur);
    if constexpr (SP2) {
        PG8_STAGE(PG8_SB(0, 0), cB, voffB); PG8_STAGE(PG8_SB(0, 1), cB + hstep, voffB); PG8_STAGE(PG8_SA(0, 0), cA, voffA); PG8_STAGE(PG8_SA(0, 1), cA + hstep, voffA);
        if (wr == 1) PG8_BAR;
        PG8_WAIT_V(2); PG8_BAR;
        PG8_STAGE(PG8_SB(1, 0), cB + kstep, voffB); PG8_STAGE(PG8_SA(1, 0), cA + kstep, voffA); PG8_STAGE(PG8_SB(1, 1), cB + hstep + kstep, voffB);
        PG8_WAIT_V(6); PG8_BAR;
    } else {
        PG8_STAGE(PG8_SB(0, 0), cB, voffB); PG8_STAGE(PG8_SA(0, 0), cA, voffA); PG8_STAGE(PG8_SB(0, 1), cB + hstep, voffB); PG8_STAGE(PG8_SA(0, 1), cA + hstep, voffA);
        if (wr == 1) PG8_BAR;
        PG8_WAIT_V(4); PG8_BAR;
        PG8_STAGE(PG8_SB(1, 0), cB + kstep, voffB); PG8_STAGE(PG8_SA(1, 0), cA + kstep, voffA); PG8_STAGE(PG8_SB(1, 1), cB + hstep + kstep, voffB);
        PG8_WAIT_V(6); PG8_BAR;
    }
    for (;;) {
        const bool has_next = S.next(ui + 1, nxt);
        const char* nA = has_next ? (const char*)g.A + (size_t)nxt.pm * tstep : cA; const char* nB = has_next ? (const char*)g.Bt + (size_t)nxt.pn * tstep : cB;
        for (int t = 0; t < nt; t += 2) {
            const bool last = (t == nt - 2);
            const char* a1 = cA + (size_t)(t + 1) * kstep;
            const char* a2 = last ? nA : cA + (size_t)(t + 2) * kstep; const char* b2 = last ? nB : cB + (size_t)(t + 2) * kstep;
            const char* a3 = a2 + kstep; const char* b3 = b2 + kstep;
            if (last && has_next) S.a_ready(nxt);
            if constexpr (SP2) {
            PG8_LDB(B0, 0, 0); PG8_LDB(B1, 0, 1); PG8_SCHED; PG8_LDA(At, 0, 0); PG8_STAGE(PG8_SA(1, 1), a1 + hstep, voffA);
            PG8_WAIT_V(8); PG8_WAIT_L(0); PG8_BAR; PG8_MMA(0, 0, At, B0); PG8_MMA(0, 1, At, B1); PG8_BAR; PG8_SCHED;
            PG8_LDA(At, 0, 1); PG8_STAGE(PG8_SB(0, 0), b2, voffB); PG8_STAGE(PG8_SB(0, 1), b2 + hstep, voffB); PG8_STAGE(PG8_SA(0, 0), a2, voffA);
            PG8_WAIT_V(8); PG8_WAIT_L(0); PG8_BAR; PG8_MMA(1, 0, At, B0); PG8_MMA(1, 1, At, B1); PG8_BAR; PG8_SCHED;
            PG8_LDB(B0, 1, 0); PG8_LDB(B1, 1, 1); PG8_SCHED; PG8_LDA(At, 1, 0); PG8_STAGE(PG8_SA(0, 1), a2 + hstep, voffA);
            PG8_WAIT_V(8); PG8_WAIT_L(0); PG8_BAR; PG8_MMA(0, 0, At, B0); PG8_MMA(0, 1, At, B1); PG8_BAR; PG8_SCHED;
            PG8_LDA(At, 1, 1); PG8_STAGE(PG8_SB(1, 0), b3, voffB); PG8_STAGE(PG8_SB(1, 1), b3 + hstep, voffB); PG8_STAGE(PG8_SA(1, 0), a3, voffA);
            PG8_WAIT_V(8); PG8_WAIT_L(0); PG8_BAR; PG8_MMA(1, 0, At, B0); PG8_MMA(1, 1, At, B1); PG8_BAR; PG8_SCHED;
            } else {
            PG8_LDB(B0, 0, 0); PG8_SCHED; PG8_LDA(At, 0, 0); PG8_STAGE(PG8_SA(1, 1), a1 + hstep, voffA);
            PG8_WAIT_L(8); PG8_BAR; PG8_WAIT_L(0); PG8_MMA(0, 0, At, B0); PG8_BAR; PG8_SCHED;
            PG8_LDB(B1, 0, 1); PG8_STAGE(PG8_SB(0, 0), b2, voffB);
            PG8_BAR; PG8_WAIT_L(0); PG8_MMA(0, 1, At, B1); PG8_BAR;
            PG8_LDA(At, 0, 1); PG8_STAGE(PG8_SA(0, 0), a2, voffA);
            PG8_BAR; PG8_WAIT_L(0); PG8_MMA(1, 0, At, B0); PG8_BAR; PG8_SCHED;
            PG8_STAGE(PG8_SB(0, 1), b2 + hstep, voffB);
            PG8_WAIT_V(6); PG8_BAR; PG8_MMA(1, 1, At, B1); PG8_BAR;
            PG8_LDB(B0, 1, 0); PG8_SCHED; PG8_LDA(At, 1, 0); PG8_STAGE(PG8_SA(0, 1), a2 + hstep, voffA);
            PG8_WAIT_L(8); PG8_BAR; PG8_WAIT_L(0); PG8_MMA(0, 0, At, B0); PG8_BAR; PG8_SCHED;
            PG8_LDB(B1, 1, 1); PG8_STAGE(PG8_SB(1, 0), b3, voffB);
            PG8_BAR; PG8_WAIT_L(0); PG8_MMA(0, 1, At, B1); PG8_BAR;
            PG8_LDA(At, 1, 1); PG8_STAGE(PG8_SA(1, 0), a3, voffA);
            PG8_BAR; PG8_WAIT_L(0); PG8_MMA(1, 0, At, B0); PG8_BAR; PG8_SCHED;
            PG8_STAGE(PG8_SB(1, 1), b3 + hstep, voffB);
            PG8_WAIT_V(6); PG8_BAR; PG8_MMA(1, 1, At, B1); PG8_BAR;
            }
        }
        if constexpr (ALIGN_EPI) { if (wr == 0) PG8_BAR; }
        E(acc, cur, wr, wc, fr, fq); S.done(cur);
        if (!has_next) break;
#pragma unroll
        for (int a = 0; a < 2; ++a)
#pragma unroll
            for (int b = 0; b < 2; ++b)
#pragma unroll
                for (int m = 0; m < 4; ++m)
#pragma unroll
                    for (int n = 0; n < 2; ++n) acc[a][b][m][n] = (f32x4){0.f, 0.f, 0.f, 0.f};
        cur = nxt; cA = nA; cB = nB; ++ui;
        if constexpr (ALIGN_EPI) { if (wr == 1) PG8_BAR; }
    }
    PG8_WAIT_V(0);
    if constexpr (!ALIGN_EPI) { if (wr == 0) PG8_BAR; }
    PG8_BAR;
#undef PG8_SA
#undef PG8_SB
#undef PG8_STAGE
#undef PG8_LDA
#undef PG8_LDB
#undef PG8_MMA
#undef PG8_WAIT_V
#undef PG8_WAIT_L
#undef PG8_BAR
#undef PG8_SCHED
}
#else
template <class Epi, class Sched, bool ALIGN_EPI = false, bool SP2 = false>
inline void gemm_phase(unsigned char*, const Gemm g, const Sched& S, const Epi& E) {
    const int tid = threadIdx.x, wid = tid >> 6, lane = tid & 63, wr = wid >> 2, wc = wid & 3, fr = lane & 15, fq = lane >> 4;
    Unit u;
    for (int i = 0; S.next(i, u); ++i) {
        f32x4 acc[2][2][4][2];
        for (int ai = 0; ai < 2; ++ai) for (int bj = 0; bj < 2; ++bj) for (int m = 0; m < 4; ++m) for (int n = 0; n < 2; ++n) for (int j = 0; j < 4; ++j) {
            const int row = 256 * u.pm + 128 * ai + 64 * wr + 16 * m + fr;
            const int cit = Epi::PERM ? 128 * bj + 32 * wc + 8 * fq + 4 * n + j : 128 * bj + 32 * wc + 16 * n + 4 * fq + j;
            const bf16_t* a = g.A + (size_t)row * g.K; const bf16_t* b = g.Bt + (size_t)(256 * u.pn + cit) * g.K; float s = 0.f;
            for (int k = 0; k < g.K; ++k) s += bf2f(a[k]) * bf2f(b[k]);
            acc[ai][bj][m][n][j] = s; }
        E(acc, u, wr, wc, fr, fq);
    }
}
#endif
}

typedef const f32x4 (&AccRef)[2][2][4][2];
struct EpiInProj {
    static constexpr bool PERM = true;
    bf16_t* Pb; float* G16;
    DEV void operator()(AccRef acc, const pg8::Unit& u, int wr, int wc, int fr, int fq) const {
        const int row0 = u.pm * 256 + wr * 64 + fr;
        if (u.po < NPB / 256) {
            const int col0 = u.po * 256 + wc * 32 + 8 * fq;
#pragma unroll
            for (int ai = 0; ai < 2; ++ai)
#pragma unroll
                for (int m = 0; m < 4; ++m) { bf16_t* rowp = Pb + (size_t)(row0 + ai * 128 + m * 16) * NPB + col0;
#pragma unroll
                    for (int bj = 0; bj < 2; ++bj) { const f32x4 v0 = acc[ai][bj][m][0], v1 = acc[ai][bj][m][1];
                        u32x4 w; w.x = pk2(v0[0], v0[1]); w.y = pk2(v0[2], v0[3]); w.z = pk2(v1[0], v1[1]); w.w = pk2(v1[2], v1[3]);
                        *(u32x4*)(rowp + bj * 128) = w; } }
        } else if (wc == 0 && fq < 2) {
#pragma unroll
            for (int ai = 0; ai < 2; ++ai)
#pragma unroll
                for (int m = 0; m < 4; ++m) { float* rowp = G16 + (size_t)(row0 + ai * 128 + m * 16) * 16 + 8 * fq;
                    *(f32x4*)rowp = acc[ai][0][m][0]; *(f32x4*)(rowp + 4) = acc[ai][0][m][1]; }
        }
    }
};
struct EpiBranch {
    static constexpr bool PERM = true;
    const bf16_t* Pb; float* MGF; bf16_t* MG; int n;
    DEV void operator()(AccRef acc, const pg8::Unit& u, int wr, int wc, int fr, int fq) const {
        const int row0 = u.pm * 256 + wr * 64 + fr, col0 = u.po * 256 + wc * 32 + 8 * fq;
#pragma unroll
        for (int ai = 0; ai < 2; ++ai)
#pragma unroll
            for (int m = 0; m < 4; ++m) { const int row = row0 + ai * 128 + m * 16;
#pragma unroll
                for (int bj = 0; bj < 2; ++bj) { const int col = col0 + bj * 128;
                    float gt[8]; unpack8(*(const u32x4*)(Pb + (size_t)row * NPB + PGATE + n * D + col), gt);
                    float v[8];
#pragma unroll
                    for (int q = 0; q < 8; ++q) v[q] = sigmoidf_(gt[q]) * acc[ai][bj][m][q >> 2][q & 3];
                    float* mp = MGF + (size_t)row * D + col;
                    if (n > 0) { const f32x4 p0 = *(const f32x4*)mp, p1 = *(const f32x4*)(mp + 4);
#pragma unroll
                        for (int q = 0; q < 4; ++q) { v[q] += p0[q]; v[4 + q] += p1[q]; } }
                    if (n < 2) { *(f32x4*)mp = (f32x4){v[0], v[1], v[2], v[3]}; *(f32x4*)(mp + 4) = (f32x4){v[4], v[5], v[6], v[7]}; }
                    else *(u32x4*)(MG + (size_t)row * D + col) = pack8(v); } }
    }
};
struct EpiResid {
    static constexpr bool PERM = false;
    const float* baseL; const float* baseC; float* outL; float* outC; const float* gate;
    bool moe; const int* rtok; const float* rw; const int* rslot; float* ys;
    DEV void operator()(AccRef acc, const pg8::Unit& u, int wr, int wc, int fr, int fq) const {
        const int row0 = u.pm * 256 + wr * 64 + fr, col0 = u.po * 256 + wc * 32 + 4 * fq;
#pragma unroll
        for (int ai = 0; ai < 2; ++ai)
#pragma unroll
            for (int m = 0; m < 4; ++m) { const int row = row0 + ai * 128 + m * 16;
                if (moe) {
                    const int tok = rtok[row]; if (tok < 0) continue;
                    const float w = rw[row]; float* o = ys + ((size_t)rslot[row] * MLAT + tok) * D + col0;
#pragma unroll
                    for (int bj = 0; bj < 2; ++bj)
#pragma unroll
                        for (int n = 0; n < 2; ++n) *(f32x4*)(o + bj * 128 + n * 16) = acc[ai][bj][m][n] * w;
                } else {
                    const bool lat = row < MLAT; const float* b = lat ? baseL + (size_t)row * D : baseC + (size_t)(row - MLAT) * D;
                    float* o = lat ? outL + (size_t)row * D : outC + (size_t)(row - MLAT) * D; const float* gv = gate + (size_t)row_vec(row) * 6 * D;
#pragma unroll
                    for (int bj = 0; bj < 2; ++bj)
#pragma unroll
                        for (int n = 0; n < 2; ++n) { const int c = col0 + bj * 128 + n * 16; *(f32x4*)(o + c) = *(const f32x4*)(b + c) + *(const f32x4*)(gv + c) * acc[ai][bj][m][n]; }
                } }
    }
};
struct EpiGU {
    static constexpr bool PERM = true;
    bf16_t* ACT;
    DEV void operator()(AccRef acc, const pg8::Unit& u, int wr, int wc, int fr, int fq) const {
        const int row0 = u.pm * 256 + wr * 64 + fr, col0 = u.po * 128 + wc * 32 + 8 * fq;
#pragma unroll
        for (int ai = 0; ai < 2; ++ai)
#pragma unroll
            for (int m = 0; m < 4; ++m) { float v[8];
#pragma unroll
                for (int q = 0; q < 8; ++q) v[q] = siluf_(acc[ai][0][m][q >> 2][q & 3]) * acc[ai][1][m][q >> 2][q & 3];
                *(u32x4*)(ACT + (size_t)(row0 + ai * 128 + m * 16) * DFF + col0) = pack8(v); }
    }
};

namespace att {
constexpr int NW = 8, QBLK = 32, KVBLK = 64, LDQ = ATT_W, LDK = KV_W, LDO = BW;
constexpr float SCALE = 0.088388347648318440f, THR = 8.f;
constexpr size_t SHM_V = KVBLK * HD * 2, SHM_K = KVBLK * HD * 2, SHM_ATTN = 2 * SHM_V + 2 * SHM_K + NW * 64 * 4;
#ifndef HOST_EMU
using s16x4 = __attribute__((ext_vector_type(4))) short;
#define KSWZ(row, colB) ((row) * 256 + ((colB) ^ (((row) & 7) << 4)))
#define SBAR() __builtin_amdgcn_sched_barrier(0)
__device__ __forceinline__ unsigned cvtpk(float lo, float hi) { unsigned r; asm volatile("v_cvt_pk_bf16_f32 %0, %1, %2" : "=v"(r) : "v"(lo), "v"(hi)); return r; }
__device__ __forceinline__ void partialSM(f32x16& p0, f32x16& p1, float& m_reg, float& mn, float& alpha) {
  constexpr float C = SCALE * 1.4426950408889634f;
  float pmax = p0[0]; for (int r = 1; r < 16; ++r) pmax = fmaxf(pmax, p0[r]); for (int r = 0; r < 16; ++r) pmax = fmaxf(pmax, p1[r]);
  { auto rr = __builtin_amdgcn_permlane32_swap(__float_as_uint(pmax), __float_as_uint(pmax), false, false);
    pmax = fmaxf(__uint_as_float(rr[0]), __uint_as_float(rr[1])); }
  if (__builtin_expect(__all(pmax - m_reg <= THR / SCALE), 1)) { mn = m_reg; alpha = 1.f; }
  else { mn = fmaxf(m_reg, pmax); alpha = __builtin_amdgcn_exp2f((m_reg - mn) * C); m_reg = mn; }
  float mnC = -mn * C;
  for (int r = 0; r < 16; ++r) p0[r] = fmaf(p0[r], C, mnC); for (int r = 0; r < 16; ++r) p1[r] = fmaf(p1[r], C, mnC);
  for (int r = 0; r < 16; ++r) p0[r] = __builtin_amdgcn_exp2f(p0[r]);
}
__device__ __forceinline__ void finishSM(f32x16& p0, f32x16& p1, float alpha, float& l_reg, bf16x8& pa0, bf16x8& pa1, bf16x8& pa2, bf16x8& pa3) {
  for (int r = 0; r < 16; ++r) p1[r] = __builtin_amdgcn_exp2f(p1[r]);
  float ps = 0; for (int r = 0; r < 16; ++r) ps += p0[r]; for (int r = 0; r < 16; ++r) ps += p1[r];
  { auto rr = __builtin_amdgcn_permlane32_swap(__float_as_uint(ps), __float_as_uint(ps), false, false);
    ps = __uint_as_float(rr[0]) + __uint_as_float(rr[1]); }
  l_reg = l_reg * alpha + ps;
#define PK4(P, BASE, OUT) do { unsigned a0 = cvtpk(P[BASE + 0], P[BASE + 1]), a1 = cvtpk(P[BASE + 2], P[BASE + 3]);   \
    unsigned b0 = cvtpk(P[BASE + 4], P[BASE + 5]), b1 = cvtpk(P[BASE + 6], P[BASE + 7]);                              \
    auto r0 = __builtin_amdgcn_permlane32_swap(a0, b0, false, false); auto r1 = __builtin_amdgcn_permlane32_swap(a1, b1, false, false); \
    u32x4 w = {r0[0], r1[0], r0[1], r1[1]}; OUT = *reinterpret_cast<bf16x8*>(&w); } while (0)
  PK4(p0, 0, pa0); PK4(p0, 8, pa1); PK4(p1, 0, pa2); PK4(p1, 8, pa3);
#undef PK4
}
__device__ __forceinline__ void qkt(f32x16& p0, f32x16& p1, const bf16_t* Ks, const bf16x8* qr, int r32, int hi) {
  p0 = f32x16{}; p1 = f32x16{};
  for (int d0 = 0; d0 < 8; ++d0) { int cb = (d0 * 16 + hi * 8) * 2;
    bf16x8 b0 = *reinterpret_cast<const bf16x8*>((const char*)Ks + KSWZ(r32, cb));
    bf16x8 b1 = *reinterpret_cast<const bf16x8*>((const char*)Ks + KSWZ(32 + r32, cb));
    p0 = __builtin_amdgcn_mfma_f32_32x32x16_bf16(b0, qr[d0], p0, 0, 0, 0);
    p1 = __builtin_amdgcn_mfma_f32_32x32x16_bf16(b1, qr[d0], p1, 0, 0, 0); }
}
__device__ __forceinline__ int v_st(int k, int c) { const int kk = (k & ~0xC) | ((k & 4) << 1) | ((k & 8) >> 1); return ((kk >> 3) * 4 + (c >> 5)) * 512 + ((kk & 7) * 32 + (c & 31)) * 2; }
__device__ __forceinline__ int v_rd_base(int lane) { return ((lane & 3) << 3) | (((lane >> 2) & 3) << 6) | (((lane >> 4) & 1) << 5) | (((lane >> 5) & 1) << 8); }
constexpr int v_rd_off(int d0, int ks, int half) { return d0 * 512 + ks * 4096 + half * 2048; }
template <int OFF> __device__ __forceinline__ s16x4 tr_read(int vb) {
  s16x4 r; asm volatile("ds_read_b64_tr_b16 %0, %1 offset:%2" : "=&v"(r) : "v"(vb), "i"(OFF) : "memory"); return r;
}
template <int D0> __device__ __forceinline__ void pv_one(f32x16& od, int vb, bf16x8 pa0, bf16x8 pa1, bf16x8 pa2, bf16x8 pa3) {
  const s16x4 l0 = tr_read<v_rd_off(D0, 0, 0)>(vb), h0 = tr_read<v_rd_off(D0, 0, 1)>(vb), l1 = tr_read<v_rd_off(D0, 1, 0)>(vb), h1 = tr_read<v_rd_off(D0, 1, 1)>(vb);
  const s16x4 l2 = tr_read<v_rd_off(D0, 2, 0)>(vb), h2 = tr_read<v_rd_off(D0, 2, 1)>(vb), l3 = tr_read<v_rd_off(D0, 3, 0)>(vb), h3 = tr_read<v_rd_off(D0, 3, 1)>(vb);
  asm volatile("s_waitcnt lgkmcnt(0)" ::: "memory"); SBAR();
#define PK(L, H) (bf16x8){L[0], L[1], L[2], L[3], H[0], H[1], H[2], H[3]}
  od = __builtin_amdgcn_mfma_f32_32x32x16_bf16(pa0, PK(l0, h0), od, 0, 0, 0);
  od = __builtin_amdgcn_mfma_f32_32x32x16_bf16(pa1, PK(l1, h1), od, 0, 0, 0);
  od = __builtin_amdgcn_mfma_f32_32x32x16_bf16(pa2, PK(l2, h2), od, 0, 0, 0);
  od = __builtin_amdgcn_mfma_f32_32x32x16_bf16(pa3, PK(l3, h3), od, 0, 0, 0);
#undef PK
}
__device__ __forceinline__ void pv_d0(f32x16* o, int vb, bf16x8 pa0, bf16x8 pa1, bf16x8 pa2, bf16x8 pa3) {
  pv_one<0>(o[0], vb, pa0, pa1, pa2, pa3); pv_one<1>(o[1], vb, pa0, pa1, pa2, pa3); pv_one<2>(o[2], vb, pa0, pa1, pa2, pa3); pv_one<3>(o[3], vb, pa0, pa1, pa2, pa3);
}
__device__ __forceinline__ void attn_dense_body(const bf16_t* __restrict__ Qb, const bf16_t* __restrict__ Kh, const bf16_t* __restrict__ Vh, bf16_t* __restrict__ Ob, int seq, char* lds) {
  const int tid = opaque_tid(), wid = tid >> 6, lane = tid & 63, r32 = lane & 31, hi = lane >> 5;
  bf16_t* V_lds = (bf16_t*)lds; bf16_t* K_lds = (bf16_t*)(lds + 2 * SHM_V);
  float* ws = (float*)(lds + 2 * SHM_V + 2 * SHM_K) + wid * 64; float* li_l = ws; float* al_l = ws + 32;
  float m_reg = -1e30f, l_reg = 0; f32x16 o[4] = {}; bf16x8 qr[8];
  const bf16_t* Qw = Qb + (long)(wid * QBLK + r32) * LDQ + hi * 8;
#pragma unroll
  for (int d0 = 0; d0 < 8; ++d0) qr[d0] = *reinterpret_cast<const bf16x8*>(Qw + d0 * 16);
  const int sr = tid >> 4, sc = (tid & 15) * 8, vst0 = v_st(sr, sc), vst1 = v_st(32 + sr, sc);
  const int vb0 = (int)(uintptr_t)V_lds + v_rd_base(lane);
  struct { bf16x8 vs0, vs1, ks0, ks1; } sr_[2];
#define SLOAD(i, k0) do { sr_[i].vs0 = *reinterpret_cast<const bf16x8*>(&Vh[(long)((k0) + sr) * LDK + sc]); sr_[i].vs1 = *reinterpret_cast<const bf16x8*>(&Vh[(long)((k0) + 32 + sr) * LDK + sc]); \
    sr_[i].ks0 = *reinterpret_cast<const bf16x8*>(&Kh[(long)((k0) + sr) * LDK + sc]); sr_[i].ks1 = *reinterpret_cast<const bf16x8*>(&Kh[(long)((k0) + 32 + sr) * LDK + sc]); } while (0)
#define SWRITE(b, i) do { *(bf16x8*)((char*)V_lds + (b) * SHM_V + vst0) = sr_[i].vs0;          \
    *(bf16x8*)((char*)V_lds + (b) * SHM_V + vst1) = sr_[i].vs1; int kc = sc * 2;               \
    *(bf16x8*)((char*)K_lds + (b) * SHM_K + KSWZ(sr, kc)) = sr_[i].ks0;                       \
    *(bf16x8*)((char*)K_lds + (b) * SHM_K + KSWZ(32 + sr, kc)) = sr_[i].ks1; } while (0)
#define SWAIT() asm volatile("s_waitcnt vmcnt(4)" ::: "memory")
#define RESC(a) do { if (__any((a) < 1.f)) { if (hi == 0) al_l[r32] = (a); asm volatile("s_waitcnt lgkmcnt(0)" ::: "memory"); \
    for (int d = 0; d < 4; ++d) for (int r = 0; r < 16; ++r) o[d][r] *= al_l[crow(r, hi)]; } } while (0)
  f32x16 pA0, pA1, pB0, pB1; float mnA, mnB, alA, alB; bf16x8 pa0, pa1, pa2, pa3; const int NT = seq / KVBLK;
  constexpr int SE = 0, SO = 1;
  SLOAD(SE, 0); asm volatile("s_waitcnt vmcnt(0)" ::: "memory"); SWRITE(0, SE); __syncthreads();
  qkt(pA0, pA1, K_lds, qr, r32, hi); partialSM(pA0, pA1, m_reg, mnA, alA);
  SLOAD(SO, KVBLK); if (2 < NT) SLOAD(SE, 2 * KVBLK);
  SWAIT(); SWRITE(1, SO); __syncthreads();
  for (int j = 1; j + 1 < NT; j += 2) {
    SBAR(); qkt(pB0, pB1, (bf16_t*)((char*)K_lds + SHM_K), qr, r32, hi);
    finishSM(pA0, pA1, alA, l_reg, pa0, pa1, pa2, pa3); SBAR();
    SLOAD(SO, (j + 2) * KVBLK); SBAR();
    pv_d0(o, vb0, pa0, pa1, pa2, pa3); partialSM(pB0, pB1, m_reg, mnB, alB);
    __syncthreads(); SWAIT(); SWRITE(0, SE);
    RESC(alB); __syncthreads();
    SBAR(); qkt(pA0, pA1, K_lds, qr, r32, hi);
    finishSM(pB0, pB1, alB, l_reg, pa0, pa1, pa2, pa3); SBAR();
    if (j + 3 < NT) SLOAD(SE, (j + 3) * KVBLK); SBAR();
    pv_d0(o, vb0 + (int)SHM_V, pa0, pa1, pa2, pa3); partialSM(pA0, pA1, m_reg, mnA, alA);
    __syncthreads(); SWAIT(); SWRITE(1, SO);
    RESC(alA); __syncthreads();
  }
  SBAR(); qkt(pB0, pB1, (bf16_t*)((char*)K_lds + SHM_K), qr, r32, hi);
  finishSM(pA0, pA1, alA, l_reg, pa0, pa1, pa2, pa3); SBAR();
  pv_d0(o, vb0, pa0, pa1, pa2, pa3); partialSM(pB0, pB1, m_reg, mnB, alB);
  __syncthreads(); RESC(alB);
  finishSM(pB0, pB1, alB, l_reg, pa0, pa1, pa2, pa3); SBAR();
  pv_d0(o, vb0 + (int)SHM_V, pa0, pa1, pa2, pa3);
  if (hi == 0) li_l[r32] = l_reg; asm volatile("s_waitcnt lgkmcnt(0)" ::: "memory");
  float rli[16];
#pragma unroll
  for (int r = 0; r < 16; ++r) rli[r] = __builtin_amdgcn_rcpf(li_l[crow(r, hi)]);
  bf16_t* Ow = Ob + (long)(wid * QBLK) * LDO;
#pragma unroll
  for (int r = 0; r < 16; ++r) { int orow = crow(r, hi);
    for (int d0 = 0; d0 < 4; ++d0) Ow[(long)orow * LDO + d0 * 32 + r32] = (bf16_t)f2bf(o[d0][r] * rli[r]); }
  __syncthreads();
#undef SLOAD
#undef SWRITE
#undef SWAIT
#undef RESC
}
#else
inline void attn_dense_body(const bf16_t* Qb, const bf16_t* Kh, const bf16_t* Vh, bf16_t* Ob, int seq, char*) {
  const int tid = threadIdx.x; if (tid >= 256) return;
  const bf16_t* q = Qb + (long)tid * LDQ; std::vector<float> sc(seq); float mx = -1e30f;
  for (int k = 0; k < seq; ++k) { float s = 0; for (int d = 0; d < HD; ++d) s += bf2f(q[d]) * bf2f(Kh[(long)k * LDK + d]); sc[k] = s * SCALE; mx = fmaxf(mx, sc[k]); }
  float l = 0; for (int k = 0; k < seq; ++k) { sc[k] = expf(sc[k] - mx); l += sc[k]; }
  for (int d = 0; d < HD; ++d) { float o = 0; for (int k = 0; k < seq; ++k) o += sc[k] * bf2f(Vh[(long)k * LDK + d]); Ob[(long)tid * LDO + d] = (bf16_t)f2bf(o / l); }
}
#endif
}
DEV void phase_attn(const Params& P, const Ctx& C, bool need_ctx) {
    constexpr int QBL = TL / 256, QBC = TC / 256, NUL = NB * AH * QBL;
    const int nu = NUL + (need_ctx ? NB * AH * QBC : 0);
    for (int u = C.bid; u < nu; u += C.nblk) {
        const bool lat = u < NUL; const int v = lat ? u : u - NUL, nqb = lat ? QBL : QBC;
        const int qb = v % nqb, h = (v / nqb) % AH, b = v / (nqb * AH), kvh = h / (AH / AKV);
        const int row0 = lat ? lat_row(b, qb * 256) : ctx_row(b, qb * 256);
        const bf16_t* Kh = WSP(bf16_t, WS_KCAT) + (size_t)b * TT * KV_W + kvh * HD; const bf16_t* Vh = WSP(bf16_t, WS_VCAT) + (size_t)b * TT * KV_W + kvh * HD;
        att::attn_dense_body(WSP(bf16_t, WS_QA) + (size_t)row0 * ATT_W + h * HD, Kh, Vh, WSP(bf16_t, WS_Y) + (size_t)row0 * BW + h * HD, lat ? TT : TC, (char*)C.lds);
    }
}

constexpr size_t SM2_PE = 0;
constexpr int CW_PE = 2048, CW_NPAN = 2047;
static_assert(CW_PE + MOE_PANELS <= CW_BAR, "panel table fits below the barrier words");
DEV void phase_moe_gather(const Params& P, const Ctx& C) {
    const unsigned* cnt = WSP(unsigned, WS_CTL) + CW_CNT;
    int poff[NE + 1]; poff[0] = 0;
#pragma unroll
    for (int e = 0; e < NE; ++e) poff[e + 1] = poff[e] + (int)((cnt[e] + 255u) / 256u) * 256;
    if (C.bid == 0 && C.tid < MOE_PANELS) { int e = -1;
#pragma unroll
        for (int q = 0; q < NE; ++q) if (C.tid * 256 >= poff[q] && C.tid * 256 < poff[q + 1]) e = q;
        WSP(int, WS_CTL)[CW_PE + C.tid] = e < 0 ? 0 : e; if (C.tid == 0) WSP(int, WS_CTL)[CW_NPAN] = poff[NE] / 256; }
    const int* te = WSP(int, WS_SMALL + SM_TE); const float* tw = WSP(float, WS_SMALL + SM_TW); const int* tp = WSP(int, WS_SMALL + SM_TP);
    for (int i = C.gw; i < MLAT * 2; i += C.ngw) {
        const int tok = i >> 1, k = i & 1, e = te[i]; int base = 0;
#pragma unroll
        for (int q = 0; q < NE; ++q) if (q == e) base = poff[q];
        const int r = base + tp[i];
        const u32x4* src = (const u32x4*)(WSP(bf16_t, WS_H) + (size_t)tok * D); u32x4* dst = (u32x4*)(WSP(bf16_t, WS_APERM) + (size_t)r * D);
        for (int q = C.lane; q < D / 8; q += 64) dst[q] = src[q];
        if (C.lane == 0) { WSP(int, WS_SMALL + SM_RTOK)[r] = tok; WSP(float, WS_SMALL + SM_RW)[r] = tw[i]; WSP(int, WS_SMALL + SM_RSLOT)[r] = k; }
    }
}
DEV void phase_moe_combine(const Params& P, const Ctx& C, int l) {
    const int gt = C.bid * NTHREADS + C.tid, ngt = C.nblk * NTHREADS;
    const float* ys = WSP(float, WS_YS);
    for (int i = gt; i < MLAT * (D / 4); i += ngt) {
        const int row = i / (D / 4), col = (i % (D / 4)) * 4;
        const f32x4 g = *(const f32x4*)(mod_vec(P, l, row_vec(row), 5) + col);
        *(f32x4*)(P.out + (size_t)row * D + col) = *(const f32x4*)(WSP(float, WS_X1) + (size_t)row * D + col) + g * (*(const f32x4*)(ys + (size_t)row * D + col) + *(const f32x4*)(ys + ((size_t)MLAT + row) * D + col));
    }
}

#ifndef HOST_EMU
#define LAS __attribute__((address_space(3)))
#define XB_TMO      128
#define XB_XCNT(j)  (256  + 64 * (j))
#define XB_XSUB(j)  (1280 + 64 * (j))
#define XB_XGEN(j)  (2304 + 64 * (j))
#define XB_TOP      3328
#define XB_TOPGEN   3392
#define XCD_BAR_WORDS 3456
#define XB_SPIN_CAP (1u << 18)
__device__ __forceinline__ unsigned xb_ld(unsigned* p)              { return __hip_atomic_load(p, __ATOMIC_RELAXED, __HIP_MEMORY_SCOPE_AGENT); }
__device__ __forceinline__ unsigned xb_add(unsigned* p, unsigned v) { return __hip_atomic_fetch_add(p, v, __ATOMIC_RELAXED, __HIP_MEMORY_SCOPE_AGENT); }
__device__ __forceinline__ unsigned xb_xcc_id() { return (unsigned)__builtin_amdgcn_s_getreg((3 << 11) | 20) & 0xFu; }
#define XB_SPIN(cond, bar) do { unsigned _sp = 0; while (cond) { __builtin_amdgcn_s_sleep(1); \
    if ((++_sp & 255u) == 0u) { if (xb_ld(&(bar)[XB_TMO])) break; if (_sp > XB_SPIN_CAP) { atomicAdd(&(bar)[XB_TMO], 1u); break; } } } } while (0)
struct XcdBarrier { unsigned* bar; unsigned x; volatile LAS unsigned* st; };
__device__ __forceinline__ XcdBarrier xcd_barrier_post(unsigned* bar, volatile LAS unsigned* st) {
    XcdBarrier b; b.bar = bar; b.x = xb_xcc_id(); b.st = st;
    if (threadIdx.x == 0) (void)xb_add(&bar[XB_XCNT(b.x)], 1u);
    return b;
}
__device__ __forceinline__ void xcd_barrier_complete(unsigned* bar, unsigned x, unsigned& nloc, unsigned& nx) {
    const unsigned G = gridDim.x * gridDim.y * gridDim.z;
    unsigned sum, cnt, mine, sp = 0u;
    for (;;) {
        sum = 0u; cnt = 0u; mine = 0u;
#pragma unroll
        for (unsigned j = 0; j < 16; ++j) { const unsigned c = xb_ld(&bar[XB_XCNT(j)]); sum += c; cnt += (c > 0u) ? 1u : 0u; mine = (j == x) ? c : mine; }
        if (sum == G) break;
        __builtin_amdgcn_s_sleep(1);
        if ((++sp & 255u) == 0u) { if (xb_ld(&bar[XB_TMO])) break; if (sp > XB_SPIN_CAP) { atomicAdd(&bar[XB_TMO], 1u); break; } }
    }
    nloc = mine > 0u ? mine : 1u; nx = cnt > 0u ? cnt : 1u;
}
__device__ __forceinline__ void xcd_barrier(const XcdBarrier& b) {
    asm volatile("s_waitcnt vmcnt(0)" ::: "memory");
    __syncthreads();
    if (threadIdx.x == 0) {
        unsigned* bar = b.bar;
        __builtin_amdgcn_s_waitcnt(0);
        unsigned nloc = b.st[0], nx = b.st[1];
        if (nloc == 0u) { xcd_barrier_complete(bar, b.x, nloc, nx); b.st[0] = nloc; b.st[1] = nx; }
        const unsigned old = xb_add(&bar[XB_XSUB(b.x)], 1u);
        const unsigned gen = old / nloc;
        if (old + 1u == (gen + 1u) * nloc) {
            __builtin_amdgcn_fence(__ATOMIC_RELEASE, "agent");
            asm volatile("s_waitcnt vmcnt(0)" ::: "memory");
            const unsigned og = xb_add(&bar[XB_TOP], 1u);
            const unsigned tg = og / nx;
            if (og + 1u == (tg + 1u) * nx) xb_add(&bar[XB_TOPGEN], 1u);
            else XB_SPIN(xb_ld(&bar[XB_TOPGEN]) == tg, bar);
            __builtin_amdgcn_fence(__ATOMIC_ACQUIRE, "agent");
            xb_add(&bar[XB_XGEN(b.x)], 1u);
            asm volatile("s_waitcnt vmcnt(0)" ::: "memory");
        } else {
            XB_SPIN(xb_ld(&bar[XB_XGEN(b.x)]) == gen, bar);
            __builtin_amdgcn_fence(__ATOMIC_ACQUIRE, "agent");
            asm volatile("s_waitcnt vmcnt(0)" ::: "memory");
        }
    }
    __syncthreads();
}
#define GEMM_LDS(C) ((PG8_LAS unsigned char*)(C).lds)
#else
struct XcdBarrier { int dummy; };
inline void xcd_barrier(const XcdBarrier&) {}
#define GEMM_LDS(C) ((C).lds)
#endif

constexpr int NPL = 13, NPHASES = 2 + DEPTH * NPL;
#ifndef PROBE_MASK
#define PROBE_MASK 0
#endif
#define REPS(g) (1 + ((PROBE_MASK >> (g)) & 1))
#define REP_BEGIN(g) _Pragma("unroll 1") for (int rep_ = 0; rep_ < REPS(g); ++rep_) {
#define REP_END(g) if (rep_ + 1 < REPS(g)) xcd_barrier(bar); }
DEV void run_phases(const Params& P, unsigned char* ldsp, const int lo, const int hi, const XcdBarrier& bar) {
#define C make_ctx(ldsp)
#define IN(k) (lo <= (k) && (k) < hi)
#define SEAM(k) do { if (IN(k) && IN((k) + 1)) xcd_barrier(bar); } while (0)
    if (IN(0)) { REP_BEGIN(0) phase_weights(P, C); phase_mod_partial(P, C); REP_END(0) }
    SEAM(0);
    if (IN(1)) phase_mod_final(P, C);
    SEAM(1);
    for (int l = 0; l < DEPTH; ++l) {
        const int pb = 2 + l * NPL; const bool need_ctx = l < DEPTH - 1, moe = (l & 1) != 0;
        const int rows = need_ctx ? MT : MLAT;
        if (IN(pb + 0)) { REP_BEGIN(1) phase_hpass(P, C, l, 0, false); REP_END(1) }
        SEAM(pb + 0);
        if (IN(pb + 1)) { REP_BEGIN(2)
            pg8::Gemm g{WSP(bf16_t, WS_H), WSP(bf16_t, WS_WIN) + (size_t)l * NP * D, D};
            pg8::PanelOrder S; S.init(MT / 256, NP / 256, C.nblk, C.bid, nullptr);
            EpiInProj E{WSP(bf16_t, WS_P), WSP(float, WS_G16)};
            pg8::gemm_phase<EpiInProj, pg8::PanelOrder, true, true>(GEMM_LDS(C), g, S, E);
        REP_END(2) }
        SEAM(pb + 1);
        if (IN(pb + 2)) { REP_BEGIN(3) phase_fixup(P, C, l, need_ctx); REP_END(3) }
        SEAM(pb + 2);
        REP_BEGIN(4)
        if (IN(pb + 3)) phase_s1(P, C, l);
        SEAM(pb + 3);
        if (IN(pb + 4)) phase_s2(P, C);
        REP_END(4)
        SEAM(pb + 4);
        if (IN(pb + 5)) { REP_BEGIN(5) phase_attn(P, C, need_ctx); REP_END(5) REP_BEGIN(6) phase_s3(P, C, l, need_ctx); REP_END(6) }
        SEAM(pb + 5);
        if (IN(pb + 6)) { REP_BEGIN(7)
            for (int n = 0; n < 3; ++n) {
                pg8::Gemm g{WSP(bf16_t, WS_Y) + (size_t)n * MT * BW, WSP(bf16_t, WS_WBR) + (size_t)(l * 3 + n) * D * BW, BW};
                pg8::PanelOrder S; S.init(rows / 256, D / 256, C.nblk, C.bid, nullptr);
                EpiBranch E{WSP(bf16_t, WS_P), WSP(float, WS_MGF), WSP(bf16_t, WS_MG), n};
                pg8::gemm_phase<EpiBranch, pg8::PanelOrder, true, true>(GEMM_LDS(C), g, S, E);
            }
        REP_END(7) }
        SEAM(pb + 6);
        if (IN(pb + 7)) { REP_BEGIN(8)
            pg8::Gemm g{WSP(bf16_t, WS_MG), WSP(bf16_t, WS_WOUT) + (size_t)l * D * D, D};
            pg8::PanelOrder S; S.init(rows / 256, D / 256, C.nblk, C.bid, nullptr);
            const float* bL = l == 0 ? P.x : WSP(float, WS_X2); const float* bC = l == 0 ? P.ctx : WSP(float, WS_X2) + (size_t)MLAT * D;
            EpiResid E{bL, bC, WSP(float, WS_X1), WSP(float, WS_X1) + (size_t)MLAT * D, mod_vec(P, l, 0, 2), false, nullptr, nullptr, nullptr, nullptr};
            pg8::gemm_phase<EpiResid, pg8::PanelOrder, true, true>(GEMM_LDS(C), g, S, E);
        REP_END(8) }
        SEAM(pb + 7);
        if (IN(pb + 8)) phase_hpass(P, C, l, 1, moe);
        SEAM(pb + 8);
        if (IN(pb + 9)) { if (moe) phase_moe_gather(P, C); }
        SEAM(pb + 9);
        if (IN(pb + 10)) { REP_BEGIN(9)
            pg8::Gemm g{moe ? WSP(bf16_t, WS_APERM) : WSP(bf16_t, WS_H), moe ? WSP(bf16_t, WS_WMGU) + (size_t)(l / 2) * NE * 2 * DFF * D : WSP(bf16_t, WS_WGU) + (size_t)(l / 2) * 2 * DFF * D, D};
            pg8::PanelOrder S; S.init(moe ? WSP(int, WS_CTL)[CW_NPAN] : rows / 256, 2 * DFF / 256, C.nblk, C.bid, moe ? WSP(int, WS_CTL) + CW_PE : nullptr);
            EpiGU E{WSP(bf16_t, WS_ACT)};
            pg8::gemm_phase<EpiGU, pg8::PanelOrder, true, true>(GEMM_LDS(C), g, S, E);
        REP_END(9) }
        SEAM(pb + 10);
        if (IN(pb + 11)) { REP_BEGIN(10)
            pg8::Gemm g{WSP(bf16_t, WS_ACT), moe ? WSP(bf16_t, WS_WMDN) + (size_t)(l / 2) * NE * D * DFF : WSP(bf16_t, WS_WDN) + (size_t)(l / 2) * D * DFF, DFF};
            pg8::PanelOrder S; S.init(moe ? WSP(int, WS_CTL)[CW_NPAN] : rows / 256, D / 256, C.nblk, C.bid, moe ? WSP(int, WS_CTL) + CW_PE : nullptr);
            float* oL = (l == DEPTH - 1) ? P.out : WSP(float, WS_X2);
            EpiResid E{WSP(float, WS_X1), WSP(float, WS_X1) + (size_t)MLAT * D, oL, WSP(float, WS_X2) + (size_t)MLAT * D, mod_vec(P, l, 0, 5), moe,
                       WSP(int, WS_SMALL + SM_RTOK), WSP(float, WS_SMALL + SM_RW), WSP(int, WS_SMALL + SM_RSLOT), WSP(float, WS_YS)};
            pg8::gemm_phase<EpiResid, pg8::PanelOrder, true, true>(GEMM_LDS(C), g, S, E);
        REP_END(10) }
        SEAM(pb + 11);
        if (IN(pb + 12)) { if (moe) phase_moe_combine(P, C, l); }
        if (l + 1 < DEPTH) SEAM(pb + 12);
    }
#undef IN
#undef SEAM
#undef C
}

struct Args { Params P; int ph_lo, ph_hi; };
#if !defined(HOST_EMU) && !defined(NO_MAIN_KERNEL)
constexpr int MISC_OFF = 131072 + 320;
__global__ void __launch_bounds__(NTHREADS, 2) hybrid_fwd(Args a) {
    extern __shared__ __attribute__((aligned(16))) unsigned char lds[];
    volatile LAS unsigned* MISC = (volatile LAS unsigned*)((LAS unsigned char*)lds + MISC_OFF);
    if (threadIdx.x < 32) MISC[threadIdx.x] = 0u;
    __syncthreads();
    XcdBarrier bar = xcd_barrier_post((unsigned*)(a.P.ws + WS_CTL) + CW_BAR, MISC + 8);
    run_phases(a.P, lds, a.ph_lo, a.ph_hi, bar);
}

#ifndef N_LAUNCH_MODE
#define N_LAUNCH_MODE 1
#endif
extern "C" void kernel_launch(void* const* d_in, const int* in_sizes, int n_in, void* d_out, int out_size, void* d_ws, size_t ws_size, hipStream_t stream) {
    static int grid = 0;
    if (grid == 0) {
        if (n_in != 25 || in_sizes[0] != MLAT * D || out_size != MLAT * D || ws_size < WS_END) {
            fprintf(stderr, "kernel_launch: unexpected shapes: n_in %d in0 %d out %d ws %zu (need %zu)\n", n_in, n_in > 0 ? in_sizes[0] : -1, out_size, ws_size, (size_t)WS_END); grid = -1; return; }
        int dev = 0, cus = 0, per_cu = 0;
        if (hipGetDevice(&dev) != hipSuccess || hipDeviceGetAttribute(&cus, hipDeviceAttributeMultiprocessorCount, dev) != hipSuccess) { grid = -1; return; }
        if (hipFuncSetAttribute((const void*)hybrid_fwd, hipFuncAttributeMaxDynamicSharedMemorySize, LDS_BYTES) != hipSuccess) { fprintf(stderr, "kernel_launch: hipFuncSetAttribute failed\n"); grid = -1; return; }
        if (hipOccupancyMaxActiveBlocksPerMultiprocessor(&per_cu, (const void*)hybrid_fwd, NTHREADS, LDS_BYTES) != hipSuccess || per_cu < 1) fprintf(stderr, "kernel_launch: occupancy query says %d\n", per_cu);
        (void)hipGetLastError();
        grid = cus;
    }
    if (grid < 0) return;
    (void)hipMemsetAsync((char*)d_ws + WS_CTL, 0, CTL_BYTES, stream);
    Args a{};
    const float** pp = (const float**)&a.P;
    for (int i = 0; i < 25; ++i) pp[i] = (const float*)d_in[i];
    a.P.out = (float*)d_out; a.P.ws = (unsigned char*)d_ws;
    if (N_LAUNCH_MODE == 1) { a.ph_lo = 0; a.ph_hi = NPHASES; hipLaunchKernelGGL(hybrid_fwd, dim3(grid), dim3(NTHREADS), LDS_BYTES, stream, a); }
    else for (int ph = 0; ph < NPHASES; ++ph) { a.ph_lo = ph; a.ph_hi = ph + 1; hipLaunchKernelGGL(hybrid_fwd, dim3(grid), dim3(NTHREADS), LDS_BYTES, stream, a); }
    const hipError_t le = hipPeekAtLastError();
    if (le != hipSuccess) fprintf(stderr, "kernel_launch: launch failed: %s\n", hipGetErrorName(le));
}
#endif
```

```cpp
#ifdef HOST_EMU
#include "emu.h"
#define DEV inline
#define WAVE_LDS_SYNC() emu::wave_barrier()
#define MFMA32(a, b, c) emu_mfma_32x32x16_bf16((a), (b), (c))
#define LDS_BASE() EMU_LDS_BASE()
#else
#include <hip/hip_runtime.h>
#include <cstdio>
#define DEV __device__ __forceinline__
#define WAVE_LDS_SYNC() asm volatile("s_waitcnt lgkmcnt(0)" ::: "memory")
#define MFMA32(a, b, c) __builtin_amdgcn_mfma_f32_32x32x16_bf16((a), (b), (c), 0, 0, 0)
typedef short bf16x8 __attribute__((ext_vector_type(8)));
typedef float f32x16 __attribute__((ext_vector_type(16)));
typedef float f32x4 __attribute__((ext_vector_type(4)));
#endif
typedef unsigned short bf16_t;
typedef unsigned u32x4 __attribute__((ext_vector_type(4)));
typedef unsigned u32x2 __attribute__((ext_vector_type(2)));
typedef float f32x2 __attribute__((ext_vector_type(2)));

#ifdef SMALL_CFG
constexpr int D = 512, NB = 2, TL = 256, TC = 256, AH = 4, AKV = 2, MLH = 2, HGH = 4, DFF = 768;
#else
constexpr int D = 2048, NB = 2, TL = 4096, TC = 256, AH = 8, AKV = 2, MLH = 4, HGH = 8, DFF = 5632;
#endif
constexpr int DEPTH = 2, GRIDW = 64, HD = 128, ATT_W = AH * HD, KV_W = AKV * HD, MDK = 256, MDV = 256, ML_W = MLH * MDV, HDK = 128, HDV = 128, HG_W = HGH * HDV;
constexpr int BW = ATT_W, NE = 8, CH = 64, NV = NB + 1;
constexpr float EPS = 1e-6f;
#ifndef I8_INPROJ
#define I8_INPROJ 1
#endif
#ifndef I8_FFNUP
#define I8_FFNUP 1
#endif
constexpr int MLAT = NB * TL, MCTX = NB * TC, MT = MLAT + MCTX, TT = TC + TL, NCH = TT / CH, NCHC = TC / CH;
constexpr int NG = 4 * MLH;
static_assert(ML_W == BW && HG_W == BW && NG <= 16 && TC % 256 == 0 && TL % 256 == 0 && D % 256 == 0 && DFF % 128 == 0, "config");
constexpr int OQ = 0, OK_ = OQ + ATT_W, OV = OK_ + KV_W, OMQ = OV + KV_W, OMK = OMQ + ML_W, OMV = OMK + ML_W, OMO = OMV + ML_W, OMG = OMO + ML_W;
constexpr int OHQ = OMG + NG, OHF = OHQ + HG_W, OHB = OHF + HG_W, OHI = OHB + HG_W, OHG = OHI + HG_W, OGATE = OHG + HG_W, N_IN = OGATE + 3 * D;
constexpr int PQ = OQ, PK = OK_, PV = OV, PMQ = OMQ, PMK = OMK, PMV = OMV, PMO = OMO, PHQ = OMG, PHF = PHQ + HG_W, PHB = PHF + HG_W, PHI = PHB + HG_W, PHG = PHI + HG_W, PGATE = PHG + HG_W;
constexpr int NPB = N_IN - NG, NP = NPB + 256;
static_assert(NPB % 256 == 0 && PGATE + 3 * D == NPB, "projection layout");
constexpr int MOE_ROWS = MLAT * 2 + NE * 256, MOE_PANELS = MOE_ROWS / 256;
constexpr int NSQM = NB * MLH * 2, NSQH = NB * HGH * 2;

constexpr size_t al256(size_t x) { return (x + 255) / 256 * 256; }
constexpr size_t WS_CTL = 0, CTL_BYTES = 1u << 20;
constexpr size_t WS_MODP = WS_CTL + CTL_BYTES;
constexpr size_t WS_MOD = WS_MODP + al256((size_t)(D / 64) * DEPTH * NV * 6 * D * 4);
constexpr size_t WS_LB = WS_MOD + al256((size_t)DEPTH * NV * 6 * D * 4);
constexpr size_t WS_WIN = WS_LB + al256((size_t)DEPTH * HG_W * 4);
constexpr size_t WS_WBR = WS_WIN + al256((size_t)DEPTH * NP * D * 2);
constexpr size_t WS_WOUT = WS_WBR + al256((size_t)DEPTH * 3 * D * BW * 2);
constexpr size_t WS_WGU = WS_WOUT + al256((size_t)DEPTH * D * D * 2);
constexpr size_t WS_WDN = WS_WGU + al256((size_t)2 * DFF * D * 2);
constexpr size_t WS_WMGU = WS_WDN + al256((size_t)D * DFF * 2);
constexpr size_t WS_WMDN = WS_WMGU + al256((size_t)NE * 2 * DFF * D * 2);
constexpr size_t WS_H = WS_WMDN + al256((size_t)NE * D * DFF * 2);
constexpr size_t WS_G16 = WS_H + al256((size_t)MT * D * 2);
constexpr size_t WS_QA = WS_G16 + al256((size_t)MT * 16 * 4);
constexpr size_t WS_KCAT = WS_QA + al256((size_t)MT * ATT_W * 2);
constexpr size_t WS_VCAT = WS_KCAT + al256((size_t)NB * TT * KV_W * 2);
constexpr size_t WS_QM = WS_VCAT + al256((size_t)NB * TT * KV_W * 2);
constexpr size_t WS_KM = WS_QM + al256((size_t)MT * ML_W * 2);
constexpr size_t WS_Y = WS_KM + al256((size_t)MT * ML_W * 2);
constexpr size_t WS_MGF = WS_Y + al256((size_t)3 * MT * BW * 2);
constexpr size_t WS_MG = WS_MGF + al256((size_t)MT * D * 4);
constexpr size_t WS_X1 = WS_MG + al256((size_t)MT * D * 2);
constexpr size_t WS_X2 = WS_X1 + al256((size_t)MT * D * 4);
constexpr size_t WS_SMALL = WS_X2 + al256((size_t)MT * D * 4);
constexpr size_t SM_FL = 0;
constexpr size_t SM_MLOC = SM_FL + al256((size_t)NSQM * NCH * 4);
constexpr size_t SM_MST = SM_MLOC + al256((size_t)NSQM * NCH * 4);
constexpr size_t SM_NLOC = SM_MST + al256((size_t)NSQM * NCH * 4);
constexpr size_t SM_LAM = SM_NLOC + al256((size_t)NSQM * NCH * MDK * 4);
constexpr size_t SM_TE = SM_LAM + al256((size_t)NSQH * NCH * HDK * 4);
constexpr size_t SM_TW = SM_TE + al256((size_t)MLAT * 2 * 4);
constexpr size_t SM_TP = SM_TW + al256((size_t)MLAT * 2 * 4);
constexpr size_t SM_RTOK = SM_TP + al256((size_t)MLAT * 2 * 4);
constexpr size_t SM_RW = SM_RTOK + al256((size_t)MOE_ROWS * 4);
constexpr size_t SM_RSLOT = SM_RW + al256((size_t)MOE_ROWS * 4);
constexpr size_t SM_ASC = SM_RSLOT + al256((size_t)MOE_ROWS * 4);
constexpr size_t SM_RASC = SM_ASC + al256((size_t)MT * 4);
constexpr size_t SM_WSIN = SM_RASC + al256((size_t)MOE_ROWS * 4);
constexpr size_t SM_WSGU = SM_WSIN + al256((size_t)DEPTH * NP * 4);
constexpr size_t SM_WSMGU = SM_WSGU + al256((size_t)2 * DFF * 4);
constexpr size_t SM_END = SM_WSMGU + al256((size_t)NE * 2 * DFF * 4);
constexpr size_t WS_BIG = WS_SMALL + SM_END;
constexpr size_t WS_P = WS_BIG;
constexpr size_t WS_ACT = WS_BIG;
constexpr size_t WS_APERM = WS_ACT + al256((size_t)MOE_ROWS * DFF * 2);
constexpr size_t BIG_BYTES = al256((size_t)MT * NPB * 2) > al256((size_t)MOE_ROWS * DFF * 2) + al256((size_t)MOE_ROWS * D * 2) ? al256((size_t)MT * NPB * 2) : al256((size_t)MOE_ROWS * DFF * 2) + al256((size_t)MOE_ROWS * D * 2);
constexpr size_t WS_ST = WS_BIG + BIG_BYTES;
constexpr size_t WS_CSTM = WS_ST;
constexpr size_t WS_CSTH = WS_CSTM + al256((size_t)NSQM * NCH * MDV * MDK * 2);
constexpr size_t WS_YS = WS_ST;
constexpr size_t ST_BYTES = al256((size_t)NSQM * NCH * MDV * MDK * 2) + al256((size_t)NSQH * NCH * HDV * HDK * 2) > al256((size_t)2 * MLAT * D * 4) ? al256((size_t)NSQM * NCH * MDV * MDK * 2) + al256((size_t)NSQH * NCH * HDV * HDK * 2) : al256((size_t)2 * MLAT * D * 4);
constexpr size_t WS_END = WS_ST + ST_BYTES;
constexpr int CW_BAR = 4096;
constexpr int CW_CNT = 1024;

constexpr int NTHREADS = 512, NWAVES = 8;
constexpr int LDS_BYTES = 147456;

struct Params {
    const float *x, *c, *ctx, *c_ctx, *w_mod, *b_mod, *norm1_g, *norm2_g, *w_in, *qn_g, *kn_g, *conv_w, *gate_b, *ml_norm_g, *lb_logits, *hg_norm_g,
        *w_branch, *w_out, *ffn_wg, *ffn_wu, *ffn_wd, *moe_wr, *moe_wg, *moe_wu, *moe_wd;
    float* out; unsigned char* ws;
};

DEV unsigned fbits(float f) { return __builtin_bit_cast(unsigned, f); }
DEV float bitsf(unsigned u) { return __builtin_bit_cast(float, u); }
DEV float bf2f(bf16_t h) { return bitsf(((unsigned)h) << 16); }
DEV unsigned f2bf(float f) { const unsigned u = fbits(f); return (u + 0x7fffu + ((u >> 16) & 1u)) >> 16; }
DEV unsigned pk2(float lo, float hi) { return f2bf(lo) | (f2bf(hi) << 16); }
DEV unsigned q8(float x) { const float r = fminf(fmaxf(rintf(x), -127.0f), 127.0f); return (unsigned)(int)r & 0xffu; }
DEV unsigned pk4_i8(float a, float b, float c, float d) { return q8(a) | (q8(b) << 8) | (q8(c) << 16) | (q8(d) << 24); }
#ifdef HOST_EMU
DEV float fexp(float x) { return expf(x); }
#else
DEV float fexp(float x) { return __builtin_amdgcn_exp2f(x * 1.4426950408889634f); }
#endif
#ifdef HOST_EMU
DEV float sigmoidf_(float x) { return 1.0f / (1.0f + expf(-x)); }
DEV float flog(float x) { return logf(x); }
#else
DEV float sigmoidf_(float x) { return __builtin_amdgcn_rcpf(1.0f + __builtin_amdgcn_exp2f(x * -1.4426950408889634f)); }
DEV float flog(float x) { return __builtin_amdgcn_logf(x) * 0.6931471805599453f; }
#endif
DEV float siluf_(float x) { return x * sigmoidf_(x); }
DEV float logsigmoidf_(float x) { return fminf(x, 0.f) - log1pf(expf(-fabsf(x))); }
DEV float wave_sum(float v) {
#pragma unroll
    for (int o = 1; o < 64; o <<= 1) v += __shfl_xor(v, o);
    return v;
}
DEV int crow(int r, int hi) { return (r & 3) + 8 * (r >> 2) + 4 * hi; }
#ifdef HOST_EMU
typedef s16x4_emu s16x4;
DEV void tr_issue(s16x4& lo, s16x4& hi4, const bf16_t* X, int px, int k0, int n0, int lane) {
    const bf16_t* a = X + (size_t)(k0 + 8 * (lane >> 5) + ((lane & 15) >> 2)) * px + n0 + 16 * ((lane >> 4) & 1) + 4 * (lane & 3);
    lo = emu_tr_read(a); hi4 = emu_tr_read(a + 4 * px);
}
#define TR_WAIT2(a, b) do {} while (0)
#define TR_WAIT4(a, b, c, d) do {} while (0)
#define TR_WAIT8(a, b, c, d, e, f, g, h) do {} while (0)
#else
typedef short s16x4 __attribute__((ext_vector_type(4)));
DEV void tr_issue(s16x4& lo, s16x4& hi4, const bf16_t* X, int px, int k0, int n0, int lane) {
    const bf16_t* a = X + (size_t)(k0 + 8 * (lane >> 5) + ((lane & 15) >> 2)) * px + n0 + 16 * ((lane >> 4) & 1) + 4 * (lane & 3);
    const unsigned a0 = (unsigned)(uintptr_t)a, a1 = (unsigned)(uintptr_t)(a + 4 * px);
    asm volatile("ds_read_b64_tr_b16 %0, %1" : "=&v"(lo) : "v"(a0) : "memory");
    asm volatile("ds_read_b64_tr_b16 %0, %1" : "=&v"(hi4) : "v"(a1) : "memory");
}
#define TR_WAIT2(a, b) asm volatile("s_waitcnt lgkmcnt(0)" : "+v"(a), "+v"(b) :: "memory")
#define TR_WAIT4(a, b, c, d) asm volatile("s_waitcnt lgkmcnt(0)" : "+v"(a), "+v"(b), "+v"(c), "+v"(d) :: "memory")
#define TR_WAIT8(a, b, c, d, e, f, g, h) asm volatile("s_waitcnt lgkmcnt(0)" : "+v"(a), "+v"(b), "+v"(c), "+v"(d), "+v"(e), "+v"(f), "+v"(g), "+v"(h) :: "memory")
#endif
#define TR_PK(L, H) ((bf16x8){(L)[0], (L)[1], (L)[2], (L)[3], (H)[0], (H)[1], (H)[2], (H)[3]})
DEV float wave_max(float v) {
#pragma unroll
    for (int o = 1; o < 64; o <<= 1) v = fmaxf(v, __shfl_xor(v, o));
    return v;
}
DEV float wave_scan_add(float v, int lane) {
#pragma unroll
    for (int o = 1; o < 64; o <<= 1) { const float t = __shfl(v, (lane - o) & 63); if (lane >= o) v += t; }
    return v;
}
DEV float wave_scan_max(float v, int lane) {
#pragma unroll
    for (int o = 1; o < 64; o <<= 1) { const float t = __shfl(v, (lane - o) & 63); if (lane >= o) v = fmaxf(v, t); }
    return v;
}
DEV void unpack8(const u32x4 w, float (&f)[8]) {
    f[0] = bitsf(w.x << 16); f[1] = bitsf(w.x & 0xffff0000u); f[2] = bitsf(w.y << 16); f[3] = bitsf(w.y & 0xffff0000u);
    f[4] = bitsf(w.z << 16); f[5] = bitsf(w.z & 0xffff0000u); f[6] = bitsf(w.w << 16); f[7] = bitsf(w.w & 0xffff0000u);
}
DEV u32x4 pack8(const float (&f)[8]) { u32x4 w; w.x = pk2(f[0], f[1]); w.y = pk2(f[2], f[3]); w.z = pk2(f[4], f[5]); w.w = pk2(f[6], f[7]); return w; }
DEV int lat_row(int b, int t) { return b * TL + t; }
DEV int ctx_row(int b, int t) { return MLAT + b * TC + t; }
DEV int seq_row(int b, int d, int p) {
    if (p < TC) return ctx_row(b, d ? TC - 1 - p : p);
    const int t = p - TC; return lat_row(b, d ? TL - 1 - t : t);
}
DEV int dir_chunk(int cc, int d) { if (!d) return cc; return cc < NCHC ? NCHC - 1 - cc : NCH - 1 - (cc - NCHC); }
DEV int chunk_row0(int b, int cc) { return cc < NCHC ? ctx_row(b, cc * CH) : lat_row(b, (cc - NCHC) * CH); }
DEV int row_vec(int row) { return row < MLAT ? row / TL : NB; }

#ifdef HOST_EMU
DEV int opaque_tid() { return threadIdx.x; }
#else
DEV int opaque_tid() { int t = threadIdx.x; asm volatile("" : "+v"(t)); return t; }
#endif
struct Ctx {
    int tid, lane, wave, gw, ngw, bid, nblk; unsigned char* lds;
};
DEV Ctx make_ctx(unsigned char* lds) {
    Ctx c; c.tid = opaque_tid(); c.lane = c.tid & 63; c.wave = c.tid >> 6; c.bid = blockIdx.x; c.nblk = gridDim.x; c.gw = c.bid * NWAVES + c.wave; c.ngw = c.nblk * NWAVES; c.lds = lds; return c;
}
#define WSP(T, off) ((T*)(P.ws + (off)))

struct Job { const float* src; int K, ld, c0, nc; bf16_t* dst; int r0, mode, i8, ncv; float* wsc; };
constexpr int NJOBS = DEPTH * 6 + 3 + NE * 3 + DEPTH;
DEV Job get_job(const Params& P, int j) {
    Job J; J.mode = 0; J.r0 = 0; J.c0 = 0; J.i8 = 0; J.ncv = 32; J.wsc = nullptr; J.src = nullptr; J.dst = nullptr; J.K = D; J.ld = D; J.nc = 0;
    if (j >= NJOBS - DEPTH) { const int l = j - (NJOBS - DEPTH); if (!I8_INPROJ) return J;
        J.src = P.w_in + (size_t)l * D * N_IN; J.ld = N_IN; J.c0 = OMG; J.nc = 32; J.ncv = NG; J.dst = WSP(bf16_t, WS_WIN) + (size_t)l * NP * D; J.r0 = NPB; J.i8 = 1; J.wsc = WSP(float, WS_SMALL + SM_WSIN) + (size_t)l * NP; return J; }
    if (j < DEPTH * 6) {
        const int l = j / 6, k = j % 6;
        if (k == 0) { J.src = P.w_in + (size_t)l * D * N_IN; J.K = D; J.ld = N_IN; J.c0 = 0; J.nc = OMG; J.dst = WSP(bf16_t, WS_WIN) + (size_t)l * NP * D; J.r0 = 0; J.i8 = I8_INPROJ; J.wsc = WSP(float, WS_SMALL + SM_WSIN) + (size_t)l * NP; }
        else if (k == 1) { J.src = P.w_in + (size_t)l * D * N_IN; J.K = D; J.ld = N_IN; J.c0 = OMG + NG; J.nc = N_IN - OMG - NG; J.dst = WSP(bf16_t, WS_WIN) + (size_t)l * NP * D; J.r0 = OMG; J.i8 = I8_INPROJ; J.wsc = WSP(float, WS_SMALL + SM_WSIN) + (size_t)l * NP; }
        else if (k < 5) { const int n = k - 2; J.src = P.w_branch + (size_t)(l * 3 + n) * BW * D; J.K = BW; J.ld = D; J.nc = D; J.dst = WSP(bf16_t, WS_WBR) + (size_t)(l * 3 + n) * D * BW; }
        else { J.src = P.w_out + (size_t)l * D * D; J.K = D; J.ld = D; J.nc = D; J.dst = WSP(bf16_t, WS_WOUT) + (size_t)l * D * D; }
        return J;
    }
    j -= DEPTH * 6;
    if (j < 3) {
        if (j == 0) { J.src = P.ffn_wg; J.K = D; J.ld = DFF; J.nc = DFF; J.dst = WSP(bf16_t, WS_WGU); J.r0 = 0; J.mode = 1; J.i8 = I8_FFNUP; J.wsc = WSP(float, WS_SMALL + SM_WSGU); }
        else if (j == 1) { J.src = P.ffn_wu; J.K = D; J.ld = DFF; J.nc = DFF; J.dst = WSP(bf16_t, WS_WGU); J.r0 = 128; J.mode = 1; J.i8 = I8_FFNUP; J.wsc = WSP(float, WS_SMALL + SM_WSGU); }
        else { J.src = P.ffn_wd; J.K = DFF; J.ld = D; J.nc = D; J.dst = WSP(bf16_t, WS_WDN); }
        return J;
    }
    j -= 3; const int e = j / 3, k = j % 3;
    if (k == 0) { J.src = P.moe_wg + (size_t)e * D * DFF; J.K = D; J.ld = DFF; J.nc = DFF; J.dst = (bf16_t*)(P.ws + WS_WMGU + (size_t)e * 2 * DFF * D * (I8_FFNUP ? 1 : 2)); J.r0 = 0; J.mode = 1; J.i8 = I8_FFNUP; J.wsc = WSP(float, WS_SMALL + SM_WSMGU) + (size_t)e * 2 * DFF; }
    else if (k == 1) { J.src = P.moe_wu + (size_t)e * D * DFF; J.K = D; J.ld = DFF; J.nc = DFF; J.dst = (bf16_t*)(P.ws + WS_WMGU + (size_t)e * 2 * DFF * D * (I8_FFNUP ? 1 : 2)); J.r0 = 128; J.mode = 1; J.i8 = I8_FFNUP; J.wsc = WSP(float, WS_SMALL + SM_WSMGU) + (size_t)e * 2 * DFF; }
    else { J.src = P.moe_wd + (size_t)e * DFF * D; J.K = DFF; J.ld = D; J.nc = D; J.dst = WSP(bf16_t, WS_WMDN) + (size_t)e * D * DFF; }
    return J;
}
DEV int job_items(const Job& J) { return J.i8 ? 0 : (J.K / 64) * (J.nc / 32); }
DEV int job_panels(const Job& J) { return J.i8 ? J.nc / 32 : 0; }
DEV void ti_load(const Job& J, int item, f32x4 (&v)[8], int lane) {
    const int nblk = J.nc / 32, kb = item / nblk, nb = item % nblk, k0 = 64 * kb, n0 = 32 * nb;
    const float* sp = J.src + (size_t)(k0 + (lane >> 3)) * J.ld + J.c0 + n0 + 4 * (lane & 7);
#pragma unroll
    for (int i = 0; i < 8; ++i) v[i] = *(const f32x4*)(sp + (size_t)(8 * i) * J.ld);
}
DEV void ti_store(const Job& J, int item, const f32x4 (&v)[8], float* scr, int lane) {
    const int nblk = J.nc / 32, kb = item / nblk, nb = item % nblk, k0 = 64 * kb, n0 = 32 * nb;
#pragma unroll
    for (int i = 0; i < 8; ++i) { float* d = scr + (8 * i + (lane >> 3)) * 33 + 4 * (lane & 7); d[0] = v[i][0]; d[1] = v[i][1]; d[2] = v[i][2]; d[3] = v[i][3]; }
    WAVE_LDS_SYNC();
    const int c = lane & 7;
#pragma unroll
    for (int jj = 0; jj < 4; ++jj) { const int n = (lane >> 3) + 8 * jj; const float* s = scr + (8 * c) * 33 + n; const int nn = n0 + n;
        u32x4 o; o.x = pk2(s[0 * 33], s[1 * 33]); o.y = pk2(s[2 * 33], s[3 * 33]); o.z = pk2(s[4 * 33], s[5 * 33]); o.w = pk2(s[6 * 33], s[7 * 33]);
        const int row = J.mode ? J.r0 + 256 * (nn / 128) + (nn % 128) : J.r0 + nn;
        *(u32x4*)(J.dst + (size_t)row * J.K + k0 + 8 * c) = o; }
    WAVE_LDS_SYNC();
}
DEV void i8_panel(const Job& J, int pan, const Ctx& C) {
    constexpr int NI = D / 8 / 64, RP = 64 * NI + 8;
    float* cm = (float*)C.lds;
    unsigned char* scr = C.lds + 1024 + C.wave * (32 * RP);
    const int lane = C.lane, w = C.wave, cq = lane & 7, rr = lane >> 3, n0 = 32 * pan;
    const bool valid = 4 * cq < J.ncv;
    f32x4 v[NI][8]; float mx[4] = {0.f, 0.f, 0.f, 0.f};
    const float* sp = J.src + (size_t)(w * (D / 8) + rr) * J.ld + J.c0 + n0 + 4 * cq;
#pragma unroll
    for (int it = 0; it < NI; ++it)
#pragma unroll
        for (int i = 0; i < 8; ++i) { v[it][i] = valid ? *(const f32x4*)(sp + (size_t)(64 * it + 8 * i) * J.ld) : (f32x4){0.f, 0.f, 0.f, 0.f}; }
#pragma unroll
    for (int it = 0; it < NI; ++it)
#pragma unroll
        for (int i = 0; i < 8; ++i)
#pragma unroll
            for (int q = 0; q < 4; ++q) mx[q] = fmaxf(mx[q], fabsf(v[it][i][q]));
#pragma unroll
    for (int q = 0; q < 4; ++q) { mx[q] = fmaxf(mx[q], __shfl_xor(mx[q], 8)); mx[q] = fmaxf(mx[q], __shfl_xor(mx[q], 16)); mx[q] = fmaxf(mx[q], __shfl_xor(mx[q], 32)); }
    if (rr == 0) *(f32x4*)(cm + w * 32 + 4 * cq) = (f32x4){mx[0], mx[1], mx[2], mx[3]};
    __syncthreads();
    float inv[4];
#pragma unroll
    for (int q = 0; q < 4; ++q) { float m = 0.f;
#pragma unroll
        for (int ww = 0; ww < 8; ++ww) m = fmaxf(m, cm[ww * 32 + 4 * cq + q]);
        inv[q] = m > 0.f ? 127.0f / m : 0.f;
        if (w == 0 && rr == 0) { const int nn = n0 + 4 * cq + q; const int row = J.mode ? J.r0 + 256 * (nn / 128) + (nn % 128) : J.r0 + nn; J.wsc[row] = m > 0.f ? m * (1.0f / 127.0f) : 1.0f; } }
#pragma unroll
    for (int it = 0; it < NI; ++it)
#pragma unroll
        for (int i = 0; i < 8; ++i)
#pragma unroll
            for (int q = 0; q < 4; ++q) scr[(4 * cq + q) * RP + 64 * it + 8 * i + rr] = (unsigned char)q8(v[it][i][q] * inv[q]);
    WAVE_LDS_SYNC();
#pragma unroll
    for (int t = 0; t < (32 * 8 * NI) / 64; ++t) { const int ch = lane + 64 * t, n = ch / (8 * NI), c8 = ch % (8 * NI), nn = n0 + n;
        const int row = J.mode ? J.r0 + 256 * (nn / 128) + (nn % 128) : J.r0 + nn;
        *(u32x2*)((unsigned char*)J.dst + (size_t)row * D + w * (D / 8) + 8 * c8) = *(const u32x2*)(scr + n * RP + 8 * c8); }
    __syncthreads();
}
DEV bool find_job(const Params& P, int it, int total, Job& J, int& r) {
    if (it >= total) return false;
    r = it; int j = 0; J = get_job(P, 0);
    for (;;) { const int n = job_items(J); if (r < n) break; r -= n; ++j; J = get_job(P, j); }
    return true;
}
DEV void phase_weights(const Params& P, const Ctx& C) {
    float* scr = (float*)(C.lds + C.wave * 16384);
    int total = 0, totalp = 0;
    for (int j = 0; j < NJOBS; ++j) { const Job J = get_job(P, j); total += job_items(J); totalp += job_panels(J); }
    for (int pi = C.bid; pi < totalp; pi += C.nblk) {
        int r = pi, j = 0; Job J = get_job(P, 0);
        for (;;) { const int n = job_panels(J); if (r < n) break; r -= n; ++j; J = get_job(P, j); }
        i8_panel(J, r, C);
    }
    {
        Job J, Jn; int r = 0, rn = 0; f32x4 v[8], vn[8];
        bool have = find_job(P, C.gw, total, J, r);
        if (have) ti_load(J, r, v, C.lane);
        for (int it = C.gw; have; it += C.ngw) {
            const bool hn = find_job(P, it + C.ngw, total, Jn, rn);
            if (hn) ti_load(Jn, rn, vn, C.lane);
            ti_store(J, r, v, scr, C.lane);
            have = hn; J = Jn; r = rn;
#pragma unroll
            for (int i = 0; i < 8; ++i) v[i] = vn[i];
        }
    }
    const int gt = C.bid * NTHREADS + C.tid, ngt = C.nblk * NTHREADS;
    if (I8_INPROJ) {
        for (int i = gt; i < DEPTH * 224 * (D / 16); i += ngt) { const int l = i / (224 * (D / 16)), r = 32 + (i / (D / 16)) % 224, k16 = (i % (D / 16)) * 16;
            *(u32x4*)((unsigned char*)(WSP(bf16_t, WS_WIN) + (size_t)l * NP * D) + (size_t)(NPB + r) * D + k16) = (u32x4){0u, 0u, 0u, 0u}; }
        for (int i = gt; i < DEPTH * 224; i += ngt) WSP(float, WS_SMALL + SM_WSIN)[(size_t)(i / 224) * NP + NPB + 32 + i % 224] = 1.0f;
    } else
    for (int i = gt; i < DEPTH * 256 * (D / 8); i += ngt) {
        const int l = i / (256 * (D / 8)), r = (i / (D / 8)) % 256, k8 = (i % (D / 8)) * 8;
        float f[8];
#pragma unroll
        for (int q = 0; q < 8; ++q) f[q] = r < NG ? P.w_in[((size_t)l * D + k8 + q) * N_IN + OMG + r] : 0.f;
        *(u32x4*)(WSP(bf16_t, WS_WIN) + ((size_t)l * NP + NPB + r) * D + k8) = pack8(f);
    }
}
DEV const float* cvec_ptr(const Params& P, int v) { return v < NB ? P.c + (size_t)v * D : P.c_ctx; }
DEV void phase_mod_partial(const Params& P, const Ctx& C) {
    constexpr int NCG = 6 * D / 256, NKS = D / 64;
    for (int it = C.gw; it < DEPTH * NKS * NCG; it += C.ngw) {
        const int cg = it % NCG, ks = (it / NCG) % NKS, l = it / (NCG * NKS), col = cg * 256 + C.lane * 4;
        f32x4 acc[NV];
#pragma unroll
        for (int v = 0; v < NV; ++v) acc[v] = (f32x4){0.f, 0.f, 0.f, 0.f};
#pragma unroll 16
        for (int k = ks * 64; k < ks * 64 + 64; ++k) {
            const f32x4 w = *(const f32x4*)(P.w_mod + ((size_t)l * D + k) * 6 * D + col);
#pragma unroll
            for (int v = 0; v < NV; ++v) { const float s = siluf_(cvec_ptr(P, v)[k]); acc[v] += w * s; }
        }
#pragma unroll
        for (int v = 0; v < NV; ++v) *(f32x4*)(WSP(float, WS_MODP) + (((size_t)ks * DEPTH + l) * NV + v) * 6 * D + col) = acc[v];
    }
}
DEV void phase_mod_final(const Params& P, const Ctx& C) {
    constexpr int NKS = D / 64;
    const int gt = C.bid * NTHREADS + C.tid, ngt = C.nblk * NTHREADS;
    for (int i = gt; i < DEPTH * NV * 6 * D; i += ngt) {
        const int col = i % (6 * D), v = (i / (6 * D)) % NV, l = i / (6 * D * NV);
        float s = P.b_mod[(size_t)l * 6 * D + col];
        for (int ks = 0; ks < NKS; ++ks) s += WSP(float, WS_MODP)[(((size_t)ks * DEPTH + l) * NV + v) * 6 * D + col];
        WSP(float, WS_MOD)[((size_t)l * NV + v) * 6 * D + col] = s;
    }
    for (int i = gt; i < HG_W; i += ngt) {
        float mx = -1e30f; for (int l = 0; l < DEPTH; ++l) mx = fmaxf(mx, P.lb_logits[(size_t)l * HG_W + i]);
        float den = 0.f; for (int l = 0; l < DEPTH; ++l) den += expf(P.lb_logits[(size_t)l * HG_W + i] - mx);
        float cum = 0.f;
        for (int l = 0; l < DEPTH; ++l) { if (l > 0) cum += expf(P.lb_logits[(size_t)l * HG_W + i] - mx) / den; WSP(float, WS_LB)[(size_t)l * HG_W + i] = cum; }
    }
}
DEV const float* mod_vec(const Params& P, int l, int v, int idx) { return WSP(float, WS_MOD) + ((size_t)l * NV + v) * 6 * D + (size_t)idx * D; }

DEV void phase_hpass(const Params& P, const Ctx& C, int l, int which, bool router) {
    constexpr int NJ = D / 256;
    const int nrows = (which == 1 && l == DEPTH - 1) ? MLAT : MT;
    const float* g = (which ? P.norm2_g : P.norm1_g) + (size_t)l * D;
    for (int row = C.gw; row < nrows; row += C.ngw) {
        const float* src;
        if (which) src = WSP(float, WS_X1) + (size_t)row * D;
        else if (l == 0) src = row < MLAT ? P.x + (size_t)row * D : P.ctx + (size_t)(row - MLAT) * D;
        else src = WSP(float, WS_X2) + (size_t)row * D;
        const int v = row_vec(row);
        const float* sh = mod_vec(P, l, v, which ? 3 : 0); const float* sc = mod_vec(P, l, v, which ? 4 : 1);
        f32x4 x[NJ]; float ss = 0.f;
#pragma unroll
        for (int j = 0; j < NJ; ++j) { x[j] = *(const f32x4*)(src + 256 * j + 4 * C.lane); ss += (x[j].x * x[j].x + x[j].y * x[j].y) + (x[j].z * x[j].z + x[j].w * x[j].w); }
        const float rstd = 1.0f / sqrtf(wave_sum(ss) * (1.0f / D) + EPS);
        float lg[NE];
#pragma unroll
        for (int e = 0; e < NE; ++e) lg[e] = 0.f;
        const bool i8 = which ? (I8_FFNUP != 0) : (I8_INPROJ != 0);
        float amax = 0.f;
#pragma unroll
        for (int j = 0; j < NJ; ++j) {
            const int col = 256 * j + 4 * C.lane;
            const f32x4 gg = *(const f32x4*)(g + col), s1 = *(const f32x4*)(sc + col), s0 = *(const f32x4*)(sh + col);
            x[j] = x[j] * rstd * gg * (s1 + 1.0f) + s0;
            amax = fmaxf(fmaxf(amax, fmaxf(fabsf(x[j].x), fabsf(x[j].y))), fmaxf(fabsf(x[j].z), fabsf(x[j].w)));
        }
        float qinv = 0.f;
        if (i8) { amax = wave_max(amax); qinv = amax > 0.f ? 127.0f / amax : 0.f; if (C.lane == 0) WSP(float, WS_SMALL + SM_ASC)[row] = amax > 0.f ? amax * (1.0f / 127.0f) : 1.0f; }
#pragma unroll
        for (int j = 0; j < NJ; ++j) {
            const int col = 256 * j + 4 * C.lane;
            const f32x4 y = x[j];
            if (i8) *(unsigned*)(P.ws + WS_H + (size_t)row * D + col) = pk4_i8(y.x * qinv, y.y * qinv, y.z * qinv, y.w * qinv);
            else { u32x2 o; o.x = pk2(y.x, y.y); o.y = pk2(y.z, y.w); *(u32x2*)(WSP(bf16_t, WS_H) + (size_t)row * D + col) = o; }
            if (router) {
                const float* wr = P.moe_wr + (size_t)(l / 2) * D * NE + (size_t)col * NE;
#pragma unroll
                for (int q = 0; q < 4; ++q)
#pragma unroll
                    for (int e = 0; e < NE; ++e) lg[e] += y[q] * wr[q * NE + e];
            }
        }
        if (router) {
#pragma unroll
            for (int e = 0; e < NE; ++e) lg[e] = wave_sum(lg[e]);
            if (C.lane == 0) {
                int i0 = 0; float v0 = lg[0];
#pragma unroll
                for (int e = 1; e < NE; ++e) if (lg[e] > v0) { v0 = lg[e]; i0 = e; }
                int i1 = -1; float v1 = -3.0e38f;
#pragma unroll
                for (int e = 0; e < NE; ++e) if (e != i0 && lg[e] > v1) { v1 = lg[e]; i1 = e; }
                const float w1 = 1.0f / (1.0f + expf(v0 - v1)), w0 = 1.0f - w1;
                int* te = WSP(int, WS_SMALL + SM_TE) + row * 2; float* tw = WSP(float, WS_SMALL + SM_TW) + row * 2; int* tp = WSP(int, WS_SMALL + SM_TP) + row * 2;
                unsigned* cnt = WSP(unsigned, WS_CTL) + CW_CNT;
                te[0] = i0; te[1] = i1; tw[0] = w0; tw[1] = w1;
                tp[0] = (int)atomicAdd(cnt + i0, 1u); tp[1] = (int)atomicAdd(cnt + i1, 1u);
            }
        }
    }
    if (router) {
        const int gt = C.bid * NTHREADS + C.tid, ngt = C.nblk * NTHREADS;
        for (int i = gt; i < MOE_ROWS; i += ngt) WSP(int, WS_SMALL + SM_RTOK)[i] = -1;
    }
}

DEV void phase_fixup(const Params& P, const Ctx& C, int l, bool need_ctx) {
    const bf16_t* Pb = WSP(bf16_t, WS_P);
    const float* qg = P.qn_g + (size_t)l * HD; const float* kg = P.kn_g + (size_t)l * HD;
    const float* cw = P.conv_w + (size_t)l * 3 * 2 * ML_W;
    const int lane = C.lane, jf = lane & 31;
    const float invf = expf(-logf(10000.0f) * (float)(2 * jf) / 64.0f);
    for (int row = C.gw; row < MT; row += C.ngw) {
        const bool lat = row < MLAT;
        const int b = lat ? row / TL : (row - MLAT) / TC, t = lat ? row % TL : (row - MLAT) % TC, tseg = lat ? TL : TC;
        const bf16_t* pr = Pb + (size_t)row * NPB;
        float c0 = 1.f, s0 = 0.f, c1 = 1.f, s1 = 0.f;
        if (lat) { const float a0 = (float)(t / GRIDW) * invf, a1 = (float)(t % GRIDW) * invf; c0 = cosf(a0); s0 = sinf(a0); c1 = cosf(a1); s1 = sinf(a1); }
        const int pos = lat ? TC + t : t;
        for (int hh = 0; hh < AH + AKV; ++hh) {
            const bool isq = hh < AH;
            if (isq && !lat && !need_ctx) continue;
            const int col = isq ? PQ + hh * HD : PK + (hh - AH) * HD;
            float e0 = bf2f(pr[col + lane]), e1 = bf2f(pr[col + 64 + lane]);
            const float r = 1.0f / sqrtf(wave_sum(e0 * e0 + e1 * e1) * (1.0f / HD) + EPS);
            const float* gg = isq ? qg : kg;
            e0 *= r * gg[lane]; e1 *= r * gg[64 + lane];
            if (lat) {
                const float p0 = __shfl_xor(e0, 32), p1 = __shfl_xor(e1, 32);
                e0 = lane < 32 ? e0 * c0 - p0 * s0 : e0 * c0 + p0 * s0;
                e1 = lane < 32 ? e1 * c1 - p1 * s1 : e1 * c1 + p1 * s1;
            }
            bf16_t* dst = isq ? WSP(bf16_t, WS_QA) + (size_t)row * ATT_W + hh * HD : WSP(bf16_t, WS_KCAT) + ((size_t)b * TT + pos) * KV_W + (hh - AH) * HD;
            dst[lane] = (bf16_t)f2bf(e0); dst[64 + lane] = (bf16_t)f2bf(e1);
        }
        for (int cidx = lane * 4; cidx < KV_W; cidx += 256) *(u32x2*)(WSP(bf16_t, WS_VCAT) + ((size_t)b * TT + pos) * KV_W + cidx) = *(const u32x2*)(pr + PV + cidx);
        for (int cidx = lane * 8; cidx < 2 * ML_W; cidx += 512) {
            const bool isk = cidx >= ML_W; const int pc = isk ? PMK + (cidx - ML_W) : PMQ + cidx;
            float xm[8], x0[8], xp[8], o[8];
            unpack8(*(const u32x4*)(pr + pc), x0);
            if (t > 0) unpack8(*(const u32x4*)(pr - NPB + pc), xm); else { for (int q = 0; q < 8; ++q) xm[q] = 0.f; }
            if (t + 1 < tseg) unpack8(*(const u32x4*)(pr + NPB + pc), xp); else { for (int q = 0; q < 8; ++q) xp[q] = 0.f; }
            const float sc = isk ? 0.0625f : 1.0f;
#pragma unroll
            for (int q = 0; q < 8; ++q) o[q] = (xm[q] * cw[cidx + q] + x0[q] * cw[2 * ML_W + cidx + q] + xp[q] * cw[4 * ML_W + cidx + q]) * sc;
            bf16_t* dst = (isk ? WSP(bf16_t, WS_KM) + (size_t)row * ML_W + (cidx - ML_W) : WSP(bf16_t, WS_QM) + (size_t)row * ML_W + cidx);
            *(u32x4*)dst = pack8(o);
        }
    }
}

constexpr int MQP = MDK + 8, CP = CH + 8;
DEV const bf16_t* cptr(const bf16_t* p) { return p; }
DEV void mlstm_s1_unit(const Params& P, const Ctx& C0, int l, int u) {
    const Ctx C = make_ctx(C0.lds);
    const int c = u % NCH, sq = u / NCH, d = sq & 1, h = (sq >> 1) % MLH, b = sq / (2 * MLH);
    bf16_t* Ks = (bf16_t*)C.lds;
    bf16_t* Vs = Ks + CH * MQP;
    float* wsl = (float*)(Vs + CH * MQP);
    const float* G16 = WSP(float, WS_G16); const float* gb = P.gate_b + (size_t)l * NG;
    const int lane = C.lane, w = C.wave, r32 = lane & 31, hi = lane >> 5;
    const int rowL = seq_row(b, d, c * CH + lane);
    const float li = G16[(size_t)rowL * 16 + d * MLH + h] + gb[d * MLH + h];
    const float lf = logsigmoidf_(G16[(size_t)rowL * 16 + (2 + d) * MLH + h] + gb[(2 + d) * MLH + h]);
    const float fc = wave_scan_add(lf, lane), tot = __shfl(fc, 63);
    const float g = tot - fc + li, mx = wave_max(g), wsv = expf(g - mx);
    if (w == 0) { wsl[lane] = wsv; if (lane == 0) { WSP(float, WS_SMALL + SM_FL)[sq * NCH + c] = tot; WSP(float, WS_SMALL + SM_MLOC)[sq * NCH + c] = mx; } }
#pragma unroll
    for (int it = 0; it < CH * (MDK / 8) / NTHREADS; ++it) {
        const int i = C.tid + NTHREADS * it, s = i / (MDK / 8), cg = i % (MDK / 8), row = seq_row(b, d, c * CH + s);
        const float wv = __shfl(wsv, s);
        *(u32x4*)(Ks + s * MQP + cg * 8) = *(const u32x4*)(WSP(bf16_t, WS_KM) + (size_t)row * ML_W + h * MDK + cg * 8);
        float vv[8]; unpack8(*(const u32x4*)(WSP(bf16_t, WS_P) + (size_t)row * NPB + PMV + h * MDV + cg * 8), vv);
#pragma unroll
        for (int q = 0; q < 8; ++q) vv[q] *= wv;
        *(u32x4*)(Vs + s * MQP + cg * 8) = pack8(vv);
    }
    __syncthreads();
    if (C.tid < MDK) { float s = 0.f; for (int j = 0; j < CH; ++j) s += wsl[j] * bf2f(Ks[j * MQP + C.tid]); WSP(float, WS_SMALL + SM_NLOC)[((size_t)sq * NCH + c) * MDK + C.tid] = s; }
    f32x16 acc[8];
#pragma unroll
    for (int mb = 0; mb < 8; ++mb) acc[mb] = (f32x16){0};
#pragma unroll
    for (int ks = 0; ks < CH / 16; ++ks) {
        s16x4 bl, bh; tr_issue(bl, bh, cptr(Vs), MQP, 16 * ks, 32 * w, lane);
#pragma unroll
        for (int g4 = 0; g4 < 2; ++g4) {
            s16x4 al[4], ah[4];
#pragma unroll
            for (int q = 0; q < 4; ++q) tr_issue(al[q], ah[q], cptr(Ks), MQP, 16 * ks, 32 * (4 * g4 + q), lane);
            TR_WAIT8(al[0], ah[0], al[1], ah[1], al[2], ah[2], al[3], ah[3]); TR_WAIT2(bl, bh);
#pragma unroll
            for (int q = 0; q < 4; ++q) acc[4 * g4 + q] = MFMA32(TR_PK(al[q], ah[q]), TR_PK(bl, bh), acc[4 * g4 + q]);
        }
    }
    bf16_t* out = WSP(bf16_t, WS_CSTM) + ((size_t)sq * NCH + c) * MDV * MDK + (size_t)(32 * w + r32) * MDK + 4 * hi;
#pragma unroll
    for (int mb = 0; mb < 8; ++mb)
#pragma unroll
        for (int g4 = 0; g4 < 4; ++g4) { u32x2 o; o.x = pk2(acc[mb][4 * g4], acc[mb][4 * g4 + 1]); o.y = pk2(acc[mb][4 * g4 + 2], acc[mb][4 * g4 + 3]); *(u32x2*)(out + 32 * mb + 8 * g4) = o; }
    __syncthreads();
}
DEV void mlstm_s2(const Params& P, const Ctx& C) {
    const int gt = C.bid * NTHREADS + C.tid, ngt = C.nblk * NTHREADS;
    constexpr int NG8 = MDV * MDK / 8;
    static_assert(NCH % 4 == 0, "chunk pipeline depth");
    const float* FL = WSP(float, WS_SMALL + SM_FL); const float* MLOC = WSP(float, WS_SMALL + SM_MLOC);
    for (int i = gt; i < NSQM * NG8; i += ngt) {
        const int sq = i / NG8, g8 = i % NG8; float run[8];
#pragma unroll
        for (int q = 0; q < 8; ++q) run[q] = 0.f;
        float m_run = -1e30f;
        u32x4* p = (u32x4*)(WSP(bf16_t, WS_CSTM) + (size_t)sq * NCH * MDV * MDK + (size_t)g8 * 8);
        u32x4 buf[4];
#pragma unroll
        for (int q = 0; q < 4; ++q) buf[q] = p[(size_t)q * NG8];
        for (int c0 = 0; c0 < NCH; c0 += 4) {
#pragma unroll
            for (int q = 0; q < 4; ++q) { const int c = c0 + q;
                float kl[8]; unpack8(buf[q], kl);
                if (c + 4 < NCH) buf[q] = p[(size_t)(c + 4) * NG8];
                p[(size_t)c * NG8] = pack8(run);
                const float fl = FL[sq * NCH + c], ml = MLOC[sq * NCH + c], mn = fmaxf(fl + m_run, ml), dec = fexp(fl + m_run - mn), sl = fexp(ml - mn);
#pragma unroll
                for (int e = 0; e < 8; ++e) run[e] = dec * run[e] + sl * kl[e];
                m_run = mn; }
        }
    }
    for (int i = gt; i < NSQM * MDK; i += ngt) {
        const int sq = i / MDK, dk = i % MDK; float run = 0.f, m_run = -1e30f;
        float* p = WSP(float, WS_SMALL + SM_NLOC) + (size_t)sq * NCH * MDK + dk;
        for (int c = 0; c < NCH; ++c) {
            const float nl = p[(size_t)c * MDK]; p[(size_t)c * MDK] = run;
            const float fl = FL[sq * NCH + c], ml = MLOC[sq * NCH + c], mn = fmaxf(fl + m_run, ml), dec = fexp(fl + m_run - mn), sl = fexp(ml - mn);
            run = dec * run + sl * nl;
            if (dk == 0) WSP(float, WS_SMALL + SM_MST)[sq * NCH + c] = m_run;
            m_run = mn;
        }
    }
}
DEV void mlstm_s3_unit(const Params& P, const Ctx& C0, int l, int u) {
    const Ctx C = make_ctx(C0.lds);
    const int cc = u % NCH, h = (u / NCH) % MLH, b = u / (NCH * MLH);
    const int row0 = chunk_row0(b, cc);
    bf16_t* Qs = (bf16_t*)C.lds;
    bf16_t* Ks = Qs + CH * MQP;
    bf16_t* Vs = Ks + CH * MQP;
    bf16_t* SC = Vs + CH * MQP;
    float* vec = (float*)(SC + 2 * CH * CP);
    float* liv = vec;
    float* fcv = vec + 128;
    float* mtv = vec + 256;
    float* av = vec + 384;
    float* qnv = vec + 512;
    float* rinv = vec + 640;
    float* HS = (float*)C.lds;
    const float* G16 = WSP(float, WS_G16); const float* gb = P.gate_b + (size_t)l * NG;
    const int sq0 = (b * MLH + h) * 2, c0 = dir_chunk(cc, 0), c1 = dir_chunk(cc, 1);
    const int lane = C.lane, r32 = lane & 31, hi = lane >> 5, w = C.wave;
#pragma unroll
    for (int it = 0; it < CH * (MDK / 8) / NTHREADS; ++it) {
        const int i = C.tid + NTHREADS * it, s = i / (MDK / 8), cg = i % (MDK / 8), row = row0 + s;
        *(u32x4*)(Qs + s * MQP + cg * 8) = *(const u32x4*)(WSP(bf16_t, WS_QM) + (size_t)row * ML_W + h * MDK + cg * 8);
        *(u32x4*)(Ks + s * MQP + cg * 8) = *(const u32x4*)(WSP(bf16_t, WS_KM) + (size_t)row * ML_W + h * MDK + cg * 8);
        *(u32x4*)(Vs + s * MQP + cg * 8) = *(const u32x4*)(WSP(bf16_t, WS_P) + (size_t)row * NPB + PMV + h * MDV + cg * 8);
    }
    if (w == 4 || w == 5) {
        const int d = w - 4, j = d ? CH - 1 - lane : lane, row = row0 + j;
        const float li = G16[(size_t)row * 16 + d * MLH + h] + gb[d * MLH + h];
        const float lf = logsigmoidf_(G16[(size_t)row * 16 + (2 + d) * MLH + h] + gb[(2 + d) * MLH + h]);
        const float ms = WSP(float, WS_SMALL + SM_MST)[(sq0 + d) * NCH + (d ? c1 : c0)];
        const float fc = wave_scan_add(lf, lane), pm = wave_scan_max(li - fc, lane), mt = fc + fmaxf(ms, pm);
        liv[d * 64 + j] = li; fcv[d * 64 + j] = fc; mtv[d * 64 + j] = mt; av[d * 64 + j] = expf(fc + ms - mt);
    }
    __syncthreads();
    f32x16 sacc = (f32x16){0};
    if (w < 4) {
        const int tb = w >> 1, sb = w & 1;
#pragma unroll
        for (int ks = 0; ks < MDK / 16; ++ks) {
            const bf16x8 a = *(const bf16x8*)(Qs + (32 * tb + r32) * MQP + 16 * ks + 8 * hi);
            const bf16x8 bb = *(const bf16x8*)(Ks + (32 * sb + r32) * MQP + 16 * ks + 8 * hi);
            sacc = MFMA32(a, bb, sacc);
        }
    }
    {
        const int t = C.tid >> 3, part = C.tid & 7;
        const float* n0 = WSP(float, WS_SMALL + SM_NLOC) + ((size_t)(sq0 + 0) * NCH + c0) * MDK + part * 32;
        const float* n1 = WSP(float, WS_SMALL + SM_NLOC) + ((size_t)(sq0 + 1) * NCH + c1) * MDK + part * 32;
        float s0 = 0.f, s1 = 0.f;
#pragma unroll
        for (int q4 = 0; q4 < 4; ++q4) { float qq[8]; unpack8(*(const u32x4*)(Qs + t * MQP + part * 32 + q4 * 8), qq);
            const f32x4 a0 = *(const f32x4*)(n0 + q4 * 8), a1 = *(const f32x4*)(n0 + q4 * 8 + 4), b0 = *(const f32x4*)(n1 + q4 * 8), b1 = *(const f32x4*)(n1 + q4 * 8 + 4);
#pragma unroll
            for (int e = 0; e < 4; ++e) { s0 += qq[e] * a0[e] + qq[4 + e] * a1[e]; s1 += qq[e] * b0[e] + qq[4 + e] * b1[e]; } }
#pragma unroll
        for (int o = 1; o < 8; o <<= 1) { s0 += __shfl_xor(s0, o); s1 += __shfl_xor(s1, o); }
        if (part == 0) { qnv[t] = s0; qnv[64 + t] = s1; }
    }
    if (w < 4) {
        const int tb = w >> 1, sb = w & 1, s = 32 * sb + r32;
#pragma unroll
        for (int d = 0; d < 2; ++d) { const float fs = fcv[d * 64 + s], ls = liv[d * 64 + s];
#pragma unroll
            for (int r = 0; r < 16; ++r) { const int t = 32 * tb + crow(r, hi); const bool ok = d ? (s >= t) : (s <= t);
                const float wgt = ok ? fexp(fcv[d * 64 + t] - fs + ls - mtv[d * 64 + t]) : 0.f;
                SC[(d * CH + t) * CP + s] = (bf16_t)f2bf(ok ? sacc[r] * wgt : 0.f);
                if ((r & 3) == 3) asm volatile("" ::: "memory"); } }
    }
    __syncthreads();
    if (C.tid < 2 * CH) { const int d = C.tid >> 6, t = C.tid & 63; float s = 0.f;
#pragma unroll
        for (int k8 = 0; k8 < CH / 8; ++k8) { float x[8]; unpack8(*(const u32x4*)(SC + (d * CH + t) * CP + k8 * 8), x);
#pragma unroll
            for (int e = 0; e < 8; ++e) s += x[e]; }
        const float den = s + av[C.tid] * qnv[C.tid]; rinv[C.tid] = 1.0f / fmaxf(fabsf(den), expf(-mtv[C.tid])); }
    __syncthreads();
    f32x16 hs[2]; hs[0] = (f32x16){0}; hs[1] = (f32x16){0};
#pragma unroll 1
    for (int d = 0; d < 2; ++d) {
        { f32x16 a1[2]; a1[0] = (f32x16){0}; a1[1] = (f32x16){0};
#pragma unroll
        for (int ks = 0; ks < CH / 16; ++ks) {
            s16x4 bl, bh; tr_issue(bl, bh, cptr(Vs), MQP, 16 * ks, 32 * w, lane);
            const bf16x8 x0 = *(const bf16x8*)(SC + (d * CH + r32) * CP + 16 * ks + 8 * hi), x1 = *(const bf16x8*)(SC + (d * CH + 32 + r32) * CP + 16 * ks + 8 * hi);
            TR_WAIT2(bl, bh);
            a1[0] = MFMA32(x0, TR_PK(bl, bh), a1[0]); a1[1] = MFMA32(x1, TR_PK(bl, bh), a1[1]);
        }
#pragma unroll
        for (int r = 0; r < 16; ++r) { const int t = crow(r, hi); hs[0][r] += a1[0][r] * rinv[d * 64 + t]; hs[1][r] += a1[1][r] * rinv[d * 64 + 32 + t]; } }
        f32x16 a2[2]; a2[0] = (f32x16){0}; a2[1] = (f32x16){0};
        const bf16_t* cst = WSP(bf16_t, WS_CSTM) + ((size_t)(sq0 + d) * NCH + (d ? c1 : c0)) * MDV * MDK + (size_t)(32 * w + r32) * MDK + 8 * hi;
#pragma unroll 4
        for (int ks = 0; ks < MDK / 16; ++ks) {
            const bf16x8 bb = *(const bf16x8*)(cst + 16 * ks);
            const bf16x8 x0 = *(const bf16x8*)(Qs + r32 * MQP + 16 * ks + 8 * hi), x1 = *(const bf16x8*)(Qs + (32 + r32) * MQP + 16 * ks + 8 * hi);
            a2[0] = MFMA32(x0, bb, a2[0]); a2[1] = MFMA32(x1, bb, a2[1]);
        }
#pragma unroll
        for (int r = 0; r < 16; ++r) { const int t = crow(r, hi);
            hs[0][r] += av[d * 64 + t] * a2[0][r] * rinv[d * 64 + t];
            hs[1][r] += av[d * 64 + 32 + t] * a2[1][r] * rinv[d * 64 + 32 + t]; }
    }
    __syncthreads();
#pragma unroll
    for (int tb = 0; tb < 2; ++tb)
#pragma unroll
        for (int r = 0; r < 16; ++r) HS[(32 * tb + crow(r, hi)) * 257 + 32 * w + r32] = hs[tb][r];
    __syncthreads();
    const float* ng = P.ml_norm_g + (size_t)l * ML_W + h * MDV;
    for (int t = w; t < CH; t += NWAVES) {
        float v[4], ss = 0.f;
#pragma unroll
        for (int q = 0; q < 4; ++q) { v[q] = HS[t * 257 + C.lane * 4 + q]; ss += v[q] * v[q]; }
        const float rstd = 1.0f / sqrtf(wave_sum(ss) * (1.0f / MDV) + EPS);
        const int row = row0 + t; const u32x2 ov = *(const u32x2*)(WSP(bf16_t, WS_P) + (size_t)row * NPB + PMO + h * MDV + C.lane * 4);
        const float o0 = bitsf(ov.x << 16), o1 = bitsf(ov.x & 0xffff0000u), o2 = bitsf(ov.y << 16), o3 = bitsf(ov.y & 0xffff0000u);
        u32x2 y; y.x = pk2(v[0] * rstd * ng[C.lane * 4 + 0] * sigmoidf_(o0), v[1] * rstd * ng[C.lane * 4 + 1] * sigmoidf_(o1));
        y.y = pk2(v[2] * rstd * ng[C.lane * 4 + 2] * sigmoidf_(o2), v[3] * rstd * ng[C.lane * 4 + 3] * sigmoidf_(o3));
        *(u32x2*)(WSP(bf16_t, WS_Y) + ((size_t)1 * MT + row) * BW + h * MDV + C.lane * 4) = y;
    }
    __syncthreads();
}

constexpr int HQP = HDK + 8;
DEV float hg_f(float z, float lb) { return lb + (1.0f - lb) * sigmoidf_(z); }
DEV void hgrn_s1_unit(const Params& P, const Ctx& C0, int l, int u) {
    const Ctx C = make_ctx(C0.lds);
    const int cc = u % NCH, h = (u / NCH) % HGH, b = u / (NCH * HGH), row0 = chunk_row0(b, cc);
    bf16_t* KP = (bf16_t*)C.lds;
    bf16_t* Vs = KP + 2 * CH * HQP;
    float* T = (float*)(Vs + CH * HQP);
    const bf16_t* Pb = WSP(bf16_t, WS_P); const float* LB = WSP(float, WS_LB) + (size_t)l * HG_W + h * HDK;
    const int sq0 = (b * HGH + h) * 2;
    const int lane = C.lane, r32 = lane & 31, hi = lane >> 5, w = C.wave;
#pragma unroll
    for (int it = 0; it < CH * (HDV / 8) / NTHREADS; ++it) {
        const int i = C.tid + NTHREADS * it, s = i / (HDV / 8), cg = i % (HDV / 8);
        *(u32x4*)(Vs + s * HQP + cg * 8) = *(const u32x4*)(Pb + (size_t)(row0 + s) * NPB + PHI + h * HDV + cg * 8);
    }
    const float lb0 = LB[2 * lane], lb1 = LB[2 * lane + 1];
    float kk[2][8][2], gg[2][8][2];
#pragma unroll
    for (int d = 0; d < 2; ++d) {
        float c0 = 0.f, c1 = 0.f;
#pragma unroll
        for (int i = 0; i < 8; ++i) { const int p = 8 * w + i, j = d ? CH - 1 - p : p;
            const unsigned zz = *(const unsigned*)(Pb + (size_t)(row0 + j) * NPB + (d ? PHB : PHF) + h * HDK + 2 * lane);
            const float f0 = hg_f(bitsf(zz << 16), lb0), f1 = hg_f(bitsf(zz & 0xffff0000u), lb1);
            c0 += flog(f0); c1 += flog(f1); kk[d][i][0] = 1.0f - f0; kk[d][i][1] = 1.0f - f1; gg[d][i][0] = c0; gg[d][i][1] = c1; }
        *(f32x2*)(T + (d * 8 + w) * HDK + 2 * lane) = (f32x2){c0, c1};
    }
    __syncthreads();
#pragma unroll
    for (int d = 0; d < 2; ++d) {
        float off0 = 0.f, off1 = 0.f, tot0 = 0.f, tot1 = 0.f;
#pragma unroll
        for (int sg = 0; sg < 8; ++sg) { const f32x2 t = *(const f32x2*)(T + (d * 8 + sg) * HDK + 2 * lane); tot0 += t.x; tot1 += t.y; if (sg < w) { off0 += t.x; off1 += t.y; } }
#pragma unroll
        for (int i = 0; i < 8; ++i) { const int p = 8 * w + i, j = d ? CH - 1 - p : p;
            *(unsigned*)(KP + (d * CH + j) * HQP + 2 * lane) = pk2(kk[d][i][0] * fexp(tot0 - off0 - gg[d][i][0]), kk[d][i][1] * fexp(tot1 - off1 - gg[d][i][1])); }
        if (w == 0) *(f32x2*)(WSP(float, WS_SMALL + SM_LAM) + ((size_t)(sq0 + d) * NCH + dir_chunk(cc, d)) * HDK + 2 * lane) = (f32x2){fexp(tot0), fexp(tot1)};
    }
    __syncthreads();
    const int d = w >> 2, nb = w & 3;
    f32x16 acc[4];
#pragma unroll
    for (int mb = 0; mb < 4; ++mb) acc[mb] = (f32x16){0};
#pragma unroll
    for (int ks = 0; ks < CH / 16; ++ks) {
        s16x4 bl, bh, al[4], ah[4]; tr_issue(bl, bh, cptr(Vs), HQP, 16 * ks, 32 * nb, lane);
#pragma unroll
        for (int q = 0; q < 4; ++q) tr_issue(al[q], ah[q], cptr(KP + d * CH * HQP), HQP, 16 * ks, 32 * q, lane);
        TR_WAIT8(al[0], ah[0], al[1], ah[1], al[2], ah[2], al[3], ah[3]); TR_WAIT2(bl, bh);
#pragma unroll
        for (int q = 0; q < 4; ++q) acc[q] = MFMA32(TR_PK(al[q], ah[q]), TR_PK(bl, bh), acc[q]);
    }
    bf16_t* out = WSP(bf16_t, WS_CSTH) + ((size_t)(sq0 + d) * NCH + dir_chunk(cc, d)) * HDV * HDK + (size_t)(32 * nb + r32) * HDK + 4 * hi;
#pragma unroll
    for (int mb = 0; mb < 4; ++mb)
#pragma unroll
        for (int g4 = 0; g4 < 4; ++g4) { u32x2 o; o.x = pk2(acc[mb][4 * g4], acc[mb][4 * g4 + 1]); o.y = pk2(acc[mb][4 * g4 + 2], acc[mb][4 * g4 + 3]); *(u32x2*)(out + 32 * mb + 8 * g4) = o; }
    __syncthreads();
}
DEV void hgrn_s2(const Params& P, const Ctx& C) {
    const int gt = C.bid * NTHREADS + C.tid, ngt = C.nblk * NTHREADS;
    constexpr int NG8 = HDV * HDK / 8;
    for (int i = gt; i < NSQH * NG8; i += ngt) {
        const int sq = i / NG8, g8 = i % NG8, dk0 = (g8 * 8) % HDK; float run[8];
#pragma unroll
        for (int q = 0; q < 8; ++q) run[q] = 0.f;
        u32x4* p = (u32x4*)(WSP(bf16_t, WS_CSTH) + (size_t)sq * NCH * HDV * HDK + (size_t)g8 * 8);
        const float* lam = WSP(float, WS_SMALL + SM_LAM) + (size_t)sq * NCH * HDK + dk0;
        u32x4 buf[4];
#pragma unroll
        for (int q = 0; q < 4; ++q) buf[q] = p[(size_t)q * NG8];
        for (int c0 = 0; c0 < NCH; c0 += 4) {
#pragma unroll
            for (int q = 0; q < 4; ++q) { const int c = c0 + q;
                float kl[8]; unpack8(buf[q], kl);
                if (c + 4 < NCH) buf[q] = p[(size_t)(c + 4) * NG8];
                p[(size_t)c * NG8] = pack8(run);
                const f32x4 la = *(const f32x4*)(lam + (size_t)c * HDK), lb4 = *(const f32x4*)(lam + (size_t)c * HDK + 4);
#pragma unroll
                for (int e = 0; e < 4; ++e) { run[e] = la[e] * run[e] + kl[e]; run[4 + e] = lb4[e] * run[4 + e] + kl[4 + e]; } }
        }
    }
}
DEV void hgrn_s3_unit(const Params& P, const Ctx& C0, int l, int u) {
    const Ctx C = make_ctx(C0.lds);
    const int cc = u % NCH, h = (u / NCH) % HGH, b = u / (NCH * HGH), row0 = chunk_row0(b, cc);
    bf16_t* QH = (bf16_t*)C.lds;
    bf16_t* KH = QH + CH * HQP;
    bf16_t* KTL = KH + CH * HQP;
    bf16_t* QP = KTL + 32 * HQP;
    bf16_t* Vs = QP + CH * HQP;
    bf16_t* AT = Vs + CH * HQP;
    float* T = (float*)(AT + CH * CP);
    float* HS = (float*)C.lds;
    const bf16_t* Pb = WSP(bf16_t, WS_P); const float* LB = WSP(float, WS_LB) + (size_t)l * HG_W + h * HDK;
    const int sq0 = (b * HGH + h) * 2;
    const int lane = C.lane, r32 = lane & 31, hi = lane >> 5, w = C.wave, tbo = w >> 2, eb = w & 3;
#pragma unroll
    for (int it = 0; it < CH * (HDV / 8) / NTHREADS; ++it) {
        const int i = C.tid + NTHREADS * it, s = i / (HDV / 8), cg = i % (HDV / 8);
        *(u32x4*)(Vs + s * HQP + cg * 8) = *(const u32x4*)(Pb + (size_t)(row0 + s) * NPB + PHI + h * HDV + cg * 8);
    }
    const float lb0 = LB[2 * lane], lb1 = LB[2 * lane + 1];
    f32x16 oacc = (f32x16){0};
#pragma unroll 1
    for (int d = 0; d < 2; ++d) {
        const int zc = (d ? PHB : PHF) + h * HDK;
        float kk[8][2], gg[8][2], qq[8][2]; float c0 = 0.f, c1 = 0.f;
#pragma unroll
        for (int i = 0; i < 8; ++i) { const int p = 8 * w + i, j = d ? CH - 1 - p : p;
            const unsigned zz = *(const unsigned*)(Pb + (size_t)(row0 + j) * NPB + zc + 2 * lane), qv = *(const unsigned*)(Pb + (size_t)(row0 + j) * NPB + PHQ + h * HDK + 2 * lane);
            const float f0 = hg_f(bitsf(zz << 16), lb0), f1 = hg_f(bitsf(zz & 0xffff0000u), lb1);
            c0 += flog(f0); c1 += flog(f1); kk[i][0] = 1.0f - f0; kk[i][1] = 1.0f - f1; gg[i][0] = c0; gg[i][1] = c1;
            qq[i][0] = siluf_(bitsf(qv << 16)); qq[i][1] = siluf_(bitsf(qv & 0xffff0000u)); }
        *(f32x2*)(T + w * HDK + 2 * lane) = (f32x2){c0, c1};
        __syncthreads();
        float off0 = 0.f, off1 = 0.f, mid0 = 0.f, mid1 = 0.f;
#pragma unroll
        for (int sg = 0; sg < 8; ++sg) { const f32x2 t = *(const f32x2*)(T + sg * HDK + 2 * lane); if (sg < 4) { mid0 += t.x; mid1 += t.y; } if (sg < w) { off0 += t.x; off1 += t.y; } }
        const bool ref0 = w < 4;
        const float rf0 = ref0 ? 0.f : mid0, rf1 = ref0 ? 0.f : mid1;
#pragma unroll
        for (int i = 0; i < 8; ++i) { const int p = 8 * w + i, j = d ? CH - 1 - p : p; const float G0 = off0 + gg[i][0], G1 = off1 + gg[i][1];
            *(unsigned*)(QH + j * HQP + 2 * lane) = pk2(qq[i][0] * fexp(G0 - rf0), qq[i][1] * fexp(G1 - rf1));
            *(unsigned*)(KH + j * HQP + 2 * lane) = pk2(kk[i][0] * fexp(rf0 - G0), kk[i][1] * fexp(rf1 - G1));
            *(unsigned*)(QP + j * HQP + 2 * lane) = pk2(qq[i][0] * fexp(G0), qq[i][1] * fexp(G1));
            if (ref0) *(unsigned*)(KTL + (j & 31) * HQP + 2 * lane) = pk2(kk[i][0] * fexp(mid0 - G0), kk[i][1] * fexp(mid1 - G1)); }
        __syncthreads();
        if (w < 4) {
            const int tb = w >> 1, sb = w & 1; const bool diag = tb == sb, off = d ? (tb == 0 && sb == 1) : (tb == 1 && sb == 0);
            f32x16 sa = (f32x16){0};
            if (diag || off) {
                const bf16_t* kb = diag ? KH + (32 * sb) * HQP : KTL;
#pragma unroll
                for (int ks = 0; ks < HDK / 16; ++ks) {
                    const bf16x8 a = *(const bf16x8*)(QH + (32 * tb + r32) * HQP + 16 * ks + 8 * hi);
                    const bf16x8 bb = *(const bf16x8*)(kb + r32 * HQP + 16 * ks + 8 * hi);
                    sa = MFMA32(a, bb, sa);
                }
            }
#pragma unroll
            for (int r = 0; r < 16; ++r) { const int t = 32 * tb + crow(r, hi), s = 32 * sb + r32; const bool ok = d ? (s >= t) : (s <= t);
                AT[t * CP + s] = (bf16_t)f2bf((ok && (diag || off)) ? sa[r] : 0.f); }
        }
        __syncthreads();
#pragma unroll
        for (int ks = 0; ks < CH / 16; ++ks) {
            s16x4 bl, bh; tr_issue(bl, bh, cptr(Vs), HQP, 16 * ks, 32 * eb, lane);
            const bf16x8 a = *(const bf16x8*)(AT + (32 * tbo + r32) * CP + 16 * ks + 8 * hi);
            TR_WAIT2(bl, bh);
            oacc = MFMA32(a, TR_PK(bl, bh), oacc);
        }
        const bf16_t* sst = WSP(bf16_t, WS_CSTH) + ((size_t)(sq0 + d) * NCH + dir_chunk(cc, d)) * HDV * HDK + (size_t)(32 * eb + r32) * HDK + 8 * hi;
#pragma unroll
        for (int ks = 0; ks < HDK / 16; ++ks) {
            const bf16x8 a = *(const bf16x8*)(QP + (32 * tbo + r32) * HQP + 16 * ks + 8 * hi);
            const bf16x8 bb = *(const bf16x8*)(sst + 16 * ks);
            oacc = MFMA32(a, bb, oacc);
        }
        __syncthreads();
    }
#pragma unroll
    for (int r = 0; r < 16; ++r) HS[(32 * tbo + crow(r, hi)) * HDV + 32 * eb + r32] = oacc[r];
    __syncthreads();
    const float* ng = P.hg_norm_g + (size_t)l * HG_W + h * HDV;
    for (int t = w; t < CH; t += NWAVES) {
        const float v0 = HS[t * HDV + C.lane * 2], v1 = HS[t * HDV + C.lane * 2 + 1];
        const float rstd = 1.0f / sqrtf(wave_sum(v0 * v0 + v1 * v1) * (1.0f / HDV) + EPS);
        const int row = row0 + t; const unsigned gv = *(const unsigned*)(Pb + (size_t)row * NPB + PHG + h * HDV + C.lane * 2);
        const float g0 = bitsf(gv << 16), g1 = bitsf(gv & 0xffff0000u);
        *(unsigned*)(WSP(bf16_t, WS_Y) + ((size_t)2 * MT + row) * BW + h * HDV + C.lane * 2) = pk2(v0 * rstd * ng[C.lane * 2] * siluf_(g0), v1 * rstd * ng[C.lane * 2 + 1] * siluf_(g1));
    }
    __syncthreads();
}
DEV void phase_s1(const Params& P, const Ctx& C, int l) {
    for (int u = C.bid; u < NSQM * NCH; u += C.nblk) mlstm_s1_unit(P, C, l, u);
    for (int u = C.bid; u < NB * HGH * NCH; u += C.nblk) hgrn_s1_unit(P, C, l, u);
}
DEV void phase_s2(const Params& P, const Ctx& C) { mlstm_s2(P, C); hgrn_s2(P, C); }
DEV void phase_s3(const Params& P, const Ctx& C, int l, bool need_ctx) {
    const int c_lo = need_ctx ? 0 : NCHC, ncu = NCH - c_lo;
    for (int u = C.bid; u < NB * MLH * ncu; u += C.nblk) mlstm_s3_unit(P, C, l, (u / ncu) * NCH + c_lo + (u % ncu));
    for (int u = C.bid; u < NB * HGH * ncu; u += C.nblk) hgrn_s3_unit(P, C, l, (u / ncu) * NCH + c_lo + (u % ncu));
}

namespace pg8 {
constexpr int BM = 256, BK = 64, HALF = 128, HTB = HALF * BK * 2, STAGE_BYTES = 8 * HTB, NXCD = 8, WGM = 8;
struct Unit { int pm, pn, po; };
struct Gemm { const bf16_t* A; const bf16_t* Bt; int K; };
DEV int lds_byte(int r, int c) { const int st = (r >> 4) * 2 + (c >> 5), rr = r & 15, cc = c & 31, ob = rr * 64 + cc * 2; return st * 1024 + (ob ^ (((ob >> 9) & 1) << 5)); }
DEV void stage_rc(int b, int& R, int& C) { const int st = b / 1024, sb = b % 1024, swz = sb ^ (((sb >> 9) & 1) << 5); R = (st >> 1) * 16 + swz / 64; C = (st & 1) * 32 + (swz % 64) / 2; }
DEV int perm32(int rho) { const int n = rho >> 4, i = rho & 15; return 8 * (i >> 2) + 4 * n + (i & 3); }
struct PanelOrder {
    int nM, nN, nwg, G, c; const int* pe;
    DEV void init(int nM_, int nN_, int G_, int c_, const int* pe_) { nM = nM_; nN = nN_; nwg = nM * nN; G = G_; c = c_; pe = pe_; }
    DEV bool next(int i, Unit& u) const {
        const long L = (long)i * G + c; if (L >= nwg) return false;
        int wgid = (int)L; { const int q = nwg / NXCD, r = nwg % NXCD, xcd = wgid % NXCD, off = wgid / NXCD; wgid = (xcd < r ? xcd * (q + 1) : r * (q + 1) + (xcd - r) * q) + off; }
        const int nig = WGM * nN, gid = wgid / nig, fm = gid * WGM, gsz = (nM - fm) < WGM ? (nM - fm) : WGM;
        u.pm = fm + ((wgid % nig) % gsz); u.po = (wgid % nig) / gsz; u.pn = pe ? pe[u.pm] * nN + u.po : u.po; return true;
    }
    DEV void a_ready(const Unit&) const {}
    DEV void done(const Unit&) const {}
};
#ifndef HOST_EMU
#define PG8_LAS __attribute__((address_space(3)))
typedef int v4i_t __attribute__((ext_vector_type(4)));
template <class Epi, class Sched, bool ALIGN_EPI = false, bool SP2 = false, bool I8 = false>
__device__ __forceinline__ void gemm_phase(PG8_LAS unsigned char* lds, const Gemm g, const Sched& S, const Epi& E) {
    const int tid = opaque_tid(), wid = __builtin_amdgcn_readfirstlane(tid >> 6), lane = tid & 63, wr = wid >> 2, wc = wid & 3, fr = lane & 15, fq = lane >> 4;
    const int K = g.K, nt = K / BK;
    unsigned voffA[2], voffB[2];
#pragma unroll
    for (int i = 0; i < 2; ++i) { int R, C; stage_rc(tid * 16 + i * 8192, R, C); const int Rb = Epi::PERM ? ((R & ~31) + perm32(R & 31)) : R;
        voffA[i] = (unsigned)(R * K + C) * 2u; voffB[i] = (unsigned)(Rb * K + C) * 2u; }
    const size_t kstep = (size_t)(BK * 2);
    const size_t hstep = (size_t)HALF * K * 2;
    const size_t tstep = 2 * hstep;
    const unsigned ldsw = (unsigned)wid * 1024u;
    const int aoff = lds_byte(wr * 64 + fr, fq * 8), boff = lds_byte(wc * 32 + fr, fq * 8);
#define PG8_SA(b, h) (((b) * 2 + (h)) * HTB)
#define PG8_SB(b, h) ((4 + (b) * 2 + (h)) * HTB)
#define PG8_STAGE(bufoff, gbase, voff) do { _Pragma("unroll") for (int _i = 0; _i < 2; ++_i) \
        __builtin_amdgcn_global_load_lds((const unsigned*)((const char*)(gbase) + (voff)[_i]), (PG8_LAS unsigned*)(lds + (bufoff) + ldsw + _i * 8192), 16, 0, 0); } while (0)
#define PG8_LDA(dst, b, h) do { _Pragma("unroll") for (int m = 0; m < 4; ++m) _Pragma("unroll") for (int k = 0; k < 2; ++k) dst[m][k] = *(const PG8_LAS bf16x8*)(lds + PG8_SA(b, h) + aoff + m * 2048 + k * 1024); } while (0)
#define PG8_LDB(dst, b, h) do { _Pragma("unroll") for (int n = 0; n < 2; ++n) _Pragma("unroll") for (int k = 0; k < 2; ++k) dst[n][k] = *(const PG8_LAS bf16x8*)(lds + PG8_SB(b, h) + boff + n * 2048 + k * 1024); } while (0)
#define PG8_MMA(ai, bj, At, Bt) do { __builtin_amdgcn_s_setprio(1); _Pragma("unroll") for (int m = 0; m < 4; ++m) _Pragma("unroll") for (int n = 0; n < 2; ++n) _Pragma("unroll") for (int k = 0; k < 2; ++k) \
        { if constexpr (I8) acc[ai][bj][m][n] = __builtin_bit_cast(f32x4, __builtin_amdgcn_mfma_i32_16x16x64_i8(__builtin_bit_cast(v4i_t, Bt[n][k]), __builtin_bit_cast(v4i_t, At[m][k]), __builtin_bit_cast(v4i_t, acc[ai][bj][m][n]), 0, 0, 0)); \
          else acc[ai][bj][m][n] = __builtin_amdgcn_mfma_f32_16x16x32_bf16(Bt[n][k], At[m][k], acc[ai][bj][m][n], 0, 0, 0); } __builtin_amdgcn_s_setprio(0); } while (0)
#define PG8_WAIT_V(n) asm volatile("s_waitcnt vmcnt(" #n ")" ::: "memory")
#define PG8_WAIT_L(n) asm volatile("s_waitcnt lgkmcnt(" #n ")" ::: "memory")
#define PG8_BAR __builtin_amdgcn_s_barrier()
#define PG8_SCHED __builtin_amdgcn_sched_barrier(0)
    Unit cur, nxt; int ui = 0;
    if (!S.next(0, cur)) return;
    f32x4 acc[2][2][4][2];
#pragma unroll
    for (int a = 0; a < 2; ++a)
#pragma unroll
        for (int b = 0; b < 2; ++b)
#pragma unroll
            for (int m = 0; m < 4; ++m)
#pragma unroll
                for (int n = 0; n < 2; ++n) acc[a][b][m][n] = (f32x4){0.f, 0.f, 0.f, 0.f};
    bf16x8 At[4][2], B0[2][2], B1[2][2];
    const char* cA = (const char*)g.A + (size_t)cur.pm * tstep; const char* cB = (const char*)g.Bt + (size_t)cur.pn * tstep;
    S.a_ready(cur);
    if constexpr (SP2) {
        PG8_STAGE(PG8_SB(0, 0), cB, voffB); PG8_STAGE(PG8_SB(0, 1), cB + hstep, voffB); PG8_STAGE(PG8_SA(0, 0), cA, voffA); PG8_STAGE(PG8_SA(0, 1), cA + hstep, voffA);
        if (wr == 1) PG8_BAR;
        PG8_WAIT_V(2); PG8_BAR;
        PG8_STAGE(PG8_SB(1, 0), cB + kstep, voffB); PG8_STAGE(PG8_SA(1, 0), cA + kstep, voffA); PG8_STAGE(PG8_SB(1, 1), cB + hstep + kstep, voffB);
        PG8_WAIT_V(6); PG8_BAR;
    } else {
        PG8_STAGE(PG8_SB(0, 0), cB, voffB); PG8_STAGE(PG8_SA(0, 0), cA, voffA); PG8_STAGE(PG8_SB(0, 1), cB + hstep, voffB); PG8_STAGE(PG8_SA(0, 1), cA + hstep, voffA);
        if (wr == 1) PG8_BAR;
        PG8_WAIT_V(4); PG8_BAR;
        PG8_STAGE(PG8_SB(1, 0), cB + kstep, voffB); PG8_STAGE(PG8_SA(1, 0), cA + kstep, voffA); PG8_STAGE(PG8_SB(1, 1), cB + hstep + kstep, voffB);
        PG8_WAIT_V(6); PG8_BAR;
    }
    for (;;) {
        const bool has_next = S.next(ui + 1, nxt);
        const char* nA = has_next ? (const char*)g.A + (size_t)nxt.pm * tstep : cA; const char* nB = has_next ? (const char*)g.Bt + (size_t)nxt.pn * tstep : cB;
        for (int t = 0; t < nt; t += 2) {
            const bool last = (t == nt - 2);
            const char* a1 = cA + (size_t)(t + 1) * kstep;
            const char* a2 = last ? nA : cA + (size_t)(t + 2) * kstep; const char* b2 = last ? nB : cB + (size_t)(t + 2) * kstep;
            const char* a3 = a2 + kstep; const char* b3 = b2 + kstep;
            if (last && has_next) S.a_ready(nxt);
            if constexpr (SP2) {
            PG8_LDB(B0, 0, 0); PG8_LDB(B1, 0, 1); PG8_SCHED; PG8_LDA(At, 0, 0); PG8_STAGE(PG8_SA(1, 1), a1 + hstep, voffA);
            PG8_WAIT_V(8); PG8_WAIT_L(0); PG8_BAR; PG8_MMA(0, 0, At, B0); PG8_MMA(0, 1, At, B1); PG8_BAR; PG8_SCHED;
            PG8_LDA(At, 0, 1); PG8_STAGE(PG8_SB(0, 0), b2, voffB); PG8_STAGE(PG8_SB(0, 1), b2 + hstep, voffB); PG8_STAGE(PG8_SA(0, 0), a2, voffA);
            PG8_WAIT_V(8); PG8_WAIT_L(0); PG8_BAR; PG8_MMA(1, 0, At, B0); PG8_MMA(1, 1, At, B1); PG8_BAR; PG8_SCHED;
            PG8_LDB(B0, 1, 0); PG8_LDB(B1, 1, 1); PG8_SCHED; PG8_LDA(At, 1, 0); PG8_STAGE(PG8_SA(0, 1), a2 + hstep, voffA);
            PG8_WAIT_V(8); PG8_WAIT_L(0); PG8_BAR; PG8_MMA(0, 0, At, B0); PG8_MMA(0, 1, At, B1); PG8_BAR; PG8_SCHED;
            PG8_LDA(At, 1, 1); PG8_STAGE(PG8_SB(1, 0), b3, voffB); PG8_STAGE(PG8_SB(1, 1), b3 + hstep, voffB); PG8_STAGE(PG8_SA(1, 0), a3, voffA);
            PG8_WAIT_V(8); PG8_WAIT_L(0); PG8_BAR; PG8_MMA(1, 0, At, B0); PG8_MMA(1, 1, At, B1); PG8_BAR; PG8_SCHED;
            } else {
            PG8_LDB(B0, 0, 0); PG8_SCHED; PG8_LDA(At, 0, 0); PG8_STAGE(PG8_SA(1, 1), a1 + hstep, voffA);
            PG8_WAIT_L(8); PG8_BAR; PG8_WAIT_L(0); PG8_MMA(0, 0, At, B0); PG8_BAR; PG8_SCHED;
            PG8_LDB(B1, 0, 1); PG8_STAGE(PG8_SB(0, 0), b2, voffB);
            PG8_BAR; PG8_WAIT_L(0); PG8_MMA(0, 1, At, B1); PG8_BAR;
            PG8_LDA(At, 0, 1); PG8_STAGE(PG8_SA(0, 0), a2, voffA);
            PG8_BAR; PG8_WAIT_L(0); PG8_MMA(1, 0, At, B0); PG8_BAR; PG8_SCHED;
            PG8_STAGE(PG8_SB(0, 1), b2 + hstep, voffB);
            PG8_WAIT_V(6); PG8_BAR; PG8_MMA(1, 1, At, B1); PG8_BAR;
            PG8_LDB(B0, 1, 0); PG8_SCHED; PG8_LDA(At, 1, 0); PG8_STAGE(PG8_SA(0, 1), a2 + hstep, voffA);
            PG8_WAIT_L(8); PG8_BAR; PG8_WAIT_L(0); PG8_MMA(0, 0, At, B0); PG8_BAR; PG8_SCHED;
            PG8_LDB(B1, 1, 1); PG8_STAGE(PG8_SB(1, 0), b3, voffB);
            PG8_BAR; PG8_WAIT_L(0); PG8_MMA(0, 1, At, B1); PG8_BAR;
            PG8_LDA(At, 1, 1); PG8_STAGE(PG8_SA(1, 0), a3, voffA);
            PG8_BAR; PG8_WAIT_L(0); PG8_MMA(1, 0, At, B0); PG8_BAR; PG8_SCHED;
            PG8_STAGE(PG8_SB(1, 1), b3 + hstep, voffB);
            PG8_WAIT_V(6); PG8_BAR; PG8_MMA(1, 1, At, B1); PG8_BAR;
            }
        }
        if constexpr (ALIGN_EPI) { if (wr == 0) PG8_BAR; }
        if constexpr (I8) {
#pragma unroll
            for (int a = 0; a < 2; ++a)
#pragma unroll
                for (int b = 0; b < 2; ++b)
#pragma unroll
                    for (int m = 0; m < 4; ++m)
#pragma unroll
                        for (int n = 0; n < 2; ++n) acc[a][b][m][n] = __builtin_convertvector(__builtin_bit_cast(v4i_t, acc[a][b][m][n]), f32x4);
        }
        E(acc, cur, wr, wc, fr, fq); S.done(cur);
        if (!has_next) break;
#pragma unroll
        for (int a = 0; a < 2; ++a)
#pragma unroll
            for (int b = 0; b < 2; ++b)
#pragma unroll
                for (int m = 0; m < 4; ++m)
#pragma unroll
                    for (int n = 0; n < 2; ++n) acc[a][b][m][n] = (f32x4){0.f, 0.f, 0.f, 0.f};
        cur = nxt; cA = nA; cB = nB; ++ui;
        if constexpr (ALIGN_EPI) { if (wr == 1) PG8_BAR; }
    }
    PG8_WAIT_V(0);
    if constexpr (!ALIGN_EPI) { if (wr == 0) PG8_BAR; }
    PG8_BAR;
#undef PG8_SA
#undef PG8_SB
#undef PG8_STAGE
#undef PG8_LDA
#undef PG8_LDB
#undef PG8_MMA
#undef PG8_WAIT_V
#undef PG8_WAIT_L
#undef PG8_BAR
#undef PG8_SCHED
}
#else
template <class Epi, class Sched, bool ALIGN_EPI = false, bool SP2 = false, bool I8 = false>
inline void gemm_phase(unsigned char*, const Gemm g, const Sched& S, const Epi& E) {
    const int tid = threadIdx.x, wid = tid >> 6, lane = tid & 63, wr = wid >> 2, wc = wid & 3, fr = lane & 15, fq = lane >> 4;
    Unit u;
    for (int i = 0; S.next(i, u); ++i) {
        f32x4 acc[2][2][4][2];
        for (int ai = 0; ai < 2; ++ai) for (int bj = 0; bj < 2; ++bj) for (int m = 0; m < 4; ++m) for (int n = 0; n < 2; ++n) for (int j = 0; j < 4; ++j) {
            const int row = 256 * u.pm + 128 * ai + 64 * wr + 16 * m + fr;
            const int cit = Epi::PERM ? 128 * bj + 32 * wc + 8 * fq + 4 * n + j : 128 * bj + 32 * wc + 16 * n + 4 * fq + j;
            const bf16_t* a = g.A + (size_t)row * g.K; const bf16_t* b = g.Bt + (size_t)(256 * u.pn + cit) * g.K; float s = 0.f;
            if (I8) { const signed char* a8 = (const signed char*)a; const signed char* b8 = (const signed char*)b; int si = 0; for (int k = 0; k < 2 * g.K; ++k) si += (int)a8[k] * (int)b8[k]; s = (float)si; }
            else for (int k = 0; k < g.K; ++k) s += bf2f(a[k]) * bf2f(b[k]);
            acc[ai][bj][m][n][j] = s; }
        E(acc, u, wr, wc, fr, fq);
    }
}
#endif
}

typedef const f32x4 (&AccRef)[2][2][4][2];
struct EpiInProj {
    static constexpr bool PERM = true;
    bf16_t* Pb; float* G16; const float* asc; const float* wsc;
    DEV void operator()(AccRef acc, const pg8::Unit& u, int wr, int wc, int fr, int fq) const {
        const int row0 = u.pm * 256 + wr * 64 + fr;
        f32x4 ws[2][2];
#pragma unroll
        for (int bj = 0; bj < 2; ++bj)
#pragma unroll
            for (int n = 0; n < 2; ++n) ws[bj][n] = I8_INPROJ ? *(const f32x4*)(wsc + u.pn * 256 + bj * 128 + wc * 32 + 8 * fq + 4 * n) : (f32x4){1.f, 1.f, 1.f, 1.f};
        if (u.po < NPB / 256) {
            const int col0 = u.po * 256 + wc * 32 + 8 * fq;
#pragma unroll
            for (int ai = 0; ai < 2; ++ai)
#pragma unroll
                for (int m = 0; m < 4; ++m) { bf16_t* rowp = Pb + (size_t)(row0 + ai * 128 + m * 16) * NPB + col0; const float as = I8_INPROJ ? asc[row0 + ai * 128 + m * 16] : 1.0f;
#pragma unroll
                    for (int bj = 0; bj < 2; ++bj) { const f32x4 v0 = acc[ai][bj][m][0] * ws[bj][0] * as, v1 = acc[ai][bj][m][1] * ws[bj][1] * as;
                        u32x4 w; w.x = pk2(v0[0], v0[1]); w.y = pk2(v0[2], v0[3]); w.z = pk2(v1[0], v1[1]); w.w = pk2(v1[2], v1[3]);
                        *(u32x4*)(rowp + bj * 128) = w; } }
        } else if (wc == 0 && fq < 2) {
#pragma unroll
            for (int ai = 0; ai < 2; ++ai)
#pragma unroll
                for (int m = 0; m < 4; ++m) { float* rowp = G16 + (size_t)(row0 + ai * 128 + m * 16) * 16 + 8 * fq; const float as = I8_INPROJ ? asc[row0 + ai * 128 + m * 16] : 1.0f;
                    *(f32x4*)rowp = acc[ai][0][m][0] * ws[0][0] * as; *(f32x4*)(rowp + 4) = acc[ai][0][m][1] * ws[0][1] * as; }
        }
    }
};
struct EpiBranch {
    static constexpr bool PERM = true;
    const bf16_t* Pb; float* MGF; bf16_t* MG; int n;
    DEV void operator()(AccRef acc, const pg8::Unit& u, int wr, int wc, int fr, int fq) const {
        const int row0 = u.pm * 256 + wr * 64 + fr, col0 = u.po * 256 + wc * 32 + 8 * fq;
#pragma unroll
        for (int ai = 0; ai < 2; ++ai)
#pragma unroll
            for (int m = 0; m < 4; ++m) { const int row = row0 + ai * 128 + m * 16;
#pragma unroll
                for (int bj = 0; bj < 2; ++bj) { const int col = col0 + bj * 128;
                    float gt[8]; unpack8(*(const u32x4*)(Pb + (size_t)row * NPB + PGATE + n * D + col), gt);
                    float v[8];
#pragma unroll
                    for (int q = 0; q < 8; ++q) v[q] = sigmoidf_(gt[q]) * acc[ai][bj][m][q >> 2][q & 3];
                    float* mp = MGF + (size_t)row * D + col;
                    if (n > 0) { const f32x4 p0 = *(const f32x4*)mp, p1 = *(const f32x4*)(mp + 4);
#pragma unroll
                        for (int q = 0; q < 4; ++q) { v[q] += p0[q]; v[4 + q] += p1[q]; } }
                    if (n < 2) { *(f32x4*)mp = (f32x4){v[0], v[1], v[2], v[3]}; *(f32x4*)(mp + 4) = (f32x4){v[4], v[5], v[6], v[7]}; }
                    else *(u32x4*)(MG + (size_t)row * D + col) = pack8(v); } }
    }
};
struct EpiResid {
    static constexpr bool PERM = false;
    const float* baseL; const float* baseC; float* outL; float* outC; const float* gate;
    bool moe; const int* rtok; const float* rw; const int* rslot; float* ys;
    DEV void operator()(AccRef acc, const pg8::Unit& u, int wr, int wc, int fr, int fq) const {
        const int row0 = u.pm * 256 + wr * 64 + fr, col0 = u.po * 256 + wc * 32 + 4 * fq;
#pragma unroll
        for (int ai = 0; ai < 2; ++ai)
#pragma unroll
            for (int m = 0; m < 4; ++m) { const int row = row0 + ai * 128 + m * 16;
                if (moe) {
                    const int tok = rtok[row]; if (tok < 0) continue;
                    const float w = rw[row]; float* o = ys + ((size_t)rslot[row] * MLAT + tok) * D + col0;
#pragma unroll
                    for (int bj = 0; bj < 2; ++bj)
#pragma unroll
                        for (int n = 0; n < 2; ++n) *(f32x4*)(o + bj * 128 + n * 16) = acc[ai][bj][m][n] * w;
                } else {
                    const bool lat = row < MLAT; const float* b = lat ? baseL + (size_t)row * D : baseC + (size_t)(row - MLAT) * D;
                    float* o = lat ? outL + (size_t)row * D : outC + (size_t)(row - MLAT) * D; const float* gv = gate + (size_t)row_vec(row) * 6 * D;
#pragma unroll
                    for (int bj = 0; bj < 2; ++bj)
#pragma unroll
                        for (int n = 0; n < 2; ++n) { const int c = col0 + bj * 128 + n * 16; *(f32x4*)(o + c) = *(const f32x4*)(b + c) + *(const f32x4*)(gv + c) * acc[ai][bj][m][n]; }
                } }
    }
};
struct EpiGU {
    static constexpr bool PERM = true;
    bf16_t* ACT; const float* asc; const float* wsc;
    DEV void operator()(AccRef acc, const pg8::Unit& u, int wr, int wc, int fr, int fq) const {
        const int row0 = u.pm * 256 + wr * 64 + fr, col0 = u.po * 128 + wc * 32 + 8 * fq;
        float wg[8], wu[8];
#pragma unroll
        for (int q = 0; q < 8; ++q) { wg[q] = I8_FFNUP ? wsc[u.pn * 256 + wc * 32 + 8 * fq + q] : 1.0f; wu[q] = I8_FFNUP ? wsc[u.pn * 256 + 128 + wc * 32 + 8 * fq + q] : 1.0f; }
#pragma unroll
        for (int ai = 0; ai < 2; ++ai)
#pragma unroll
            for (int m = 0; m < 4; ++m) { float v[8]; const float as = I8_FFNUP ? asc[row0 + ai * 128 + m * 16] : 1.0f;
#pragma unroll
                for (int q = 0; q < 8; ++q) v[q] = siluf_(acc[ai][0][m][q >> 2][q & 3] * wg[q] * as) * (acc[ai][1][m][q >> 2][q & 3] * wu[q] * as);
                *(u32x4*)(ACT + (size_t)(row0 + ai * 128 + m * 16) * DFF + col0) = pack8(v); }
    }
};

namespace att {
constexpr int NW = 8, QBLK = 32, KVBLK = 64, LDQ = ATT_W, LDK = KV_W, LDO = BW;
constexpr float SCALE = 0.088388347648318440f, THR = 8.f;
constexpr size_t SHM_V = KVBLK * HD * 2, SHM_K = KVBLK * HD * 2, SHM_ATTN = 2 * SHM_V + 2 * SHM_K + NW * 64 * 4;
#ifndef HOST_EMU
using s16x4 = __attribute__((ext_vector_type(4))) short;
#define KSWZ(row, colB) ((row) * 256 + ((colB) ^ (((row) & 7) << 4)))
#define SBAR() __builtin_amdgcn_sched_barrier(0)
__device__ __forceinline__ unsigned cvtpk(float lo, float hi) { unsigned r; asm volatile("v_cvt_pk_bf16_f32 %0, %1, %2" : "=v"(r) : "v"(lo), "v"(hi)); return r; }
__device__ __forceinline__ void partialSM(f32x16& p0, f32x16& p1, float& m_reg, float& mn, float& alpha) {
  constexpr float C = SCALE * 1.4426950408889634f;
  float pmax = p0[0]; for (int r = 1; r < 16; ++r) pmax = fmaxf(pmax, p0[r]); for (int r = 0; r < 16; ++r) pmax = fmaxf(pmax, p1[r]);
  { auto rr = __builtin_amdgcn_permlane32_swap(__float_as_uint(pmax), __float_as_uint(pmax), false, false);
    pmax = fmaxf(__uint_as_float(rr[0]), __uint_as_float(rr[1])); }
  if (__builtin_expect(__all(pmax - m_reg <= THR / SCALE), 1)) { mn = m_reg; alpha = 1.f; }
  else { mn = fmaxf(m_reg, pmax); alpha = __builtin_amdgcn_exp2f((m_reg - mn) * C); m_reg = mn; }
  float mnC = -mn * C;
  for (int r = 0; r < 16; ++r) p0[r] = fmaf(p0[r], C, mnC); for (int r = 0; r < 16; ++r) p1[r] = fmaf(p1[r], C, mnC);
  for (int r = 0; r < 16; ++r) p0[r] = __builtin_amdgcn_exp2f(p0[r]);
}
__device__ __forceinline__ void finishSM(f32x16& p0, f32x16& p1, float alpha, float& l_reg, bf16x8& pa0, bf16x8& pa1, bf16x8& pa2, bf16x8& pa3) {
  for (int r = 0; r < 16; ++r) p1[r] = __builtin_amdgcn_exp2f(p1[r]);
  float ps = 0; for (int r = 0; r < 16; ++r) ps += p0[r]; for (int r = 0; r < 16; ++r) ps += p1[r];
  { auto rr = __builtin_amdgcn_permlane32_swap(__float_as_uint(ps), __float_as_uint(ps), false, false);
    ps = __uint_as_float(rr[0]) + __uint_as_float(rr[1]); }
  l_reg = l_reg * alpha + ps;
#define PK4(P, BASE, OUT) do { unsigned a0 = cvtpk(P[BASE + 0], P[BASE + 1]), a1 = cvtpk(P[BASE + 2], P[BASE + 3]);   \
    unsigned b0 = cvtpk(P[BASE + 4], P[BASE + 5]), b1 = cvtpk(P[BASE + 6], P[BASE + 7]);                              \
    auto r0 = __builtin_amdgcn_permlane32_swap(a0, b0, false, false); auto r1 = __builtin_amdgcn_permlane32_swap(a1, b1, false, false); \
    u32x4 w = {r0[0], r1[0], r0[1], r1[1]}; OUT = *reinterpret_cast<bf16x8*>(&w); } while (0)
  PK4(p0, 0, pa0); PK4(p0, 8, pa1); PK4(p1, 0, pa2); PK4(p1, 8, pa3);
#undef PK4
}
__device__ __forceinline__ void qkt(f32x16& p0, f32x16& p1, const bf16_t* Ks, const bf16x8* qr, int r32, int hi) {
  p0 = f32x16{}; p1 = f32x16{};
  for (int d0 = 0; d0 < 8; ++d0) { int cb = (d0 * 16 + hi * 8) * 2;
    bf16x8 b0 = *reinterpret_cast<const bf16x8*>((const char*)Ks + KSWZ(r32, cb));
    bf16x8 b1 = *reinterpret_cast<const bf16x8*>((const char*)Ks + KSWZ(32 + r32, cb));
    p0 = __builtin_amdgcn_mfma_f32_32x32x16_bf16(b0, qr[d0], p0, 0, 0, 0);
    p1 = __builtin_amdgcn_mfma_f32_32x32x16_bf16(b1, qr[d0], p1, 0, 0, 0); }
}
__device__ __forceinline__ int v_st(int k, int c) { const int kk = (k & ~0xC) | ((k & 4) << 1) | ((k & 8) >> 1); return ((kk >> 3) * 4 + (c >> 5)) * 512 + ((kk & 7) * 32 + (c & 31)) * 2; }
__device__ __forceinline__ int v_rd_base(int lane) { return ((lane & 3) << 3) | (((lane >> 2) & 3) << 6) | (((lane >> 4) & 1) << 5) | (((lane >> 5) & 1) << 8); }
constexpr int v_rd_off(int d0, int ks, int half) { return d0 * 512 + ks * 4096 + half * 2048; }
template <int OFF> __device__ __forceinline__ s16x4 tr_read(int vb) {
  s16x4 r; asm volatile("ds_read_b64_tr_b16 %0, %1 offset:%2" : "=&v"(r) : "v"(vb), "i"(OFF) : "memory"); return r;
}
template <int D0> __device__ __forceinline__ void pv_one(f32x16& od, int vb, bf16x8 pa0, bf16x8 pa1, bf16x8 pa2, bf16x8 pa3) {
  const s16x4 l0 = tr_read<v_rd_off(D0, 0, 0)>(vb), h0 = tr_read<v_rd_off(D0, 0, 1)>(vb), l1 = tr_read<v_rd_off(D0, 1, 0)>(vb), h1 = tr_read<v_rd_off(D0, 1, 1)>(vb);
  const s16x4 l2 = tr_read<v_rd_off(D0, 2, 0)>(vb), h2 = tr_read<v_rd_off(D0, 2, 1)>(vb), l3 = tr_read<v_rd_off(D0, 3, 0)>(vb), h3 = tr_read<v_rd_off(D0, 3, 1)>(vb);
  asm volatile("s_waitcnt lgkmcnt(0)" ::: "memory"); SBAR();
#define PK(L, H) (bf16x8){L[0], L[1], L[2], L[3], H[0], H[1], H[2], H[3]}
  od = __builtin_amdgcn_mfma_f32_32x32x16_bf16(pa0, PK(l0, h0), od, 0, 0, 0);
  od = __builtin_amdgcn_mfma_f32_32x32x16_bf16(pa1, PK(l1, h1), od, 0, 0, 0);
  od = __builtin_amdgcn_mfma_f32_32x32x16_bf16(pa2, PK(l2, h2), od, 0, 0, 0);
  od = __builtin_amdgcn_mfma_f32_32x32x16_bf16(pa3, PK(l3, h3), od, 0, 0, 0);
#undef PK
}
__device__ __forceinline__ void pv_d0(f32x16* o, int vb, bf16x8 pa0, bf16x8 pa1, bf16x8 pa2, bf16x8 pa3) {
  pv_one<0>(o[0], vb, pa0, pa1, pa2, pa3); pv_one<1>(o[1], vb, pa0, pa1, pa2, pa3); pv_one<2>(o[2], vb, pa0, pa1, pa2, pa3); pv_one<3>(o[3], vb, pa0, pa1, pa2, pa3);
}
__device__ __forceinline__ void attn_dense_body(const bf16_t* __restrict__ Qb, const bf16_t* __restrict__ Kh, const bf16_t* __restrict__ Vh, bf16_t* __restrict__ Ob, int seq, char* lds) {
  const int tid = opaque_tid(), wid = tid >> 6, lane = tid & 63, r32 = lane & 31, hi = lane >> 5;
  bf16_t* V_lds = (bf16_t*)lds; bf16_t* K_lds = (bf16_t*)(lds + 2 * SHM_V);
  float* ws = (float*)(lds + 2 * SHM_V + 2 * SHM_K) + wid * 64; float* li_l = ws; float* al_l = ws + 32;
  float m_reg = -1e30f, l_reg = 0; f32x16 o[4] = {}; bf16x8 qr[8];
  const bf16_t* Qw = Qb + (long)(wid * QBLK + r32) * LDQ + hi * 8;
#pragma unroll
  for (int d0 = 0; d0 < 8; ++d0) qr[d0] = *reinterpret_cast<const bf16x8*>(Qw + d0 * 16);
  const int sr = tid >> 4, sc = (tid & 15) * 8, vst0 = v_st(sr, sc), vst1 = v_st(32 + sr, sc);
  const int vb0 = (int)(uintptr_t)V_lds + v_rd_base(lane);
  struct { bf16x8 vs0, vs1, ks0, ks1; } sr_[2];
#define SLOAD(i, k0) do { sr_[i].vs0 = *reinterpret_cast<const bf16x8*>(&Vh[(long)((k0) + sr) * LDK + sc]); sr_[i].vs1 = *reinterpret_cast<const bf16x8*>(&Vh[(long)((k0) + 32 + sr) * LDK + sc]); \
    sr_[i].ks0 = *reinterpret_cast<const bf16x8*>(&Kh[(long)((k0) + sr) * LDK + sc]); sr_[i].ks1 = *reinterpret_cast<const bf16x8*>(&Kh[(long)((k0) + 32 + sr) * LDK + sc]); } while (0)
#define SWRITE(b, i) do { *(bf16x8*)((char*)V_lds + (b) * SHM_V + vst0) = sr_[i].vs0;          \
    *(bf16x8*)((char*)V_lds + (b) * SHM_V + vst1) = sr_[i].vs1; int kc = sc * 2;               \
    *(bf16x8*)((char*)K_lds + (b) * SHM_K + KSWZ(sr, kc)) = sr_[i].ks0;                       \
    *(bf16x8*)((char*)K_lds + (b) * SHM_K + KSWZ(32 + sr, kc)) = sr_[i].ks1; } while (0)
#define SWAIT() asm volatile("s_waitcnt vmcnt(4)" ::: "memory")
#define RESC(a) do { if (__any((a) < 1.f)) { if (hi == 0) al_l[r32] = (a); asm volatile("s_waitcnt lgkmcnt(0)" ::: "memory"); \
    for (int d = 0; d < 4; ++d) for (int r = 0; r < 16; ++r) o[d][r] *= al_l[crow(r, hi)]; } } while (0)
  f32x16 pA0, pA1, pB0, pB1; float mnA, mnB, alA, alB; bf16x8 pa0, pa1, pa2, pa3; const int NT = seq / KVBLK;
  constexpr int SE = 0, SO = 1;
  SLOAD(SE, 0); asm volatile("s_waitcnt vmcnt(0)" ::: "memory"); SWRITE(0, SE); __syncthreads();
  qkt(pA0, pA1, K_lds, qr, r32, hi); partialSM(pA0, pA1, m_reg, mnA, alA);
  SLOAD(SO, KVBLK); if (2 < NT) SLOAD(SE, 2 * KVBLK);
  SWAIT(); SWRITE(1, SO); __syncthreads();
  for (int j = 1; j + 1 < NT; j += 2) {
    SBAR(); qkt(pB0, pB1, (bf16_t*)((char*)K_lds + SHM_K), qr, r32, hi);
    finishSM(pA0, pA1, alA, l_reg, pa0, pa1, pa2, pa3); SBAR();
    SLOAD(SO, (j + 2) * KVBLK); SBAR();
    pv_d0(o, vb0, pa0, pa1, pa2, pa3); partialSM(pB0, pB1, m_reg, mnB, alB);
    __syncthreads(); SWAIT(); SWRITE(0, SE);
    RESC(alB); __syncthreads();
    SBAR(); qkt(pA0, pA1, K_lds, qr, r32, hi);
    finishSM(pB0, pB1, alB, l_reg, pa0, pa1, pa2, pa3); SBAR();
    if (j + 3 < NT) SLOAD(SE, (j + 3) * KVBLK); SBAR();
    pv_d0(o, vb0 + (int)SHM_V, pa0, pa1, pa2, pa3); partialSM(pA0, pA1, m_reg, mnA, alA);
    __syncthreads(); SWAIT(); SWRITE(1, SO);
    RESC(alA); __syncthreads();
  }
  SBAR(); qkt(pB0, pB1, (bf16_t*)((char*)K_lds + SHM_K), qr, r32, hi);
  finishSM(pA0, pA1, alA, l_reg, pa0, pa1, pa2, pa3); SBAR();
  pv_d0(o, vb0, pa0, pa1, pa2, pa3); partialSM(pB0, pB1, m_reg, mnB, alB);
  __syncthreads(); RESC(alB);
  finishSM(pB0, pB1, alB, l_reg, pa0, pa1, pa2, pa3); SBAR();
  pv_d0(o, vb0 + (int)SHM_V, pa0, pa1, pa2, pa3);
  if (hi == 0) li_l[r32] = l_reg; asm volatile("s_waitcnt lgkmcnt(0)" ::: "memory");
  float rli[16];
#pragma unroll
  for (int r = 0; r < 16; ++r) rli[r] = __builtin_amdgcn_rcpf(li_l[crow(r, hi)]);
  bf16_t* Ow = Ob + (long)(wid * QBLK) * LDO;
#pragma unroll
  for (int r = 0; r < 16; ++r) { int orow = crow(r, hi);
    for (int d0 = 0; d0 < 4; ++d0) Ow[(long)orow * LDO + d0 * 32 + r32] = (bf16_t)f2bf(o[d0][r] * rli[r]); }
  __syncthreads();
#undef SLOAD
#undef SWRITE
#undef SWAIT
#undef RESC
}
#else
inline void attn_dense_body(const bf16_t* Qb, const bf16_t* Kh, const bf16_t* Vh, bf16_t* Ob, int seq, char*) {
  const int tid = threadIdx.x; if (tid >= 256) return;
  const bf16_t* q = Qb + (long)tid * LDQ; std::vector<float> sc(seq); float mx = -1e30f;
  for (int k = 0; k < seq; ++k) { float s = 0; for (int d = 0; d < HD; ++d) s += bf2f(q[d]) * bf2f(Kh[(long)k * LDK + d]); sc[k] = s * SCALE; mx = fmaxf(mx, sc[k]); }
  float l = 0; for (int k = 0; k < seq; ++k) { sc[k] = expf(sc[k] - mx); l += sc[k]; }
  for (int d = 0; d < HD; ++d) { float o = 0; for (int k = 0; k < seq; ++k) o += sc[k] * bf2f(Vh[(long)k * LDK + d]); Ob[(long)tid * LDO + d] = (bf16_t)f2bf(o / l); }
}
#endif
}
DEV void phase_attn(const Params& P, const Ctx& C, bool need_ctx) {
    constexpr int QBL = TL / 256, QBC = TC / 256, NUL = NB * AH * QBL;
    const int nu = NUL + (need_ctx ? NB * AH * QBC : 0);
    for (int u = C.bid; u < nu; u += C.nblk) {
        const bool lat = u < NUL; const int v = lat ? u : u - NUL, nqb = lat ? QBL : QBC;
        const int qb = v % nqb, h = (v / nqb) % AH, b = v / (nqb * AH), kvh = h / (AH / AKV);
        const int row0 = lat ? lat_row(b, qb * 256) : ctx_row(b, qb * 256);
        const bf16_t* Kh = WSP(bf16_t, WS_KCAT) + (size_t)b * TT * KV_W + kvh * HD; const bf16_t* Vh = WSP(bf16_t, WS_VCAT) + (size_t)b * TT * KV_W + kvh * HD;
        att::attn_dense_body(WSP(bf16_t, WS_QA) + (size_t)row0 * ATT_W + h * HD, Kh, Vh, WSP(bf16_t, WS_Y) + (size_t)row0 * BW + h * HD, lat ? TT : TC, (char*)C.lds);
    }
}

constexpr size_t SM2_PE = 0;
constexpr int CW_PE = 2048, CW_NPAN = 2047;
static_assert(CW_PE + MOE_PANELS <= CW_BAR, "panel table fits below the barrier words");
DEV void phase_moe_gather(const Params& P, const Ctx& C) {
    const unsigned* cnt = WSP(unsigned, WS_CTL) + CW_CNT;
    int poff[NE + 1]; poff[0] = 0;
#pragma unroll
    for (int e = 0; e < NE; ++e) poff[e + 1] = poff[e] + (int)((cnt[e] + 255u) / 256u) * 256;
    if (C.bid == 0 && C.tid < MOE_PANELS) { int e = -1;
#pragma unroll
        for (int q = 0; q < NE; ++q) if (C.tid * 256 >= poff[q] && C.tid * 256 < poff[q + 1]) e = q;
        WSP(int, WS_CTL)[CW_PE + C.tid] = e < 0 ? 0 : e; if (C.tid == 0) WSP(int, WS_CTL)[CW_NPAN] = poff[NE] / 256; }
    const int* te = WSP(int, WS_SMALL + SM_TE); const float* tw = WSP(float, WS_SMALL + SM_TW); const int* tp = WSP(int, WS_SMALL + SM_TP);
    for (int i = C.gw; i < MLAT * 2; i += C.ngw) {
        const int tok = i >> 1, k = i & 1, e = te[i]; int base = 0;
#pragma unroll
        for (int q = 0; q < NE; ++q) if (q == e) base = poff[q];
        const int r = base + tp[i];
        constexpr int RB = D * (I8_FFNUP ? 1 : 2);
        const u32x4* src = (const u32x4*)(P.ws + WS_H + (size_t)tok * RB); u32x4* dst = (u32x4*)(P.ws + WS_APERM + (size_t)r * RB);
        for (int q = C.lane; q < RB / 16; q += 64) dst[q] = src[q];
        if (C.lane == 0) { WSP(int, WS_SMALL + SM_RTOK)[r] = tok; WSP(float, WS_SMALL + SM_RASC)[r] = WSP(float, WS_SMALL + SM_ASC)[tok]; WSP(float, WS_SMALL + SM_RW)[r] = tw[i]; WSP(int, WS_SMALL + SM_RSLOT)[r] = k; }
    }
}
DEV void phase_moe_combine(const Params& P, const Ctx& C, int l) {
    const int gt = C.bid * NTHREADS + C.tid, ngt = C.nblk * NTHREADS;
    const float* ys = WSP(float, WS_YS);
    for (int i = gt; i < MLAT * (D / 4); i += ngt) {
        const int row = i / (D / 4), col = (i % (D / 4)) * 4;
        const f32x4 g = *(const f32x4*)(mod_vec(P, l, row_vec(row), 5) + col);
        *(f32x4*)(P.out + (size_t)row * D + col) = *(const f32x4*)(WSP(float, WS_X1) + (size_t)row * D + col) + g * (*(const f32x4*)(ys + (size_t)row * D + col) + *(const f32x4*)(ys + ((size_t)MLAT + row) * D + col));
    }
}

#ifndef HOST_EMU
#define LAS __attribute__((address_space(3)))
#define XB_TMO      128
#define XB_XCNT(j)  (256  + 64 * (j))
#define XB_XSUB(j)  (1280 + 64 * (j))
#define XB_XGEN(j)  (2304 + 64 * (j))
#define XB_TOP      3328
#define XB_TOPGEN   3392
#define XCD_BAR_WORDS 3456
#define XB_SPIN_CAP (1u << 18)
__device__ __forceinline__ unsigned xb_ld(unsigned* p)              { return __hip_atomic_load(p, __ATOMIC_RELAXED, __HIP_MEMORY_SCOPE_AGENT); }
__device__ __forceinline__ unsigned xb_add(unsigned* p, unsigned v) { return __hip_atomic_fetch_add(p, v, __ATOMIC_RELAXED, __HIP_MEMORY_SCOPE_AGENT); }
__device__ __forceinline__ unsigned xb_xcc_id() { return (unsigned)__builtin_amdgcn_s_getreg((3 << 11) | 20) & 0xFu; }
#define XB_SPIN(cond, bar) do { unsigned _sp = 0; while (cond) { __builtin_amdgcn_s_sleep(1); \
    if ((++_sp & 255u) == 0u) { if (xb_ld(&(bar)[XB_TMO])) break; if (_sp > XB_SPIN_CAP) { atomicAdd(&(bar)[XB_TMO], 1u); break; } } } } while (0)
struct XcdBarrier { unsigned* bar; unsigned x; volatile LAS unsigned* st; };
__device__ __forceinline__ XcdBarrier xcd_barrier_post(unsigned* bar, volatile LAS unsigned* st) {
    XcdBarrier b; b.bar = bar; b.x = xb_xcc_id(); b.st = st;
    if (threadIdx.x == 0) (void)xb_add(&bar[XB_XCNT(b.x)], 1u);
    return b;
}
__device__ __forceinline__ void xcd_barrier_complete(unsigned* bar, unsigned x, unsigned& nloc, unsigned& nx) {
    const unsigned G = gridDim.x * gridDim.y * gridDim.z;
    unsigned sum, cnt, mine, sp = 0u;
    for (;;) {
        sum = 0u; cnt = 0u; mine = 0u;
#pragma unroll
        for (unsigned j = 0; j < 16; ++j) { const unsigned c = xb_ld(&bar[XB_XCNT(j)]); sum += c; cnt += (c > 0u) ? 1u : 0u; mine = (j == x) ? c : mine; }
        if (sum == G) break;
        __builtin_amdgcn_s_sleep(1);
        if ((++sp & 255u) == 0u) { if (xb_ld(&bar[XB_TMO])) break; if (sp > XB_SPIN_CAP) { atomicAdd(&bar[XB_TMO], 1u); break; } }
    }
    nloc = mine > 0u ? mine : 1u; nx = cnt > 0u ? cnt : 1u;
}
__device__ __forceinline__ void xcd_barrier(const XcdBarrier& b) {
    asm volatile("s_waitcnt vmcnt(0)" ::: "memory");
    __syncthreads();
    if (threadIdx.x == 0) {
        unsigned* bar = b.bar;
        __builtin_amdgcn_s_waitcnt(0);
        unsigned nloc = b.st[0], nx = b.st[1];
        if (nloc == 0u) { xcd_barrier_complete(bar, b.x, nloc, nx); b.st[0] = nloc; b.st[1] = nx; }
        const unsigned old = xb_add(&bar[XB_XSUB(b.x)], 1u);
        const unsigned gen = old / nloc;
        if (old + 1u == (gen + 1u) * nloc) {
            __builtin_amdgcn_fence(__ATOMIC_RELEASE, "agent");
            asm volatile("s_waitcnt vmcnt(0)" ::: "memory");
            const unsigned og = xb_add(&bar[XB_TOP], 1u);
            const unsigned tg = og / nx;
            if (og + 1u == (tg + 1u) * nx) xb_add(&bar[XB_TOPGEN], 1u);
            else XB_SPIN(xb_ld(&bar[XB_TOPGEN]) == tg, bar);
            __builtin_amdgcn_fence(__ATOMIC_ACQUIRE, "agent");
            xb_add(&bar[XB_XGEN(b.x)], 1u);
            asm volatile("s_waitcnt vmcnt(0)" ::: "memory");
        } else {
            XB_SPIN(xb_ld(&bar[XB_XGEN(b.x)]) == gen, bar);
            __builtin_amdgcn_fence(__ATOMIC_ACQUIRE, "agent");
            asm volatile("s_waitcnt vmcnt(0)" ::: "memory");
        }
    }
    __syncthreads();
}
#define GEMM_LDS(C) ((PG8_LAS unsigned char*)(C).lds)
#else
struct XcdBarrier { int dummy; };
inline void xcd_barrier(const XcdBarrier&) {}
#define GEMM_LDS(C) ((C).lds)
#endif

constexpr int NPL = 13, NPHASES = 2 + DEPTH * NPL;
#ifndef PROBE_MASK
#define PROBE_MASK 0
#endif
#define REPS(g) (1 + ((PROBE_MASK >> (g)) & 1))
#define REP_BEGIN(g) _Pragma("unroll 1") for (int rep_ = 0; rep_ < REPS(g); ++rep_) {
#define REP_END(g) if (rep_ + 1 < REPS(g)) xcd_barrier(bar); }
DEV void run_phases(const Params& P, unsigned char* ldsp, const int lo, const int hi, const XcdBarrier& bar) {
#define C make_ctx(ldsp)
#define IN(k) (lo <= (k) && (k) < hi)
#define SEAM(k) do { if (IN(k) && IN((k) + 1)) xcd_barrier(bar); } while (0)
    if (IN(0)) { REP_BEGIN(0) phase_weights(P, C); phase_mod_partial(P, C); REP_END(0) }
    SEAM(0);
    if (IN(1)) phase_mod_final(P, C);
    SEAM(1);
    for (int l = 0; l < DEPTH; ++l) {
        const int pb = 2 + l * NPL; const bool need_ctx = l < DEPTH - 1, moe = (l & 1) != 0;
        const int rows = need_ctx ? MT : MLAT;
        if (IN(pb + 0)) { REP_BEGIN(1) phase_hpass(P, C, l, 0, false); REP_END(1) }
        SEAM(pb + 0);
        if (IN(pb + 1)) { REP_BEGIN(2)
            pg8::Gemm g{WSP(bf16_t, WS_H), WSP(bf16_t, WS_WIN) + (size_t)l * NP * D, I8_INPROJ ? D / 2 : D};
            pg8::PanelOrder S; S.init(MT / 256, NP / 256, C.nblk, C.bid, nullptr);
            EpiInProj E{WSP(bf16_t, WS_P), WSP(float, WS_G16), WSP(float, WS_SMALL + SM_ASC), WSP(float, WS_SMALL + SM_WSIN) + (size_t)l * NP};
            pg8::gemm_phase<EpiInProj, pg8::PanelOrder, true, true, I8_INPROJ != 0>(GEMM_LDS(C), g, S, E);
        REP_END(2) }
        SEAM(pb + 1);
        if (IN(pb + 2)) { REP_BEGIN(3) phase_fixup(P, C, l, need_ctx); REP_END(3) }
        SEAM(pb + 2);
        REP_BEGIN(4)
        if (IN(pb + 3)) phase_s1(P, C, l);
        SEAM(pb + 3);
        if (IN(pb + 4)) phase_s2(P, C);
        REP_END(4)
        SEAM(pb + 4);
        if (IN(pb + 5)) { REP_BEGIN(5) phase_attn(P, C, need_ctx); REP_END(5) REP_BEGIN(6) phase_s3(P, C, l, need_ctx); REP_END(6) }
        SEAM(pb + 5);
        if (IN(pb + 6)) { REP_BEGIN(7)
            for (int n = 0; n < 3; ++n) {
                pg8::Gemm g{WSP(bf16_t, WS_Y) + (size_t)n * MT * BW, WSP(bf16_t, WS_WBR) + (size_t)(l * 3 + n) * D * BW, BW};
                pg8::PanelOrder S; S.init(rows / 256, D / 256, C.nblk, C.bid, nullptr);
                EpiBranch E{WSP(bf16_t, WS_P), WSP(float, WS_MGF), WSP(bf16_t, WS_MG), n};
                pg8::gemm_phase<EpiBranch, pg8::PanelOrder, true, true>(GEMM_LDS(C), g, S, E);
            }
        REP_END(7) }
        SEAM(pb + 6);
        if (IN(pb + 7)) { REP_BEGIN(8)
            pg8::Gemm g{WSP(bf16_t, WS_MG), WSP(bf16_t, WS_WOUT) + (size_t)l * D * D, D};
            pg8::PanelOrder S; S.init(rows / 256, D / 256, C.nblk, C.bid, nullptr);
            const float* bL = l == 0 ? P.x : WSP(float, WS_X2); const float* bC = l == 0 ? P.ctx : WSP(float, WS_X2) + (size_t)MLAT * D;
            EpiResid E{bL, bC, WSP(float, WS_X1), WSP(float, WS_X1) + (size_t)MLAT * D, mod_vec(P, l, 0, 2), false, nullptr, nullptr, nullptr, nullptr};
            pg8::gemm_phase<EpiResid, pg8::PanelOrder, true, true>(GEMM_LDS(C), g, S, E);
        REP_END(8) }
        SEAM(pb + 7);
        if (IN(pb + 8)) phase_hpass(P, C, l, 1, moe);
        SEAM(pb + 8);
        if (IN(pb + 9)) { if (moe) phase_moe_gather(P, C); }
        SEAM(pb + 9);
        if (IN(pb + 10)) { REP_BEGIN(9)
            pg8::Gemm g{moe ? WSP(bf16_t, WS_APERM) : WSP(bf16_t, WS_H), moe ? WSP(bf16_t, WS_WMGU) + (size_t)(l / 2) * NE * 2 * DFF * D : WSP(bf16_t, WS_WGU) + (size_t)(l / 2) * 2 * DFF * D, I8_FFNUP ? D / 2 : D};
            pg8::PanelOrder S; S.init(moe ? WSP(int, WS_CTL)[CW_NPAN] : rows / 256, 2 * DFF / 256, C.nblk, C.bid, moe ? WSP(int, WS_CTL) + CW_PE : nullptr);
            EpiGU E{WSP(bf16_t, WS_ACT), moe ? WSP(float, WS_SMALL + SM_RASC) : WSP(float, WS_SMALL + SM_ASC), moe ? WSP(float, WS_SMALL + SM_WSMGU) : WSP(float, WS_SMALL + SM_WSGU)};
            pg8::gemm_phase<EpiGU, pg8::PanelOrder, true, true, I8_FFNUP != 0>(GEMM_LDS(C), g, S, E);
        REP_END(9) }
        SEAM(pb + 10);
        if (IN(pb + 11)) { REP_BEGIN(10)
            pg8::Gemm g{WSP(bf16_t, WS_ACT), moe ? WSP(bf16_t, WS_WMDN) + (size_t)(l / 2) * NE * D * DFF : WSP(bf16_t, WS_WDN) + (size_t)(l / 2) * D * DFF, DFF};
            pg8::PanelOrder S; S.init(moe ? WSP(int, WS_CTL)[CW_NPAN] : rows / 256, D / 256, C.nblk, C.bid, moe ? WSP(int, WS_CTL) + CW_PE : nullptr);
            float* oL = (l == DEPTH - 1) ? P.out : WSP(float, WS_X2);
            EpiResid E{WSP(float, WS_X1), WSP(float, WS_X1) + (size_t)MLAT * D, oL, WSP(float, WS_X2) + (size_t)MLAT * D, mod_vec(P, l, 0, 5), moe,
                       WSP(int, WS_SMALL + SM_RTOK), WSP(float, WS_SMALL + SM_RW), WSP(int, WS_SMALL + SM_RSLOT), WSP(float, WS_YS)};
            pg8::gemm_phase<EpiResid, pg8::PanelOrder, true, true>(GEMM_LDS(C), g, S, E);
        REP_END(10) }
        SEAM(pb + 11);
        if (IN(pb + 12)) { if (moe) phase_moe_combine(P, C, l); }
        if (l + 1 < DEPTH) SEAM(pb + 12);
    }
#undef IN
#undef SEAM
#undef C
}

struct Args { Params P; int ph_lo, ph_hi; };
#if !defined(HOST_EMU) && !defined(NO_MAIN_KERNEL)
constexpr int MISC_OFF = 131072 + 320;
__global__ void __launch_bounds__(NTHREADS, 2) hybrid_fwd(Args a) {
    extern __shared__ __attribute__((aligned(16))) unsigned char lds[];
    volatile LAS unsigned* MISC = (volatile LAS unsigned*)((LAS unsigned char*)lds + MISC_OFF);
    if (threadIdx.x < 32) MISC[threadIdx.x] = 0u;
    __syncthreads();
    XcdBarrier bar = xcd_barrier_post((unsigned*)(a.P.ws + WS_CTL) + CW_BAR, MISC + 8);
    run_phases(a.P, lds, a.ph_lo, a.ph_hi, bar);
}

#ifndef N_LAUNCH_MODE
#define N_LAUNCH_MODE 1
#endif
extern "C" void kernel_launch(void* const* d_in, const int* in_sizes, int n_in, void* d_out, int out_size, void* d_ws, size_t ws_size, hipStream_t stream) {
    static int grid = 0;
    if (grid == 0) {
        if (n_in != 25 || in_sizes[0] != MLAT * D || out_size != MLAT * D || ws_size < WS_END) {
            fprintf(stderr, "kernel_launch: unexpected shapes: n_in %d in0 %d out %d ws %zu (need %zu)\n", n_in, n_in > 0 ? in_sizes[0] : -1, out_size, ws_size, (size_t)WS_END); grid = -1; return; }
        int dev = 0, cus = 0, per_cu = 0;
        if (hipGetDevice(&dev) != hipSuccess || hipDeviceGetAttribute(&cus, hipDeviceAttributeMultiprocessorCount, dev) != hipSuccess) { grid = -1; return; }
        if (hipFuncSetAttribute((const void*)hybrid_fwd, hipFuncAttributeMaxDynamicSharedMemorySize, LDS_BYTES) != hipSuccess) { fprintf(stderr, "kernel_launch: hipFuncSetAttribute failed\n"); grid = -1; return; }
        if (hipOccupancyMaxActiveBlocksPerMultiprocessor(&per_cu, (const void*)hybrid_fwd, NTHREADS, LDS_BYTES) != hipSuccess || per_cu < 1) fprintf(stderr, "kernel_launch: occupancy query says %d\n", per_cu);
        (void)hipGetLastError();
        grid = cus;
    }
    if (grid < 0) return;
    (void)hipMemsetAsync((char*)d_ws + WS_CTL, 0, CTL_BYTES, stream);
    Args a{};
    const float** pp = (const float**)&a.P;
    for (int i = 0; i < 25; ++i) pp[i] = (const float*)d_in[i];
    a.P.out = (float*)d_out; a.P.ws = (unsigned char*)d_ws;
    if (N_LAUNCH_MODE == 1) { a.ph_lo = 0; a.ph_hi = NPHASES; hipLaunchKernelGGL(hybrid_fwd, dim3(grid), dim3(NTHREADS), LDS_BYTES, stream, a); }
    else for (int ph = 0; ph < NPHASES; ++ph) { a.ph_lo = ph; a.ph_hi = ph + 1; hipLaunchKernelGGL(hybrid_fwd, dim3(grid), dim3(NTHREADS), LDS_BYTES, stream, a); }
    const hipError_t le = hipPeekAtLastError();
    if (le != hipSuccess) fprintf(stderr, "kernel_launch: launch failed: %s\n", hipGetErrorName(le));
}
#endif
```
